# Optimizing an MI355X kernel written in HIP

```python
import jax, jax.numpy as jnp
from jax import lax
import numpy as np

D_MODEL = 1024
BATCH = 4
SEQ = 4096
DEPTH = 4
DEC_BATCH = 8
DEC_SEQ = 8192
PAST_LEN = 128

N_META = 16
GRID_W = 64
HEAD_DIM = 64
ATTN_WIDTH = 512
N_Q_HEADS = ATTN_WIDTH // HEAD_DIM
N_KV_HEADS = 2
KV_GROUP = N_Q_HEADS // N_KV_HEADS
KV_WIDTH = N_KV_HEADS * HEAD_DIM
CONV_WIDTH = D_MODEL - ATTN_WIDTH
CONV_GROUPS = CONV_WIDTH // HEAD_DIM
D_FF = 2816
Q_BLOCK = 128
ROPE_THETA = 10000.0
ROPE_PAIRS_AXIS = HEAD_DIM // 4
EPS = 1e-6
IN_WIDTH = ATTN_WIDTH + 2 * KV_WIDTH + 3 * CONV_WIDTH
SPLIT_POINTS = (ATTN_WIDTH,
                ATTN_WIDTH + KV_WIDTH,
                ATTN_WIDTH + 2 * KV_WIDTH,
                ATTN_WIDTH + 2 * KV_WIDTH + CONV_WIDTH,
                ATTN_WIDTH + 2 * KV_WIDTH + 2 * CONV_WIDTH)

kernel_name = "hymba_conv_axial_gqa_macaron_encoder"


def rms_norm(x, g):
    xf = x.astype(jnp.float32)
    y = xf * lax.rsqrt(jnp.mean(xf * xf, axis=-1, keepdims=True) + EPS)
    return (y * g.astype(jnp.float32)).astype(x.dtype)


def group_rms_norm(x, g, n_groups):
    b, l, w = x.shape
    xf = x.astype(jnp.float32).reshape(b, l, n_groups, w // n_groups)
    y = xf * lax.rsqrt(jnp.mean(xf * xf, axis=-1, keepdims=True) + EPS)
    return (y.reshape(b, l, w) * g.astype(jnp.float32)).astype(x.dtype)


def swiglu(x, w_gate, w_up, w_down):
    return (jax.nn.silu(x @ w_gate) * (x @ w_up)) @ w_down


def rope_tables(n_tokens):
    rows = n_tokens // GRID_W
    row = jnp.repeat(jnp.arange(rows, dtype=jnp.float32), GRID_W)
    col = jnp.tile(jnp.arange(GRID_W, dtype=jnp.float32), rows)
    row = jnp.concatenate([jnp.zeros((N_META,), jnp.float32), row])
    col = jnp.concatenate([jnp.zeros((N_META,), jnp.float32), col])
    freqs = ROPE_THETA ** (-jnp.arange(ROPE_PAIRS_AXIS, dtype=jnp.float32) / ROPE_PAIRS_AXIS)
    ang = jnp.concatenate([row[:, None] * freqs, col[:, None] * freqs], axis=-1)
    return jnp.cos(ang), jnp.sin(ang)


def apply_rope(x, cos, sin):
    b, l, h, d = x.shape
    xf = x.astype(jnp.float32).reshape(b, l, h, d // 2, 2)
    x0, x1 = xf[..., 0], xf[..., 1]
    c = cos[None, :, None, :]
    s = sin[None, :, None, :]
    out = jnp.stack([x0 * c - x1 * s, x0 * s + x1 * c], axis=-1)
    return out.reshape(b, l, h, d).astype(x.dtype)


def attend(qb, k, v):
    s = jnp.einsum("bqhgd,bkhd->bhgqk", qb, k, preferred_element_type=jnp.float32)
    p = jax.nn.softmax(s * (HEAD_DIM ** -0.5), axis=-1).astype(v.dtype)
    return jnp.einsum("bhgqk,bkhd->bqhgd", p, v)


def attention_group(a_q, a_k, a_v, q_gain, k_gain, cos, sin):
    b, l, _ = a_q.shape
    q = rms_norm(a_q.reshape(b, l, N_Q_HEADS, HEAD_DIM), q_gain)
    k = rms_norm(a_k.reshape(b, l, N_KV_HEADS, HEAD_DIM), k_gain)
    v = a_v.reshape(b, l, N_KV_HEADS, HEAD_DIM)
    q = apply_rope(q, cos, sin).reshape(b, l, N_KV_HEADS, KV_GROUP, HEAD_DIM)
    k = apply_rope(k, cos, sin)
    o_meta = attend(q[:, :N_META], k, v).reshape(b, N_META, ATTN_WIDTH)
    n = l - N_META
    n_blk = n // Q_BLOCK
    q_blocks = q[:, N_META:].reshape(b, n_blk, Q_BLOCK, N_KV_HEADS, KV_GROUP, HEAD_DIM)
    q_blocks = jnp.moveaxis(q_blocks, 1, 0)
    o = lax.map(lambda qb: attend(qb, k, v), q_blocks)
    o = jnp.moveaxis(o, 0, 1).reshape(b, n, ATTN_WIDTH)
    return jnp.concatenate([o_meta, o], axis=1)


def conv_group(c_b, c_c, c_h, w, bias):
    u = c_c * c_h
    up = jnp.pad(u, ((0, 0), (1, 1), (0, 0)))
    y = up[:, :-2] * w[0] + up[:, 1:-1] * w[1] + up[:, 2:] * w[2] + bias
    return c_b * y


def trunk(x, meta_tokens, ffn1_norm, ffn1_w_gate, ffn1_w_up, ffn1_w_down, mix_norm, w_in,
          q_norm, k_norm, conv_w, conv_b, attn_out_norm, conv_out_norm, w_out,
          ffn2_norm, ffn2_w_gate, ffn2_w_up, ffn2_w_down, final_norm):
    b, n, d = x.shape
    meta = jnp.broadcast_to(meta_tokens[None].astype(x.dtype), (b, N_META, d))
    h = jnp.concatenate([meta, x], axis=1)
    cos, sin = rope_tables(n)
    for l in range(DEPTH):
        h = h + 0.5 * swiglu(rms_norm(h, ffn1_norm[l]), ffn1_w_gate[l], ffn1_w_up[l], ffn1_w_down[l])
        u = rms_norm(h, mix_norm[l]) @ w_in[l]
        a_q, a_k, a_v, c_b, c_c, c_h = jnp.split(u, SPLIT_POINTS, axis=-1)
        y_att = attention_group(a_q, a_k, a_v, q_norm[l], k_norm[l], cos, sin)
        y_conv = conv_group(c_b, c_c, c_h, conv_w[l], conv_b[l])
        y_att = group_rms_norm(y_att, attn_out_norm[l], N_Q_HEADS)
        y_conv = group_rms_norm(y_conv, conv_out_norm[l], CONV_GROUPS)
        h = h + jnp.concatenate([y_att, y_conv], axis=-1) @ w_out[l]
        h = h + 0.5 * swiglu(rms_norm(h, ffn2_norm[l]), ffn2_w_gate[l], ffn2_w_up[l], ffn2_w_down[l])
    return rms_norm(h[:, N_META:], final_norm)


def setup_inputs(seed: int = 0) -> dict:
    key = jax.random.key(seed)
    ks = jax.random.split(key, 24)
    f32 = jnp.float32

    def nrm(k, shape, scale):
        return jax.random.normal(k, shape, f32) * scale

    def gain(k, shape):
        return 1.0 + 0.01 * jax.random.normal(k, shape, f32)

    return {
        "x_prompt": nrm(ks[0], (BATCH, SEQ, D_MODEL), 1.0),
        "x_sample": nrm(ks[1], (DEC_BATCH, DEC_SEQ, D_MODEL), 1.0),
        "meta_tokens": nrm(ks[2], (N_META, D_MODEL), 1.0),
        "ffn1_norm": gain(ks[3], (DEPTH, D_MODEL)),
        "ffn1_w_gate": nrm(ks[4], (DEPTH, D_MODEL, D_FF), D_MODEL ** -0.5),
        "ffn1_w_up": nrm(ks[5], (DEPTH, D_MODEL, D_FF), D_MODEL ** -0.5),
        "ffn1_w_down": nrm(ks[6], (DEPTH, D_FF, D_MODEL), D_FF ** -0.5),
        "mix_norm": gain(ks[7], (DEPTH, D_MODEL)),
        "w_in": nrm(ks[8], (DEPTH, D_MODEL, IN_WIDTH), D_MODEL ** -0.5),
        "q_norm": gain(ks[9], (DEPTH, HEAD_DIM)),
        "k_norm": gain(ks[10], (DEPTH, HEAD_DIM)),
        "conv_w": nrm(ks[11], (DEPTH, 3, CONV_WIDTH), 3 ** -0.5),
        "conv_b": nrm(ks[12], (DEPTH, CONV_WIDTH), 0.01),
        "attn_out_norm": gain(ks[13], (DEPTH, ATTN_WIDTH)),
        "conv_out_norm": gain(ks[14], (DEPTH, CONV_WIDTH)),
        "w_out": nrm(ks[15], (DEPTH, D_MODEL, D_MODEL), D_MODEL ** -0.5),
        "ffn2_norm": gain(ks[16], (DEPTH, D_MODEL)),
        "ffn2_w_gate": nrm(ks[17], (DEPTH, D_MODEL, D_FF), D_MODEL ** -0.5),
        "ffn2_w_up": nrm(ks[18], (DEPTH, D_MODEL, D_FF), D_MODEL ** -0.5),
        "ffn2_w_down": nrm(ks[19], (DEPTH, D_FF, D_MODEL), D_FF ** -0.5),
        "final_norm": gain(ks[20], (D_MODEL,)),
    }


def reference(x_prompt, x_sample, meta_tokens, ffn1_norm, ffn1_w_gate, ffn1_w_up, ffn1_w_down,
              mix_norm, w_in, q_norm, k_norm, conv_w, conv_b, attn_out_norm, conv_out_norm, w_out,
              ffn2_norm, ffn2_w_gate, ffn2_w_up, ffn2_w_down, final_norm):
    y_prompt = trunk(x_prompt, meta_tokens, ffn1_norm, ffn1_w_gate, ffn1_w_up, ffn1_w_down,
                     mix_norm, w_in, q_norm, k_norm, conv_w, conv_b, attn_out_norm, conv_out_norm,
                     w_out, ffn2_norm, ffn2_w_gate, ffn2_w_up, ffn2_w_down, final_norm)
    y_sample = trunk(x_sample, meta_tokens, ffn1_norm, ffn1_w_gate, ffn1_w_up, ffn1_w_down,
                     mix_norm, w_in, q_norm, k_norm, conv_w, conv_b, attn_out_norm, conv_out_norm,
                     w_out, ffn2_norm, ffn2_w_gate, ffn2_w_up, ffn2_w_down, final_norm)
    return (y_prompt, y_sample)
```

```cpp
#include <hip/hip_runtime.h>
#include <hip/hip_cooperative_groups.h>
#include <hip/hip_bf16.h>
#include <cstdio>
#include <cstdint>
#include <cmath>
namespace cg = cooperative_groups;
namespace pg8 {
#define PG8_LAS __attribute__((address_space(3)))
typedef unsigned short bf16_t;
typedef short bf16x8 __attribute__((ext_vector_type(8)));
typedef float f32x4 __attribute__((ext_vector_type(4)));
typedef unsigned u32x4 __attribute__((ext_vector_type(4)));
constexpr int BM = 256, BK = 64, HALF = 128, HTB = HALF * BK * 2  , STAGE_BYTES = 8 * HTB, NXCD = 8, WGM = 8;

__host__ __device__ __forceinline__ int lds_byte(int r, int c) { const int st = (r >> 4) * 2 + (c >> 5), rr = r & 15, cc = c & 31, ob = rr * 64 + cc * 2; return st * 1024 + (ob ^ (((ob >> 9) & 1) << 5)); }
__host__ __device__ __forceinline__ void stage_rc(int b, int& R, int& C) { const int st = b / 1024, sb = b % 1024, swz = sb ^ (((sb >> 9) & 1) << 5); R = (st >> 1) * 16 + swz / 64; C = (st & 1) * 32 + (swz % 64) / 2; }
__host__ __device__ __forceinline__ int perm32(int rho) { const int n = rho >> 4, i = rho & 15; return 8 * (i >> 2) + 4 * n + (i & 3); }

struct Unit { int pm, pn; };
struct Gemm { const bf16_t* A; const bf16_t* Bt; int M, N, K; };

struct StaticOrder {
    int nM, nN, nwg, G, c;
    __host__ __device__ void init(int M, int N, int G_, int c_) { nM = M / BM; nN = N / BM; nwg = nM * nN; G = G_; c = c_; }
    __host__ __device__ bool next(int i, Unit& u) const {
        const long L = (long)i * G + c; if (L >= nwg) return false;
        int wgid = (int)L; { const int q = nwg / NXCD, r = nwg % NXCD, xcd = wgid % NXCD, off = wgid / NXCD; wgid = (xcd < r ? xcd * (q + 1) : r * (q + 1) + (xcd - r) * q) + off; }
        const int nig = WGM * nN, gid = wgid / nig, fm = gid * WGM, gsz = (nM - fm) < WGM ? (nM - fm) : WGM;
        u.pm = fm + ((wgid % nig) % gsz); u.pn = (wgid % nig) / gsz; return true;
    }
    __device__ __forceinline__ void a_ready(const Unit&) const {}
    __device__ __forceinline__ void done(const Unit&) const {}
};

__device__ __forceinline__ unsigned cvt_pk_bf16(float lo, float hi) { unsigned r; asm volatile("v_cvt_pk_bf16_f32 %0, %1, %2" : "=v"(r) : "v"(lo), "v"(hi)); return r; }
constexpr float RMS_EPS = 1e-6f;
__device__ __forceinline__ float row_rstd(const float* stats, int row, int fq) {
    const f32x4 a = *(const f32x4*)(stats + (size_t)row * 16 + 4 * fq);
    float t = (a[0] + a[1]) + (a[2] + a[3]);
    t += __shfl_xor(t, 16); t += __shfl_xor(t, 32);
    return rsqrtf(t * (1.0f / 1024.0f) + RMS_EPS);
}
#define EPI_RS8(rsv) float rsv[8]; _Pragma("unroll") for (int ai_ = 0; ai_ < 2; ++ai_) _Pragma("unroll") for (int m_ = 0; m_ < 4; ++m_) rsv[ai_ * 4 + m_] = row_rstd(stats, row0 + ai_ * HALF + m_ * 16, fq); asm volatile("" ::: "memory")
#define EPI_FENCE() asm volatile("" ::: "memory")
__device__ __forceinline__ float silu_f(float x) { return x * __builtin_amdgcn_rcpf(1.0f + __builtin_amdgcn_exp2f(-1.4426950408889634f * x)); }
__device__ __forceinline__ u32x4 pack8(const f32x4 a, const f32x4 b) { u32x4 w; w.x = cvt_pk_bf16(a[0], a[1]); w.y = cvt_pk_bf16(a[2], a[3]); w.z = cvt_pk_bf16(b[0], b[1]); w.w = cvt_pk_bf16(b[2], b[3]); return w; }

struct EpiGateUp {
    static constexpr bool PERM = true, AFTER_DRAIN = false;
    bf16_t* O; const float* stats; int ldo;
    __device__ __forceinline__ void operator()(const f32x4 (&acc)[2][2][4][2], const Unit& u, int wr, int wc, int fr_in, int fq_in) const {
        int fr = fr_in, fq = fq_in; asm volatile("" : "+v"(fr), "+v"(fq));
        const int row0 = u.pm * BM + wr * 64 + fr, col0 = u.pn * 128 + wc * 32 + 8 * fq;
        EPI_RS8(rsv);
#pragma unroll
        for (int ai = 0; ai < 2; ++ai)
#pragma unroll
            for (int m = 0; m < 4; ++m) { const int row = row0 + ai * HALF + m * 16; const float rs = rsv[ai * 4 + m];
                f32x4 o0, o1;
#pragma unroll
                for (int e = 0; e < 4; ++e) { o0[e] = silu_f(acc[ai][0][m][0][e] * rs) * (acc[ai][1][m][0][e] * rs); o1[e] = silu_f(acc[ai][0][m][1][e] * rs) * (acc[ai][1][m][1][e] * rs); }
                *(u32x4*)(O + (size_t)row * ldo + col0) = pack8(o0, o1); EPI_FENCE(); }
    }
};
struct EpiResid {
    static constexpr bool PERM = true, AFTER_DRAIN = false;
    float* H; bf16_t* HB; float* stats; float scale;
    __device__ __forceinline__ void operator()(const f32x4 (&acc)[2][2][4][2], const Unit& u, int wr, int wc, int fr_in, int fq_in) const {
        int fr = fr_in, fq = fq_in; asm volatile("" : "+v"(fr), "+v"(fq));
        const int row0 = u.pm * BM + wr * 64 + fr, col0 = u.pn * BM + wc * 32 + 8 * fq;
#pragma unroll
        for (int ai = 0; ai < 2; ++ai)
#pragma unroll
            for (int m = 0; m < 4; ++m) { const int row = row0 + ai * HALF + m * 16; float ss = 0.f;
#pragma unroll
                for (int bj = 0; bj < 2; ++bj) { float* hp = H + (size_t)row * 1024 + col0 + bj * HALF;
                    f32x4 h0 = *(const f32x4*)hp, h1 = *(const f32x4*)(hp + 4);
                    h0 = h0 + acc[ai][bj][m][0] * scale; h1 = h1 + acc[ai][bj][m][1] * scale;
                    *(f32x4*)hp = h0; *(f32x4*)(hp + 4) = h1;
                    *(u32x4*)(HB + (size_t)row * 1024 + col0 + bj * HALF) = pack8(h0, h1);
                    ss += ((h0[0] * h0[0] + h0[1] * h0[1]) + (h0[2] * h0[2] + h0[3] * h0[3])) + ((h1[0] * h1[0] + h1[1] * h1[1]) + (h1[2] * h1[2] + h1[3] * h1[3])); }
                ss += __shfl_xor(ss, 16); ss += __shfl_xor(ss, 32);
                if (fq == 0) stats[(size_t)row * 16 + u.pn * 4 + wc] = ss; EPI_FENCE(); }
    }
};
__device__ __forceinline__ int kv_row(int row) {
    if (row < 16384) return row + 64 * (row >> 12);
    if (row < 81920) return row + 64 * (4 + ((row - 16384) >> 13));
    const int q = (row - 81920) >> 6, i = (row - 81920) & 63;
    return (q < 4 ? 4096 * q + 4096 : 16384 + 8192 * (q - 4) + 8192) + 64 * q + i;
}
struct EpiWin {
    static constexpr bool PERM = true, AFTER_DRAIN = false;
    bf16_t *Q, *K, *V, *CB, *U; const float* stats; const float* qg; const float* kg; const float* rope;
    __device__ __forceinline__ void operator()(const f32x4 (&acc)[2][2][4][2], const Unit& u, int wr, int wc, int fr_in, int fq_in) const {
        int fr = fr_in, fq = fq_in; asm volatile("" : "+v"(fr), "+v"(fq));
        const int row0 = u.pm * BM + wr * 64 + fr, pn = u.pn;
        if (pn >= 5) {
            const int col0 = (pn - 5) * 128 + wc * 32 + 8 * fq;
#pragma unroll
            for (int ai = 0; ai < 2; ++ai)
#pragma unroll
                for (int m = 0; m < 4; ++m) { const int row = row0 + ai * HALF + m * 16; const float rs = row_rstd(stats, row, fq), rs2 = rs * rs;
                    const f32x4 o0 = acc[ai][0][m][0] * acc[ai][1][m][0] * rs2, o1 = acc[ai][0][m][1] * acc[ai][1][m][1] * rs2;
                    *(u32x4*)(U + (size_t)row * 512 + col0) = pack8(o0, o1); EPI_FENCE(); }
            return;
        }
        const int hd = 4 * pn + wc;
        const bool is_q = hd < 8, is_k = (hd >= 8 && hd < 10);
        bf16_t* dst; int ldd, cb;
        if (is_q) { dst = Q; ldd = 512; cb = hd * 64; } else if (is_k) { dst = K; ldd = 128; cb = (hd - 8) * 64; }
        else if (hd < 12) { dst = V; ldd = 128; cb = (hd - 10) * 64; } else { dst = CB; ldd = 512; cb = (hd - 12) * 64; }
        cb += 8 * fq;
        if (is_q || is_k) {
            const float* gp = (is_q ? qg : kg) + 8 * fq;
            const float osc = is_q ? (0.125f * 1.4426950408889634f) : 1.0f;
#pragma unroll
            for (int ai = 0; ai < 2; ++ai)
#pragma unroll
                for (int m = 0; m < 4; ++m) { const int row = row0 + ai * HALF + m * 16; const float rs = row_rstd(stats, row, fq);
                    f32x4 v00 = acc[ai][0][m][0] * rs, v01 = acc[ai][0][m][1] * rs, v10 = acc[ai][1][m][0] * rs, v11 = acc[ai][1][m][1] * rs;
                    float ss = ((v00[0] * v00[0] + v00[1] * v00[1]) + (v00[2] * v00[2] + v00[3] * v00[3])) + ((v01[0] * v01[0] + v01[1] * v01[1]) + (v01[2] * v01[2] + v01[3] * v01[3]))
                             + ((v10[0] * v10[0] + v10[1] * v10[1]) + (v10[2] * v10[2] + v10[3] * v10[3])) + ((v11[0] * v11[0] + v11[1] * v11[1]) + (v11[2] * v11[2] + v11[3] * v11[3]));
                    ss += __shfl_xor(ss, 16); ss += __shfl_xor(ss, 32);
                    const float rn = rsqrtf(ss * (1.0f / 64.0f) + RMS_EPS);
                    v00 = v00 * *(const f32x4*)gp * rn; v01 = v01 * *(const f32x4*)(gp + 4) * rn; v10 = v10 * *(const f32x4*)(gp + 32) * rn; v11 = v11 * *(const f32x4*)(gp + 36) * rn;
                    int rp = 0, cp = 0;
                    if (row < 81920) { const int nn = row & (row < 16384 ? 4095 : 8191); rp = nn >> 6; cp = nn & 63; }
                    const float* tr = rope + (size_t)rp * 32 + 8 * fq; const float* tc = rope + (size_t)cp * 32 + 8 * fq;
                    const f32x4 r0 = *(const f32x4*)tr, r1 = *(const f32x4*)(tr + 4), c0 = *(const f32x4*)tc, c1 = *(const f32x4*)(tc + 4);
                    f32x4 o00, o01, o10, o11;
                    o00[0] = v00[0] * r0[0] - v00[1] * r0[1]; o00[1] = v00[0] * r0[1] + v00[1] * r0[0]; o00[2] = v00[2] * r0[2] - v00[3] * r0[3]; o00[3] = v00[2] * r0[3] + v00[3] * r0[2];
                    o01[0] = v01[0] * r1[0] - v01[1] * r1[1]; o01[1] = v01[0] * r1[1] + v01[1] * r1[0]; o01[2] = v01[2] * r1[2] - v01[3] * r1[3]; o01[3] = v01[2] * r1[3] + v01[3] * r1[2];
                    o10[0] = v10[0] * c0[0] - v10[1] * c0[1]; o10[1] = v10[0] * c0[1] + v10[1] * c0[0]; o10[2] = v10[2] * c0[2] - v10[3] * c0[3]; o10[3] = v10[2] * c0[3] + v10[3] * c0[2];
                    o11[0] = v11[0] * c1[0] - v11[1] * c1[1]; o11[1] = v11[0] * c1[1] + v11[1] * c1[0]; o11[2] = v11[2] * c1[2] - v11[3] * c1[3]; o11[3] = v11[2] * c1[3] + v11[3] * c1[2];
                    bf16_t* dp = dst + (size_t)(is_k ? kv_row(row) : row) * ldd + cb;
                    *(u32x4*)dp = pack8(o00 * osc, o01 * osc); *(u32x4*)(dp + 32) = pack8(o10 * osc, o11 * osc); EPI_FENCE(); }
        } else {
#pragma unroll
            for (int ai = 0; ai < 2; ++ai)
#pragma unroll
                for (int m = 0; m < 4; ++m) { const int row = row0 + ai * HALF + m * 16; const float rs = row_rstd(stats, row, fq);
                    bf16_t* dp = dst + (size_t)(hd < 12 ? kv_row(row) : row) * ldd + cb;
                    *(u32x4*)dp = pack8(acc[ai][0][m][0] * rs, acc[ai][0][m][1] * rs); *(u32x4*)(dp + 32) = pack8(acc[ai][1][m][0] * rs, acc[ai][1][m][1] * rs); EPI_FENCE(); }
        }
    }
};

template <class Epi, class Sched, bool ALIGN_EPI = false, bool SP2 = false>
__device__ __forceinline__ void gemm_phase(PG8_LAS unsigned char* lds, const Gemm g, const Sched& S, const Epi& E) {
    int tid_ = threadIdx.x; asm volatile("" : "+v"(tid_));
    const int tid = tid_, wid = __builtin_amdgcn_readfirstlane(tid >> 6), lane = tid & 63, wr = wid >> 2, wc = wid & 3, fr = lane & 15, fq = lane >> 4;
    const int K = g.K, nt = K / BK;
    unsigned voffA[2], voffB[2];
#pragma unroll
    for (int i = 0; i < 2; ++i) { int R, C; stage_rc(tid * 16 + i * 8192, R, C); const int Rb = Epi::PERM ? ((R & ~31) + perm32(R & 31)) : R;
        voffA[i] = (unsigned)(R * K + C) * 2u; voffB[i] = (unsigned)(Rb * K + C) * 2u; }
    const size_t kstep = (size_t)(BK * 2);
    const size_t hstep = (size_t)HALF * K * 2;
    const size_t tstep = 2 * hstep;
    const unsigned ldsw = (unsigned)wid * 1024u;
    const int aoff = lds_byte(wr * 64 + fr, fq * 8), boff = lds_byte(wc * 32 + fr, fq * 8);
#define PG8_SA(b, h) (((b) * 2 + (h)) * HTB)
#define PG8_SB(b, h) ((4 + (b) * 2 + (h)) * HTB)
#define PG8_STAGE(bufoff, gbase, voff) do { _Pragma("unroll") for (int _i = 0; _i < 2; ++_i) \
        __builtin_amdgcn_global_load_lds((const unsigned*)((const char*)(gbase) + (voff)[_i]), (PG8_LAS unsigned*)(lds + (bufoff) + ldsw + _i * 8192), 16, 0, 0); } while (0)
#define PG8_LDA(dst, b, h) do { _Pragma("unroll") for (int m = 0; m < 4; ++m) _Pragma("unroll") for (int k = 0; k < 2; ++k) dst[m][k] = *(const PG8_LAS bf16x8*)(lds + PG8_SA(b, h) + aoff + m * 2048 + k * 1024); } while (0)
#define PG8_LDB(dst, b, h) do { _Pragma("unroll") for (int n = 0; n < 2; ++n) _Pragma("unroll") for (int k = 0; k < 2; ++k) dst[n][k] = *(const PG8_LAS bf16x8*)(lds + PG8_SB(b, h) + boff + n * 2048 + k * 1024); } while (0)
#define PG8_MMA(ai, bj, At, Bt) do { __builtin_amdgcn_s_setprio(1); _Pragma("unroll") for (int m = 0; m < 4; ++m) _Pragma("unroll") for (int n = 0; n < 2; ++n) _Pragma("unroll") for (int k = 0; k < 2; ++k) \
        acc[ai][bj][m][n] = __builtin_amdgcn_mfma_f32_16x16x32_bf16(Bt[n][k], At[m][k], acc[ai][bj][m][n], 0, 0, 0); __builtin_amdgcn_s_setprio(0); } while (0)
#define PG8_WAIT_V(n) asm volatile("s_waitcnt vmcnt(" #n ")" ::: "memory")
#define PG8_WAIT_L(n) asm volatile("s_waitcnt lgkmcnt(" #n ")" ::: "memory")
#define PG8_BAR __builtin_amdgcn_s_barrier()
#define PG8_SCHED __builtin_amdgcn_sched_barrier(0)
    Unit cur, nxt; int ui = 0;
    if (!S.next(0, cur)) return;
    f32x4 acc[2][2][4][2];
#pragma unroll
    for (int a = 0; a < 2; ++a)
#pragma unroll
        for (int b = 0; b < 2; ++b)
#pragma unroll
            for (int m = 0; m < 4; ++m)
#pragma unroll
                for (int n = 0; n < 2; ++n) acc[a][b][m][n] = (f32x4){0.f, 0.f, 0.f, 0.f};
    bf16x8 At[4][2], B0[2][2], B1[2][2];
    const char* cA = (const char*)g.A + (size_t)cur.pm * tstep; const char* cB = (const char*)g.Bt + (size_t)cur.pn * tstep;
    S.a_ready(cur);
    if constexpr (SP2) {
        PG8_STAGE(PG8_SB(0, 0), cB, voffB); PG8_STAGE(PG8_SB(0, 1), cB + hstep, voffB); PG8_STAGE(PG8_SA(0, 0), cA, voffA); PG8_STAGE(PG8_SA(0, 1), cA + hstep, voffA);
        if (wr == 1) PG8_BAR;
        PG8_WAIT_V(2); PG8_BAR;
        PG8_STAGE(PG8_SB(1, 0), cB + kstep, voffB); PG8_STAGE(PG8_SA(1, 0), cA + kstep, voffA); PG8_STAGE(PG8_SB(1, 1), cB + hstep + kstep, voffB);
        PG8_WAIT_V(6); PG8_BAR;
    } else {
        PG8_STAGE(PG8_SB(0, 0), cB, voffB); PG8_STAGE(PG8_SA(0, 0), cA, voffA); PG8_STAGE(PG8_SB(0, 1), cB + hstep, voffB); PG8_STAGE(PG8_SA(0, 1), cA + hstep, voffA);
        if (wr == 1) PG8_BAR;
        PG8_WAIT_V(4); PG8_BAR;
        PG8_STAGE(PG8_SB(1, 0), cB + kstep, voffB); PG8_STAGE(PG8_SA(1, 0), cA + kstep, voffA); PG8_STAGE(PG8_SB(1, 1), cB + hstep + kstep, voffB);
        PG8_WAIT_V(6); PG8_BAR;
    }
    for (;;) {
        const bool has_next = S.next(ui + 1, nxt);
        const char* nA = has_next ? (const char*)g.A + (size_t)nxt.pm * tstep : cA; const char* nB = has_next ? (const char*)g.Bt + (size_t)nxt.pn * tstep : cB;
        for (int t = 0; t < nt; t += 2) {
            const bool last = (t == nt - 2);
            const char* a1 = cA + (size_t)(t + 1) * kstep;
            const char* a2 = last ? nA : cA + (size_t)(t + 2) * kstep; const char* b2 = last ? nB : cB + (size_t)(t + 2) * kstep;
            const char* a3 = a2 + kstep; const char* b3 = b2 + kstep;
            if (last && has_next) S.a_ready(nxt);
            if constexpr (SP2) {
            PG8_LDB(B0, 0, 0); PG8_LDB(B1, 0, 1); PG8_SCHED; PG8_LDA(At, 0, 0); PG8_STAGE(PG8_SA(1, 1), a1 + hstep, voffA);
            PG8_WAIT_V(8); PG8_WAIT_L(0); PG8_BAR; PG8_MMA(0, 0, At, B0); PG8_MMA(0, 1, At, B1); PG8_BAR; PG8_SCHED;
            PG8_LDA(At, 0, 1); PG8_STAGE(PG8_SB(0, 0), b2, voffB); PG8_STAGE(PG8_SB(0, 1), b2 + hstep, voffB); PG8_STAGE(PG8_SA(0, 0), a2, voffA);
            PG8_WAIT_V(8); PG8_WAIT_L(0); PG8_BAR; PG8_MMA(1, 0, At, B0); PG8_MMA(1, 1, At, B1); PG8_BAR; PG8_SCHED;
            PG8_LDB(B0, 1, 0); PG8_LDB(B1, 1, 1); PG8_SCHED; PG8_LDA(At, 1, 0); PG8_STAGE(PG8_SA(0, 1), a2 + hstep, voffA);
            PG8_WAIT_V(8); PG8_WAIT_L(0); PG8_BAR; PG8_MMA(0, 0, At, B0); PG8_MMA(0, 1, At, B1); PG8_BAR; PG8_SCHED;
            PG8_LDA(At, 1, 1); PG8_STAGE(PG8_SB(1, 0), b3, voffB); PG8_STAGE(PG8_SB(1, 1), b3 + hstep, voffB); PG8_STAGE(PG8_SA(1, 0), a3, voffA);
            PG8_WAIT_V(8); PG8_WAIT_L(0); PG8_BAR; PG8_MMA(1, 0, At, B0); PG8_MMA(1, 1, At, B1); PG8_BAR; PG8_SCHED;
            } else {
            PG8_LDB(B0, 0, 0); PG8_SCHED; PG8_LDA(At, 0, 0); PG8_STAGE(PG8_SA(1, 1), a1 + hstep, voffA);
            PG8_WAIT_L(8); PG8_BAR; PG8_WAIT_L(0); PG8_MMA(0, 0, At, B0); PG8_BAR; PG8_SCHED;
            PG8_LDB(B1, 0, 1); PG8_STAGE(PG8_SB(0, 0), b2, voffB);
            PG8_BAR; PG8_WAIT_L(0); PG8_MMA(0, 1, At, B1); PG8_BAR;
            PG8_LDA(At, 0, 1); PG8_STAGE(PG8_SA(0, 0), a2, voffA);
            PG8_BAR; PG8_WAIT_L(0); PG8_MMA(1, 0, At, B0); PG8_BAR; PG8_SCHED;
            PG8_STAGE(PG8_SB(0, 1), b2 + hstep, voffB);
            PG8_WAIT_V(6); PG8_BAR; PG8_MMA(1, 1, At, B1); PG8_BAR;
            PG8_LDB(B0, 1, 0); PG8_SCHED; PG8_LDA(At, 1, 0); PG8_STAGE(PG8_SA(0, 1), a2 + hstep, voffA);
            PG8_WAIT_L(8); PG8_BAR; PG8_WAIT_L(0); PG8_MMA(0, 0, At, B0); PG8_BAR; PG8_SCHED;
            PG8_LDB(B1, 1, 1); PG8_STAGE(PG8_SB(1, 0), b3, voffB);
            PG8_BAR; PG8_WAIT_L(0); PG8_MMA(0, 1, At, B1); PG8_BAR;
            PG8_LDA(At, 1, 1); PG8_STAGE(PG8_SA(1, 0), a3, voffA);
            PG8_BAR; PG8_WAIT_L(0); PG8_MMA(1, 0, At, B0); PG8_BAR; PG8_SCHED;
            PG8_STAGE(PG8_SB(1, 1), b3 + hstep, voffB);
            PG8_WAIT_V(6); PG8_BAR; PG8_MMA(1, 1, At, B1); PG8_BAR;
            }
        }
        if constexpr (ALIGN_EPI) { if (wr == 0) PG8_BAR; }
        if constexpr (!Epi::AFTER_DRAIN) { E(acc, cur, wr, wc, fr, fq); S.done(cur); }
        if (!has_next) break;
#pragma unroll
        for (int a = 0; a < 2; ++a)
#pragma unroll
            for (int b = 0; b < 2; ++b)
#pragma unroll
                for (int m = 0; m < 4; ++m)
#pragma unroll
                    for (int n = 0; n < 2; ++n) acc[a][b][m][n] = (f32x4){0.f, 0.f, 0.f, 0.f};
        cur = nxt; cA = nA; cB = nB; ++ui;
        if constexpr (ALIGN_EPI) { if (wr == 1) PG8_BAR; }
    }
    PG8_WAIT_V(0);
    if constexpr (!ALIGN_EPI) { if (wr == 0) PG8_BAR; }
    PG8_BAR;
    if constexpr (Epi::AFTER_DRAIN) { E.fused(acc, cur, wr, wc, fr, fq, lds, wid, lane); S.done(cur); }
#undef PG8_SA
#undef PG8_SB
#undef PG8_STAGE
#undef PG8_LDA
#undef PG8_LDB
#undef PG8_MMA
#undef PG8_WAIT_V
#undef PG8_WAIT_L
#undef PG8_BAR
#undef PG8_SCHED
}
}

namespace attn_body {
using bf16=__hip_bfloat16;
using bf16x8=__attribute__((ext_vector_type(8)))short;
using s16x4=__attribute__((ext_vector_type(4)))short;
using f32x16=__attribute__((ext_vector_type(16)))float;
using u32x4=__attribute__((ext_vector_type(4)))unsigned;
constexpr int D=64,QP=512,KP=128,OP=1024;
typedef float f32x4 __attribute__((ext_vector_type(4)));
constexpr int NW=8,QBLK=32,QB=QBLK*NW,KVBLK=64;
__device__ __forceinline__ int crow(int r,int hi){return (r&3)+8*(r>>2)+4*hi;}
#define SBAR() __builtin_amdgcn_sched_barrier(0)
#define ATTN_STORE16(p,v) (*(u32x4*)(p)=(v))
__device__ __forceinline__ void mmask(f32x16&p0,f32x16&p1,bool any,bool all){
  const float NEG=-INFINITY;
  #pragma unroll
  for(int r=0;r<16;++r){p1[r]=any?NEG:p1[r]; p0[r]=((r>=8)?any:all)?NEG:p0[r];}
}
constexpr int NSLOT=3, SLOTB=8192;
constexpr int LDS_K=0, LDS_V=NSLOT*SLOTB, LDS_WS=2*NSLOT*SLOTB, LDS_OST=LDS_WS+NW*64*4, LDS_BYTES=LDS_OST+NW*4096;
constexpr float C2=0.125f*1.4426950408889634f;
__device__ __forceinline__ void glds16(const void*gsrc,unsigned lds_dst){unsigned keep;
  asm volatile("s_mov_b32 %0, m0\n\ts_mov_b32 m0, %2\n\ts_nop 0\n\tglobal_load_lds_dwordx4 %1, off\n\ts_mov_b32 m0, %0":"=&s"(keep):"v"(gsrc),"s"(lds_dst):"memory");}
__device__ __forceinline__ float max3f(float a,float b,float c){float r;asm("v_max3_f32 %0, %1, %2, %3":"=v"(r):"v"(a),"v"(b),"v"(c));return r;}
__device__ __forceinline__ float max2f(float a,float b){float r;asm("v_max_f32_e32 %0, %1, %2":"=v"(r):"v"(a),"v"(b));return r;}
__device__ __forceinline__ float fadd_s(float a,float b){float r;asm("v_add_f32_e32 %0, %1, %2":"=v"(r):"v"(a),"v"(b));return r;}
__device__ __forceinline__ float fsub_s(float a,float b){float r;asm("v_sub_f32_e32 %0, %1, %2":"=v"(r):"v"(a),"v"(b));return r;}
typedef float f32x2_t __attribute__((ext_vector_type(2))); typedef __bf16 bf16x2_t __attribute__((ext_vector_type(2)));
__device__ __forceinline__ unsigned cvtpk_s(float lo,float hi){f32x2_t v={lo,hi};bf16x2_t b=__builtin_convertvector(v,bf16x2_t);return __builtin_bit_cast(unsigned,b);}
#define WAIT_BAR(N) asm volatile("s_waitcnt vmcnt(" #N ") lgkmcnt(0)\n\ts_barrier":::"memory")

__device__ __forceinline__ void qkt(f32x16&p0,f32x16&p1,const char*Kslot,const bf16x8*qr,const f32x16&negm,int r32,int hi){
  const char*kb=Kslot+hi*1024+r32*16;
  #pragma unroll
  for(int d0=0;d0<4;++d0){
    const bf16x8 b0=*reinterpret_cast<const bf16x8*>(kb+d0*2048);
    const bf16x8 b1=*reinterpret_cast<const bf16x8*>(kb+d0*2048+512);
    if(d0==0){p0=__builtin_amdgcn_mfma_f32_32x32x16_bf16(b0,qr[0],negm,0,0,0);p1=__builtin_amdgcn_mfma_f32_32x32x16_bf16(b1,qr[0],negm,0,0,0);}
    else{p0=__builtin_amdgcn_mfma_f32_32x32x16_bf16(b0,qr[d0],p0,0,0,0);p1=__builtin_amdgcn_mfma_f32_32x32x16_bf16(b1,qr[d0],p1,0,0,0);}}
}
typedef __attribute__((address_space(3))) const char* lds_cptr;
typedef short v4i16_t __attribute__((ext_vector_type(4)));
__device__ __forceinline__ void kload8(bf16x8*kf,lds_cptr kp){
  kf[0]=*(const __attribute__((address_space(3))) bf16x8*)(kp);      kf[1]=*(const __attribute__((address_space(3))) bf16x8*)(kp+512);
  kf[2]=*(const __attribute__((address_space(3))) bf16x8*)(kp+2048); kf[3]=*(const __attribute__((address_space(3))) bf16x8*)(kp+2560);
  kf[4]=*(const __attribute__((address_space(3))) bf16x8*)(kp+4096); kf[5]=*(const __attribute__((address_space(3))) bf16x8*)(kp+4608);
  kf[6]=*(const __attribute__((address_space(3))) bf16x8*)(kp+6144); kf[7]=*(const __attribute__((address_space(3))) bf16x8*)(kp+6656);
}
__device__ __forceinline__ void kload2(bf16x8*kf,lds_cptr kp,int j){ kf[2*j]=*(const __attribute__((address_space(3))) bf16x8*)(kp+j*2048); kf[2*j+1]=*(const __attribute__((address_space(3))) bf16x8*)(kp+j*2048+512); }
__device__ __forceinline__ s16x4 vtr(lds_cptr p){ return __builtin_bit_cast(s16x4,__builtin_amdgcn_ds_read_tr16_b64_v4i16((__attribute__((address_space(3))) v4i16_t*)p)); }
__device__ __forceinline__ float rowmax(const f32x16&p0,const f32x16&p1){
  float a=max3f(p0[0],p0[1],p1[0]),b=max3f(p0[2],p0[3],p1[1]);a=max3f(a,p1[2],p1[3]);
  #pragma unroll
  for(int r=4;r<16;r+=4){a=max3f(a,p0[r],p0[r+1]);b=max3f(b,p0[r+2],p0[r+3]);a=max3f(a,p1[r],p1[r+1]);b=max3f(b,p1[r+2],p1[r+3]);}
  const float m=max2f(a,b);
  auto rr=__builtin_amdgcn_permlane32_swap(__float_as_uint(m),__float_as_uint(m),false,false);
  return max2f(__uint_as_float(rr[0]),__uint_as_float(rr[1]));
}
__device__ __forceinline__ void pv(f32x16*o,int vb,bf16x8 pa0,bf16x8 pa1,bf16x8 pa2,bf16x8 pa3){
  #pragma unroll
  for(int d0=0;d0<2;++d0){s16x4 lo[4],hi[4];
    #pragma unroll
    for(int ks=0;ks<4;++ks){
      asm volatile("ds_read_b64_tr_b16 %0,%1 offset:%c2":"=&v"(lo[ks]):"v"(vb),"i"(d0*4096+ks*1024):"memory");
      asm volatile("ds_read_b64_tr_b16 %0,%1 offset:%c2":"=&v"(hi[ks]):"v"(vb),"i"(d0*4096+ks*1024+512):"memory");}
    asm volatile("s_waitcnt lgkmcnt(0)":::"memory");SBAR();
    #define PK(k) (bf16x8){lo[k][0],lo[k][1],lo[k][2],lo[k][3],hi[k][0],hi[k][1],hi[k][2],hi[k][3]}
    o[d0]=__builtin_amdgcn_mfma_f32_32x32x16_bf16(pa0,PK(0),o[d0],0,0,0);
    o[d0]=__builtin_amdgcn_mfma_f32_32x32x16_bf16(pa1,PK(1),o[d0],0,0,0);
    o[d0]=__builtin_amdgcn_mfma_f32_32x32x16_bf16(pa2,PK(2),o[d0],0,0,0);
    o[d0]=__builtin_amdgcn_mfma_f32_32x32x16_bf16(pa3,PK(3),o[d0],0,0,0);
    #undef PK
  }
}

template<int THRL> __device__ __forceinline__ void attn_unit(long qrow0,int is_meta,long kvbase,int NR,long metarow,int h,const bf16*Q,const bf16*__restrict__ K,const bf16*__restrict__ V,bf16*O,char*shm){
  int tid_=threadIdx.x; asm volatile("":"+v"(tid_)); const int tid=tid_,lane=tid&63,r32=lane&31,hi=lane>>5; const int wid=__builtin_amdgcn_readfirstlane(tid>>6);
  const long qrow_l=is_meta?(metarow+(long)((wid*QBLK+r32)&63)):(qrow0+wid*QBLK+r32);
  const bf16*Qw=Q+qrow_l*QP+h*D;
  const bf16*Kh=K+(h>>2)*D,*Vh=V+(h>>2)*D;
  const unsigned lds0=(unsigned)(uintptr_t)shm;
  float*wsf=(float*)(shm+LDS_WS)+wid*64;
  const bf16*ksrc=Kh+(long)lane*KP+wid*8;
  const bf16*vsrc=Vh+(long)(16*(wid&3)+(lane>>2))*KP+(wid>>2)*32+(lane&3)*8;
  #define TROW(t) (kvbase+(long)(t)*KVBLK)
  const unsigned kdst=lds0+LDS_K+wid*1024, vdst=lds0+LDS_V+wid*1024;
  #define DMA_K(t,slot) glds16(ksrc+TROW(t)*KP,(unsigned)__builtin_amdgcn_readfirstlane(kdst+(slot)))
  #define DMA_V(t,slot) glds16(vsrc+TROW(t)*KP,(unsigned)__builtin_amdgcn_readfirstlane(vdst+(slot)))
  const int vb0=(int)(lds0+LDS_V)+((lane>>4)&1)*32+(lane&3)*8+(4*hi+((lane&15)>>2))*64;
  const char*Kbase=shm+LDS_K; bf16x8 kf[8];
  const lds_cptr shm3=(lds_cptr)shm; const lds_cptr kp0=shm3+LDS_K+hi*1024+r32*16; const lds_cptr vp0=shm3+LDS_V+((lane>>4)&1)*32+(lane&3)*8+(4*hi+((lane&15)>>2))*64;
  const int NT=NR+2;
  DMA_K(0,0);DMA_V(0,0);DMA_K(1,SLOTB);
  bf16x8 qr[4];
  #pragma unroll
  for(int d0=0;d0<4;++d0)qr[d0]=*reinterpret_cast<const bf16x8*>(&Qw[d0*16+hi*8]);
  float mhat=0.f,l_reg=0.f;f32x16 o[2];o[0]=f32x16{};o[1]=f32x16{};f32x16 negm=f32x16{};asm volatile("":"+v"(negm));
  #define CMASK(P0,P1,t) do{ mmask(P0,P1,(t)>=NT-2,(t)==NT-1); }while(0)
  bool resc=false;
  #define START(P0,P1) do{ const float rm=rowmax(P0,P1); resc=false; \
    { const float dl=rm; mhat=fadd_s(mhat,dl); \
      _Pragma("unroll") for(int r=0;r<16;++r){P0[r]=fsub_s(P0[r],dl);P1[r]=fsub_s(P1[r],dl);} \
      _Pragma("unroll") for(int r=0;r<16;++r)negm[r]=-mhat; asm volatile("":"+v"(negm)); } \
    _Pragma("unroll") for(int r=0;r<16;++r)P0[r]=__builtin_amdgcn_exp2f(P0[r]); }while(0)
  #define RESC() do{ if(resc){ asm volatile("s_waitcnt lgkmcnt(0)":::"memory"); \
      _Pragma("unroll") for(int d_=0;d_<2;++d_) _Pragma("unroll") for(int r=0;r<16;++r)o[d_][r]*=wsf[crow(r,hi)]; } }while(0)
  f32x16 pA0,pA1,pB0,pB1;
  int sl_prev=0,sl_cur=0,sl_next=SLOTB;
  #define ROT() do{sl_prev=sl_cur;sl_cur=sl_next;sl_next=(sl_next==(NSLOT-1)*SLOTB)?0:sl_next+SLOTB;}while(0)
  DMA_K(2,2*SLOTB);
  WAIT_BAR(3);
  qkt(pA0,pA1,Kbase,qr,negm,r32,hi);asm volatile("s_nop 15\n\ts_nop 7":"+v"(pA0),"+v"(pA1));
  START(pA0,pA1);
  _Pragma("unroll") for(int r=0;r<16;++r)pA1[r]=__builtin_amdgcn_exp2f(pA1[r]);
  WAIT_BAR(0);
  DMA_K(3,0);DMA_V(1,SLOTB);
  ROT();
  kload8(kf,kp0+sl_cur);
  WAIT_BAR(2);
  s16x4 vlo[8],vhi[8]; u32x4 pw0,pw1,pw2,pw3;
  #define PKW(P,B) cvtpk_s(P[B],P[B+1])
  #define PAF(k) __builtin_bit_cast(bf16x8,pw##k)
  #define VFR(i) (bf16x8){vlo[i][0],vlo[i][1],vlo[i][2],vlo[i][3],vhi[i][0],vhi[i][1],vhi[i][2],vhi[i][3]}
  #define PIN(x) asm volatile("":"+v"(x))
  #define MX3(a,b,c) __builtin_fmaxf(__builtin_fmaxf((a),(b)),(c))
  #define GAPA(MF,A0,A1,A2,A3,W0,W1,PW) do{ MF; sacc+=A0; sacc+=A1; sacc+=A2; sacc+=A3; PIN(sacc); W0; W1; PIN(PW); SBAR(); }while(0)
  #define EX(v) __builtin_amdgcn_exp2f(v)
  #define GAPB(MF,X,B) do{ MF; X[B]=EX(X[B]); X[B+1]=EX(X[B+1]); X[B+2]=EX(X[B+2]); X[B+3]=EX(X[B+3]); PIN(X); SBAR(); }while(0)
  #define VRD(i) do{ vlo[i]=vtr(vp_+(((i)>>2)*4096+((i)&3)*1024)); vhi[i]=vtr(vp_+(((i)>>2)*4096+((i)&3)*1024+512)); }while(0)
  #define KRD(G,j) do{ if(G){ kload2(kf,kp0+sl_next,j); SBAR(); } }while(0)
  #define STEP(C0,C1,P0,P1,t,GK,GV,GL) do{ SBAR(); \
    const lds_cptr vp_=vp0+sl_prev; \
    VRD(0); SBAR(); float sacc=(P0[0]+P0[1]); \
    GAPA(C0=__builtin_amdgcn_mfma_f32_32x32x16_bf16(kf[0],qr[0],negm,0,0,0), P0[2],P0[3],P0[4],P0[5],     pw0[0]=PKW(P0,0), pw0[1]=PKW(P0,2), pw0); \
    VRD(4); SBAR(); GAPA(C1=__builtin_amdgcn_mfma_f32_32x32x16_bf16(kf[1],qr[0],negm,0,0,0), P0[6],P0[7],P0[8],P0[9],     pw0[2]=PKW(P0,4), pw0[3]=PKW(P0,6), pw0); \
    VRD(1); SBAR(); GAPA(C0=__builtin_amdgcn_mfma_f32_32x32x16_bf16(kf[2],qr[1],C0,0,0,0),   P0[10],P0[11],P0[12],P0[13], pw1[0]=PKW(P0,8), pw1[1]=PKW(P0,10), pw1); \
    VRD(5); SBAR(); GAPA(C1=__builtin_amdgcn_mfma_f32_32x32x16_bf16(kf[3],qr[1],C1,0,0,0),   P0[14],P0[15],P1[0],P1[1],   pw1[2]=PKW(P0,12),pw1[3]=PKW(P0,14), pw1); \
    VRD(2); SBAR(); GAPA(C0=__builtin_amdgcn_mfma_f32_32x32x16_bf16(kf[4],qr[2],C0,0,0,0),   P1[2],P1[3],P1[4],P1[5],     pw2[0]=PKW(P1,0), pw2[1]=PKW(P1,2), pw2); \
    VRD(6); SBAR(); GAPA(C1=__builtin_amdgcn_mfma_f32_32x32x16_bf16(kf[5],qr[2],C1,0,0,0),   P1[6],P1[7],P1[8],P1[9],     pw2[2]=PKW(P1,4), pw2[3]=PKW(P1,6), pw2); \
    VRD(3); SBAR(); GAPA(C0=__builtin_amdgcn_mfma_f32_32x32x16_bf16(kf[6],qr[3],C0,0,0,0),   P1[10],P1[11],P1[12],P1[13], pw3[0]=PKW(P1,8), pw3[1]=PKW(P1,10), pw3); \
    VRD(7); SBAR(); GAPA(C1=__builtin_amdgcn_mfma_f32_32x32x16_bf16(kf[7],qr[3],C1,0,0,0),   P1[14],P1[15],0.f,0.f,       pw3[2]=PKW(P1,12),pw3[3]=PKW(P1,14), pw3); \
    l_reg+=sacc; \
    if(GK){DMA_K((t)+3,sl_cur);} if(GV){DMA_V((t)+1,sl_next);} \
    CMASK(C0,C1,t); \
    { float a=MX3(C0[0],C0[1],C1[0]),b=MX3(C0[2],C0[3],C1[1]); a=MX3(a,C1[2],C1[3]); \
      _Pragma("unroll") for(int r=4;r<16;r+=4){a=MX3(a,C0[r],C0[r+1]);b=MX3(b,C0[r+2],C0[r+3]);a=MX3(a,C1[r],C1[r+1]);b=MX3(b,C1[r+2],C1[r+3]);} \
      float rm=__builtin_fmaxf(a,b); { auto rr=__builtin_amdgcn_permlane32_swap(__float_as_uint(rm),__float_as_uint(rm),false,false); rm=__builtin_fmaxf(__uint_as_float(rr[0]),__uint_as_float(rr[1])); } \
      resc=false; \
      if(__builtin_expect(__any(rm>(float)THRL),0)){ const float dl=__builtin_fmaxf(rm,0.f); mhat+=dl; \
        _Pragma("unroll") for(int r=0;r<16;++r){C0[r]-=dl;C1[r]-=dl;} \
        _Pragma("unroll") for(int r=0;r<16;++r)negm[r]=-mhat; asm volatile("":"+v"(negm)); \
        const float f=__builtin_amdgcn_exp2f(-dl); l_reg*=f; if(hi==0)wsf[r32]=f; resc=true; } } \
    SBAR(); \
    GAPB(o[0]=__builtin_amdgcn_mfma_f32_32x32x16_bf16(PAF(0),VFR(0),o[0],0,0,0), C0,0); \
    GAPB(o[1]=__builtin_amdgcn_mfma_f32_32x32x16_bf16(PAF(0),VFR(4),o[1],0,0,0), C0,4); \
    KRD(GL,0); GAPB(o[0]=__builtin_amdgcn_mfma_f32_32x32x16_bf16(PAF(1),VFR(1),o[0],0,0,0), C0,8); \
    KRD(GL,1); GAPB(o[1]=__builtin_amdgcn_mfma_f32_32x32x16_bf16(PAF(1),VFR(5),o[1],0,0,0), C0,12); \
    KRD(GL,2); GAPB(o[0]=__builtin_amdgcn_mfma_f32_32x32x16_bf16(PAF(2),VFR(2),o[0],0,0,0), C1,0); \
    KRD(GL,3); GAPB(o[1]=__builtin_amdgcn_mfma_f32_32x32x16_bf16(PAF(2),VFR(6),o[1],0,0,0), C1,4); \
    GAPB(o[0]=__builtin_amdgcn_mfma_f32_32x32x16_bf16(PAF(3),VFR(3),o[0],0,0,0), C1,8); \
    GAPB(o[1]=__builtin_amdgcn_mfma_f32_32x32x16_bf16(PAF(3),VFR(7),o[1],0,0,0), C1,12); \
    }while(0)
  int t=1;
  #undef CMASK
  #define CMASK(P0,P1,t) do{}while(0)
  for(;t+5<NT;t+=2){
    STEP(pB0,pB1,pA0,pA1,t,true,true,true);     WAIT_BAR(2); RESC(); ROT();
    STEP(pA0,pA1,pB0,pB1,t+1,true,true,true);   WAIT_BAR(2); RESC(); ROT();
  }
  #undef CMASK
  #define CMASK(P0,P1,t) do{ mmask(P0,P1,(t)>=NT-2,(t)==NT-1); }while(0)
  #define ENDW(tt) do{ if((tt)+3<NT){WAIT_BAR(2);} else if((tt)+2<NT){WAIT_BAR(1);} else {WAIT_BAR(0);} }while(0)
  for(;t+1<NT;t+=2){
    STEP(pB0,pB1,pA0,pA1,t,(t+3<NT),(t+1<NT),(t+1<NT));       ENDW(t);   RESC(); ROT();
    STEP(pA0,pA1,pB0,pB1,t+1,(t+4<NT),(t+2<NT),(t+2<NT));     ENDW(t+1); RESC(); ROT();
  }
  STEP(pB0,pB1,pA0,pA1,NT-1,false,false,false); RESC();
  { float sacc=pB0[0]+pB0[1]; _Pragma("unroll") for(int r=2;r<16;++r)sacc+=pB0[r]; _Pragma("unroll") for(int r=0;r<16;++r)sacc+=pB1[r]; l_reg+=sacc;
    pw0=(u32x4){PKW(pB0,0),PKW(pB0,2),PKW(pB0,4),PKW(pB0,6)};pw1=(u32x4){PKW(pB0,8),PKW(pB0,10),PKW(pB0,12),PKW(pB0,14)};pw2=(u32x4){PKW(pB1,0),PKW(pB1,2),PKW(pB1,4),PKW(pB1,6)};pw3=(u32x4){PKW(pB1,8),PKW(pB1,10),PKW(pB1,12),PKW(pB1,14)};
    SBAR(); pv(o,vb0+sl_cur,PAF(0),PAF(1),PAF(2),PAF(3)); }
  #undef PKW
  #undef PAF
  #undef VFR
  #undef PIN
  #undef MX3
  #undef GAPA
  #undef GAPB
  #undef EX
  #undef VRD
  #undef KRD
  #undef STEP
  #undef ENDW
  {auto rr=__builtin_amdgcn_permlane32_swap(__float_as_uint(l_reg),__float_as_uint(l_reg),false,false);l_reg=__uint_as_float(rr[0])+__uint_as_float(rr[1]);}
  if(hi==0)wsf[32+r32]=l_reg;asm volatile("s_waitcnt lgkmcnt(0)":::"memory");
  float rli[16];
  #pragma unroll
  for(int r=0;r<16;++r)rli[r]=__builtin_amdgcn_rcpf(wsf[32+crow(r,hi)]);
  { bf16*stg=(bf16*)(shm+LDS_OST)+wid*2048;
    #pragma unroll
    for(int r=0;r<16;++r){const int orow=crow(r,hi);
      #pragma unroll
      for(int d0=0;d0<2;++d0)stg[orow*64+d0*32+r32]=__float2bfloat16(o[d0][r]*rli[r]);}
    asm volatile("s_waitcnt lgkmcnt(0)":::"memory");
    #pragma unroll
    for(int i=0;i<4;++i){const int row=i*8+(lane>>3),ch=lane&7; const u32x4 w=*(const u32x4*)(stg+row*64+ch*8);
      float x[8];
      #pragma unroll
      for(int e=0;e<4;++e){x[2*e]=__uint_as_float(w[e]<<16); x[2*e+1]=__uint_as_float(w[e]&0xffff0000u);}
      float ss=((x[0]*x[0]+x[1]*x[1])+(x[2]*x[2]+x[3]*x[3]))+((x[4]*x[4]+x[5]*x[5])+(x[6]*x[6]+x[7]*x[7]));
      ss+=__shfl_xor(ss,1); ss+=__shfl_xor(ss,2); ss+=__shfl_xor(ss,4);
      const float rn=rsqrtf(ss*(1.0f/64.0f)+1e-6f);
      u32x4 v; v.x=cvtpk_s(x[0]*rn,x[1]*rn); v.y=cvtpk_s(x[2]*rn,x[3]*rn); v.z=cvtpk_s(x[4]*rn,x[5]*rn); v.w=cvtpk_s(x[6]*rn,x[7]*rn);
      const long orow_g=is_meta?(metarow+row):(qrow0+wid*QBLK+row);
      const bool ok=(!is_meta)||(wid==0&&row<16);
      if(ok) ATTN_STORE16(O+orow_g*OP+h*D+ch*8,v);} }
  asm volatile("s_waitcnt lgkmcnt(0)\n\ts_barrier":::"memory");
  #undef DMA_K
  #undef TROW
  #undef DMA_V
  #undef CMASK
  #undef START
  #undef RESC
  #undef ROT
}
constexpr int ATTN_LDS_BYTES=LDS_BYTES;
#undef SBAR
#undef WAIT_BAR
}

constexpr int NWAVES = 8;
constexpr int DM = 1024, DFF = 2816, NIN = 2304, DEPTH = 4;
constexpr int NREAL = 81920, MB = 81920, MP = 82688;
constexpr int NSEQ = 12;
constexpr size_t MiB = 1u << 20;
constexpr size_t WS_CTL = 0, WS_ROPE = 4096, WS_STATS = 32768, WS_W = 6 * MiB, WS_H = 165 * MiB, WS_BIG = 489 * MiB;
constexpr size_t WS_END = WS_BIG + (size_t)MP * 2816 * 2;
constexpr size_t W_GU = (size_t)2 * DFF * DM, W_D = (size_t)DM * DFF, W_IN = (size_t)NIN * DM, W_OUT = (size_t)DM * DM;
constexpr size_t WL_1GU = 0, WL_1D = WL_1GU + W_GU, WL_IN = WL_1D + W_D, WL_OUT = WL_IN + W_IN, WL_2GU = WL_OUT + W_OUT, WL_2D = WL_2GU + W_GU, WL_SZ = WL_2D + W_D;
static_assert(WS_STATS + (size_t)MP * 16 * 4 <= WS_W && WS_W + WL_SZ * 2 * DEPTH <= WS_H && WS_H + (size_t)MP * DM * 4 <= WS_BIG, "ws map");
constexpr int RING_BYTES = 131072, LDS_BYTES = 147456;
static_assert(attn_body::ATTN_LDS_BYTES <= RING_BYTES, "attention LDS");

#define LAS __attribute__((address_space(3)))
typedef unsigned short bf16;
typedef unsigned v4u __attribute__((ext_vector_type(4)));
typedef float f32x4 __attribute__((ext_vector_type(4)));
__device__ __forceinline__ unsigned f2bf(float f) { unsigned u = __builtin_bit_cast(unsigned, f); return (u + 0x7fffu + ((u >> 16) & 1u)) >> 16; }
__device__ __forceinline__ unsigned pk2(float lo, float hi) { return f2bf(lo) | (f2bf(hi) << 16); }
__device__ __forceinline__ float bflo(unsigned w) { return __builtin_bit_cast(float, w << 16); }
__device__ __forceinline__ float bfhi(unsigned w) { return __builtin_bit_cast(float, w & 0xffff0000u); }
__device__ __forceinline__ float wave_sum(float v) {
#pragma unroll
    for (int o = 1; o < 64; o <<= 1) v += __shfl_xor(v, o);
    return v;
}
__device__ __forceinline__ void tr_item(const float* W, int K, int N, const float* gain, bf16* WT, int drow0, LAS float* scr, int k0, int n0, int lane) {
#pragma unroll 8
    for (int i = 0; i < 32; ++i) { const int kk = 2 * i + (lane >> 5); const float g = gain ? gain[k0 + kk] : 1.0f; scr[kk * 33 + (lane & 31)] = g * W[(size_t)(k0 + kk) * N + n0 + (lane & 31)]; }
    asm volatile("s_waitcnt lgkmcnt(0)" ::: "memory");
    const int c = lane & 7;
#pragma unroll
    for (int j = 0; j < 4; ++j) { const int n = (lane >> 3) + 8 * j; const LAS float* s = scr + (8 * c) * 33 + n;
        v4u o; o.x = pk2(s[0 * 33], s[1 * 33]); o.y = pk2(s[2 * 33], s[3 * 33]); o.z = pk2(s[4 * 33], s[5 * 33]); o.w = pk2(s[6 * 33], s[7 * 33]);
        *(v4u*)(WT + (size_t)(drow0 + n) * K + k0 + 8 * c) = o; }
    asm volatile("s_waitcnt lgkmcnt(0)" ::: "memory");
}
__device__ __forceinline__ int win_drow(int n0) {
    if (n0 < 1280) { const int hd = n0 >> 6, bj = (n0 >> 5) & 1; return 256 * (hd >> 2) + 128 * bj + 32 * (hd & 3); }
    if (n0 < 1792) { const int t = (n0 - 1280) >> 7, w = (n0 - 1280) & 127; return 1280 + 256 * t + w; }
    { const int t = (n0 - 1792) >> 7, w = (n0 - 1792) & 127; return 1280 + 256 * t + 128 + w; }
}
__device__ __forceinline__ long seq_base(int q) { return q < 4 ? 4096L * q : 16384L + 8192L * (q - 4); }

struct Args { const float* in[21]; float* out; unsigned char* ws; };

__global__ void __launch_bounds__(NWAVES * 64, 2) hymba_fwd(Args args) {
    extern __shared__ __attribute__((aligned(16))) unsigned char lds[];
    cg::grid_group grid = cg::this_grid();
    const int tid = threadIdx.x, lane0 = tid & 63, wave = __builtin_amdgcn_readfirstlane(tid >> 6);
    const int G = gridDim.x, bx = blockIdx.x;
    const int gw = bx * NWAVES + wave, NGW = G * NWAVES;
    unsigned char* ws = args.ws;
    unsigned* ctl = (unsigned*)(ws + WS_CTL);
    float* rope = (float*)(ws + WS_ROPE);
    float* stats = (float*)(ws + WS_STATS);
    bf16* Wb = (bf16*)(ws + WS_W);
    float* H = (float*)(ws + WS_H);
    bf16* HB = (bf16*)args.out;
    bf16* BIG = (bf16*)(ws + WS_BIG);
    bf16* ACT = BIG;
    bf16* Qb = BIG; bf16* Kb = BIG + (size_t)MP * 512; bf16* Vb = BIG + (size_t)MP * 640; bf16* CBb = BIG + (size_t)MP * 768; bf16* Ub = BIG + (size_t)MP * 1280; bf16* Yb = BIG + (size_t)MP * 1792;
    LAS unsigned char* ldsp = (LAS unsigned char*)lds;
    const float* x_prompt = args.in[0]; const float* x_sample = args.in[1]; const float* meta = args.in[2];

    {
        const int lane = lane0;
        if (bx == 0 && tid < 64) ctl[tid] = 0u;
        { const int gt = bx * (NWAVES * 64) + tid;
          if (gt < 2048) { const int pos = gt >> 4, i = gt & 15; const double fr = exp2(-(double)i * (13.287712379549449 / 16.0)); double s, c; sincos((double)pos * fr, &s, &c); rope[2 * gt] = (float)c; rope[2 * gt + 1] = (float)s; } }
        LAS float* scr = (LAS float*)(ldsp + wave * 16384);
        constexpr int I_GU = 16 * 88, I_D = 44 * 32, I_IN = 16 * 72, I_OUT = 16 * 32, I_L = 4 * I_GU + 2 * I_D + I_IN + I_OUT;
        for (int it = gw; it < DEPTH * I_L; it += NGW) {
            const int l = it / I_L; int r = it % I_L; bf16* WL = Wb + (size_t)l * WL_SZ;
            if (r < 4 * I_GU) { const int which = r / I_GU; r %= I_GU; const int kb = r / 88, nb = r % 88, n0 = 32 * nb;
                const float* W = args.in[(which < 2 ? 4 : 17) + (which & 1)] + (size_t)l * DM * DFF; const float* gn = args.in[which < 2 ? 3 : 16] + l * DM;
                tr_item(W, DM, DFF, gn, WL + (which < 2 ? WL_1GU : WL_2GU), 256 * (n0 >> 7) + (n0 & 127) + ((which & 1) ? 128 : 0), scr, 64 * kb, n0, lane); continue; }
            r -= 4 * I_GU;
            if (r < 2 * I_D) { const int which = r / I_D; r %= I_D; const int kb = r / 32, nb = r % 32;
                tr_item(args.in[which ? 19 : 6] + (size_t)l * DFF * DM, DFF, DM, nullptr, WL + (which ? WL_2D : WL_1D), 32 * nb, scr, 64 * kb, 32 * nb, lane); continue; }
            r -= 2 * I_D;
            if (r < I_IN) { const int kb = r / 72, nb = r % 72;
                tr_item(args.in[8] + (size_t)l * DM * NIN, DM, NIN, args.in[7] + l * DM, WL + WL_IN, win_drow(32 * nb), scr, 64 * kb, 32 * nb, lane); continue; }
            r -= I_IN;
            { const int kb = r / 32, nb = r % 32; const int k0 = 64 * kb;
              const float* gn = (k0 < 512) ? (args.in[13] + l * 512 + 0) : (args.in[14] + l * 512 - 512);
              tr_item(args.in[15] + (size_t)l * DM * DM, DM, DM, gn, WL + WL_OUT, 32 * nb, scr, k0, 32 * nb, lane); }
        }
        for (int row = gw; row < MP; row += NGW) {
            const float* src = nullptr;
            if (row < 16384) src = x_prompt + (size_t)row * DM; else if (row < NREAL) src = x_sample + (size_t)(row - 16384) * DM;
            else { const int i = (row - MB) & 63; if (i < 16) src = meta + (size_t)i * DM; }
            f32x4 v[4]; float ss = 0.f;
#pragma unroll
            for (int j = 0; j < 4; ++j) { v[j] = src ? ((const f32x4*)src)[lane + 64 * j] : (f32x4){0.f, 0.f, 0.f, 0.f}; ss += (v[j][0] * v[j][0] + v[j][1] * v[j][1]) + (v[j][2] * v[j][2] + v[j][3] * v[j][3]); }
            ss = wave_sum(ss);
#pragma unroll
            for (int j = 0; j < 4; ++j) { ((f32x4*)(H + (size_t)row * DM))[lane + 64 * j] = v[j];
                ((unsigned long long*)(HB + (size_t)row * DM))[lane + 64 * j] = (unsigned long long)pk2(v[j][0], v[j][1]) | ((unsigned long long)pk2(v[j][2], v[j][3]) << 32); }
            if (lane < 16) stats[(size_t)row * 16 + lane] = (lane == 0) ? ss : 0.f;
        }
    }
    grid.sync();

    for (int l = 0; l < DEPTH; ++l) {
        const bf16* WL = Wb + (size_t)l * WL_SZ;
        for (int s = 0; s < 2; ++s) {
            if (s == 1) {
#ifndef NO_WIN
                { pg8::Gemm g{HB, WL + WL_IN, MP, NIN, DM}; pg8::StaticOrder S; S.init(MP, NIN, G, bx);
                  pg8::EpiWin E{Qb, Kb, Vb, CBb, Ub, stats, args.in[9] + l * 64, args.in[10] + l * 64, rope};
                  pg8::gemm_phase<pg8::EpiWin, pg8::StaticOrder, true, true>(ldsp, g, S, E); }
#endif

                grid.sync();
                {
                    int lane = lane0; asm volatile("" : "+v"(lane));
                    const float* cw = args.in[11] + (size_t)l * 3 * 512; const float* cbias = args.in[12] + (size_t)l * 512;
                    f32x4 w0[2], w1[2], w2[2], bb[2];
#pragma unroll
                    for (int j = 0; j < 2; ++j) { w0[j] = *(const f32x4*)(cw + 8 * lane + 4 * j); w1[j] = *(const f32x4*)(cw + 512 + 8 * lane + 4 * j); w2[j] = *(const f32x4*)(cw + 1024 + 8 * lane + 4 * j); bb[j] = *(const f32x4*)(cbias + 8 * lane + 4 * j); }
                    for (int row = gw; row < MP; row += NGW) {
                        long prev = -1, next = -1; bool valid = true;
                        if (row < NREAL) { const int q = row < 16384 ? (row >> 12) : 4 + ((row - 16384) >> 13); const int nlen = row < 16384 ? 4096 : 8192; const int n = row & (nlen - 1);
                            prev = (n == 0) ? (long)(MB + 64 * q + 15) : (long)row - 1; next = (n == nlen - 1) ? -1L : (long)row + 1; }
                        else { const int q = (row - MB) >> 6, i = (row - MB) & 63; valid = i < 16; prev = (i == 0) ? -1L : (long)row - 1; next = (i == 15) ? seq_base(q) : (long)row + 1; }
                        v4u* yo = (v4u*)(Yb + (size_t)row * 1024 + 512) + lane;
                        if (!valid) { *yo = (v4u){0u, 0u, 0u, 0u}; *((v4u*)(Yb + (size_t)row * 1024) + lane) = (v4u){0u, 0u, 0u, 0u}; continue; }
                        const v4u uc = *((const v4u*)(Ub + (size_t)row * 512) + lane);
                        const v4u up = prev >= 0 ? *((const v4u*)(Ub + (size_t)prev * 512) + lane) : (v4u){0u, 0u, 0u, 0u};
                        const v4u un = next >= 0 ? *((const v4u*)(Ub + (size_t)next * 512) + lane) : (v4u){0u, 0u, 0u, 0u};
                        const v4u cbv = *((const v4u*)(CBb + (size_t)row * 512) + lane);
                        float y[8]; float ss = 0.f;
#pragma unroll
                        for (int e = 0; e < 8; ++e) { const int wi = e >> 1; const bool hi_ = e & 1;
                            const float a = hi_ ? bfhi(up[wi]) : bflo(up[wi]), b = hi_ ? bfhi(uc[wi]) : bflo(uc[wi]), c = hi_ ? bfhi(un[wi]) : bflo(un[wi]), d = hi_ ? bfhi(cbv[wi]) : bflo(cbv[wi]);
                            const float t = a * w0[e >> 2][e & 3] + b * w1[e >> 2][e & 3] + c * w2[e >> 2][e & 3] + bb[e >> 2][e & 3];
                            y[e] = d * t; ss += y[e] * y[e]; }
                        ss += __shfl_xor(ss, 1); ss += __shfl_xor(ss, 2); ss += __shfl_xor(ss, 4);
                        const float rn = rsqrtf(ss * (1.0f / 64.0f) + 1e-6f);
                        v4u o; o.x = pk2(y[0] * rn, y[1] * rn); o.y = pk2(y[2] * rn, y[3] * rn); o.z = pk2(y[4] * rn, y[5] * rn); o.w = pk2(y[6] * rn, y[7] * rn);
                        *yo = o;
                    }
                    __syncthreads();
                    LAS volatile unsigned* qslot = (LAS volatile unsigned*)(ldsp + RING_BYTES);
                    constexpr int NU_S = 8 * 8 * 33, NU_P = 4 * 8 * 17, NU = NU_S + NU_P;
                    for (;;) {
                        if (tid == 0) qslot[0] = atomicAdd(ctl + l, 1u);
                        __syncthreads();
                        const int idx = __builtin_amdgcn_readfirstlane((int)qslot[0]);
                        if (idx >= NU) break;
                        int q, rem, nqb;
                        if (idx < NU_S) { q = 4 + idx / 264; rem = idx % 264; nqb = 32; } else { const int i2 = idx - NU_S; q = i2 / 136; rem = i2 % 136; nqb = 16; }
                        const int h = rem / (nqb + 1), b = rem % (nqb + 1);
                        const long sb = seq_base(q);
#ifndef NO_ATT
                        attn_body::attn_unit<8>(sb + 256L * b, b == nqb ? 1 : 0, sb + 64L * q, nqb * 4, (long)(MB + 64 * q), h,
                            (const attn_body::bf16*)Qb, (const attn_body::bf16*)Kb, (const attn_body::bf16*)Vb, (attn_body::bf16*)Yb, (char*)lds);
#endif

                    }
                }
                grid.sync();
#ifndef NO_WOUT
                { pg8::Gemm g{Yb, WL + WL_OUT, MP, DM, DM}; pg8::StaticOrder S; S.init(MP, DM, G, bx);
                  pg8::EpiResid E{H, HB, stats, 1.0f};
                  pg8::gemm_phase<pg8::EpiResid, pg8::StaticOrder, true, true>(ldsp, g, S, E); }
#endif

                grid.sync();
            }
#ifndef NO_GU
            { pg8::Gemm g{HB, WL + (s ? WL_2GU : WL_1GU), MP, 2 * DFF, DM}; pg8::StaticOrder S; S.init(MP, 2 * DFF, G, bx);
              pg8::EpiGateUp E{ACT, stats, DFF};
              pg8::gemm_phase<pg8::EpiGateUp, pg8::StaticOrder, true, true>(ldsp, g, S, E); }
#endif

            grid.sync();
#ifndef NO_DOWN
            { pg8::Gemm g{ACT, WL + (s ? WL_2D : WL_1D), MP, DM, DFF}; pg8::StaticOrder S; S.init(MP, DM, G, bx);
              pg8::EpiResid E{H, HB, stats, 0.5f};
              pg8::gemm_phase<pg8::EpiResid, pg8::StaticOrder, true, true>(ldsp, g, S, E); }
#endif

            grid.sync();
        }
    }
    {
        int lane = lane0; asm volatile("" : "+v"(lane));
        const float* fn = args.in[20]; f32x4 gnv[4];
#pragma unroll
        for (int j = 0; j < 4; ++j) gnv[j] = ((const f32x4*)fn)[lane + 64 * j];
        for (int row = gw; row < NREAL; row += NGW) {
            f32x4 v[4]; float ss = 0.f;
#pragma unroll
            for (int j = 0; j < 4; ++j) { v[j] = ((const f32x4*)(H + (size_t)row * DM))[lane + 64 * j]; ss += (v[j][0] * v[j][0] + v[j][1] * v[j][1]) + (v[j][2] * v[j][2] + v[j][3] * v[j][3]); }
            const float rs = rsqrtf(wave_sum(ss) * (1.0f / 1024.0f) + 1e-6f);
#pragma unroll
            for (int j = 0; j < 4; ++j) ((f32x4*)(args.out + (size_t)row * DM))[lane + 64 * j] = v[j] * rs * gnv[j];
        }
    }
}

extern "C" void kernel_launch(void* const* d_in, const int* in_sizes, int n_in, void* d_out, int out_size, void* d_ws, size_t ws_size, hipStream_t stream) {
    static int grid = 0;
    if (grid == 0) {
        if (n_in != 21 || out_size != NREAL * DM || ws_size < WS_END || in_sizes[8] != DEPTH * DM * NIN) {
            fprintf(stderr, "kernel_launch: unexpected shapes: n_in %d out %d ws %zu (need %zu) w_in %d\n", n_in, out_size, ws_size, (size_t)WS_END, n_in > 8 ? in_sizes[8] : -1); grid = -1; return; }
        int dev = 0, cus = 0, per_cu = 0;
        (void)hipGetDevice(&dev); (void)hipDeviceGetAttribute(&cus, hipDeviceAttributeMultiprocessorCount, dev);
        if (hipFuncSetAttribute((const void*)hymba_fwd, hipFuncAttributeMaxDynamicSharedMemorySize, LDS_BYTES) != hipSuccess) { fprintf(stderr, "kernel_launch: hipFuncSetAttribute failed\n"); grid = -1; return; }
        (void)hipOccupancyMaxActiveBlocksPerMultiprocessor(&per_cu, (const void*)hymba_fwd, NWAVES * 64, LDS_BYTES);
        if (per_cu < 1) { fprintf(stderr, "kernel_launch: occupancy query says %d blocks per CU\n", per_cu); per_cu = 1; }
        (void)hipGetLastError();
        grid = cus;
    }
    if (grid < 0) return;
    Args a{};
    for (int i = 0; i < 21; ++i) a.in[i] = (const float*)d_in[i];
    a.out = (float*)d_out; a.ws = (unsigned char*)d_ws;
    void* kargs[] = {&a};
    hipError_t e = hipLaunchCooperativeKernel((const void*)hymba_fwd, dim3(grid), dim3(NWAVES * 64), kargs, LDS_BYTES, stream);
    if (e != hipSuccess) fprintf(stderr, "cooperative launch failed: %s (grid %d)\n", hipGetErrorString(e), grid);
}
```

```cpp
#include <hip/hip_runtime.h>
#include <hip/hip_cooperative_groups.h>
#include <hip/hip_bf16.h>
#include <cstdio>
#include <cstdint>
#include <cmath>
namespace cg = cooperative_groups;
namespace pg8 {
#define PG8_LAS __attribute__((address_space(3)))
typedef unsigned short bf16_t;
typedef short bf16x8 __attribute__((ext_vector_type(8)));
typedef float f32x4 __attribute__((ext_vector_type(4)));
typedef unsigned u32x4 __attribute__((ext_vector_type(4)));
constexpr int BM = 256, BK = 64, HALF = 128, HTB = HALF * BK * 2  , STAGE_BYTES = 8 * HTB, NXCD = 8, WGM = 8;

__host__ __device__ __forceinline__ int lds_byte(int r, int c) { const int st = (r >> 4) * 2 + (c >> 5), rr = r & 15, cc = c & 31, ob = rr * 64 + cc * 2; return st * 1024 + (ob ^ (((ob >> 9) & 1) << 5)); }
__host__ __device__ __forceinline__ void stage_rc(int b, int& R, int& C) { const int st = b / 1024, sb = b % 1024, swz = sb ^ (((sb >> 9) & 1) << 5); R = (st >> 1) * 16 + swz / 64; C = (st & 1) * 32 + (swz % 64) / 2; }
__host__ __device__ __forceinline__ int perm32(int rho) { const int n = rho >> 4, i = rho & 15; return 8 * (i >> 2) + 4 * n + (i & 3); }

struct Unit { int pm, pn; };
struct Gemm { const bf16_t* A; const bf16_t* Bt; int M, N, K; };

struct StaticOrder {
    int nM, nN, nwg, G, c;
    __host__ __device__ void init(int M, int N, int G_, int c_) { nM = M / BM; nN = N / BM; nwg = nM * nN; G = G_; c = c_; }
    __host__ __device__ bool next(int i, Unit& u) const {
        const long L = (long)i * G + c; if (L >= nwg) return false;
        int wgid = (int)L; { const int q = nwg / NXCD, r = nwg % NXCD, xcd = wgid % NXCD, off = wgid / NXCD; wgid = (xcd < r ? xcd * (q + 1) : r * (q + 1) + (xcd - r) * q) + off; }
        const int nig = WGM * nN, gid = wgid / nig, fm = gid * WGM, gsz = (nM - fm) < WGM ? (nM - fm) : WGM;
        u.pm = fm + ((wgid % nig) % gsz); u.pn = (wgid % nig) / gsz; return true;
    }
    __device__ __forceinline__ void a_ready(const Unit&) const {}
    __device__ __forceinline__ void done(const Unit&) const {}
};

__device__ __forceinline__ unsigned cvt_pk_bf16(float lo, float hi) { unsigned r; asm volatile("v_cvt_pk_bf16_f32 %0, %1, %2" : "=v"(r) : "v"(lo), "v"(hi)); return r; }
constexpr float RMS_EPS = 1e-6f;
__device__ __forceinline__ float row_rstd(const float* stats, int row, int fq) {
    const f32x4 a = *(const f32x4*)(stats + (size_t)row * 16 + 4 * fq);
    float t = (a[0] + a[1]) + (a[2] + a[3]);
    t += __shfl_xor(t, 16); t += __shfl_xor(t, 32);
    return rsqrtf(t * (1.0f / 1024.0f) + RMS_EPS);
}
#define EPI_RS8(rsv) float rsv[8]; _Pragma("unroll") for (int ai_ = 0; ai_ < 2; ++ai_) _Pragma("unroll") for (int m_ = 0; m_ < 4; ++m_) rsv[ai_ * 4 + m_] = row_rstd(stats, row0 + ai_ * HALF + m_ * 16, fq); asm volatile("" ::: "memory")
#define EPI_FENCE() asm volatile("" ::: "memory")
__device__ __forceinline__ float silu_f(float x) { return x * __builtin_amdgcn_rcpf(1.0f + __builtin_amdgcn_exp2f(-1.4426950408889634f * x)); }
__device__ __forceinline__ u32x4 pack8(const f32x4 a, const f32x4 b) { u32x4 w; w.x = cvt_pk_bf16(a[0], a[1]); w.y = cvt_pk_bf16(a[2], a[3]); w.z = cvt_pk_bf16(b[0], b[1]); w.w = cvt_pk_bf16(b[2], b[3]); return w; }

struct EpiGateUp {
    static constexpr bool PERM = true, AFTER_DRAIN = false;
    bf16_t* O; const float* stats; int ldo;
    __device__ __forceinline__ void operator()(const f32x4 (&acc)[2][2][4][2], const Unit& u, int wr, int wc, int fr_in, int fq_in) const {
        int fr = fr_in, fq = fq_in; asm volatile("" : "+v"(fr), "+v"(fq));
        const int row0 = u.pm * BM + wr * 64 + fr, col0 = u.pn * 128 + wc * 32 + 8 * fq;
        EPI_RS8(rsv);
#pragma unroll
        for (int ai = 0; ai < 2; ++ai)
#pragma unroll
            for (int m = 0; m < 4; ++m) { const int row = row0 + ai * HALF + m * 16; const float rs = rsv[ai * 4 + m];
                f32x4 o0, o1;
#pragma unroll
                for (int e = 0; e < 4; ++e) { o0[e] = silu_f(acc[ai][0][m][0][e] * rs) * (acc[ai][1][m][0][e] * rs); o1[e] = silu_f(acc[ai][0][m][1][e] * rs) * (acc[ai][1][m][1][e] * rs); }
                *(u32x4*)(O + (size_t)row * ldo + col0) = pack8(o0, o1); EPI_FENCE(); }
    }
};
struct EpiResid {
    static constexpr bool PERM = true, AFTER_DRAIN = false;
    bf16_t* HB; float* stats; float scale;
    __device__ __forceinline__ void operator()(const f32x4 (&acc)[2][2][4][2], const Unit& u, int wr, int wc, int fr_in, int fq_in) const {
        int fr = fr_in, fq = fq_in; asm volatile("" : "+v"(fr), "+v"(fq));
        const int row0 = u.pm * BM + wr * 64 + fr, col0 = u.pn * BM + wc * 32 + 8 * fq;
#pragma unroll
        for (int ai = 0; ai < 2; ++ai)
#pragma unroll
            for (int m = 0; m < 4; ++m) { const int row = row0 + ai * HALF + m * 16; float ss = 0.f;
#pragma unroll
                for (int bj = 0; bj < 2; ++bj) { u32x4* hp = (u32x4*)(HB + (size_t)row * 1024 + col0 + bj * HALF);
                    const u32x4 w = *hp; f32x4 h0, h1;
                    h0[0] = __uint_as_float(w.x << 16); h0[1] = __uint_as_float(w.x & 0xffff0000u); h0[2] = __uint_as_float(w.y << 16); h0[3] = __uint_as_float(w.y & 0xffff0000u);
                    h1[0] = __uint_as_float(w.z << 16); h1[1] = __uint_as_float(w.z & 0xffff0000u); h1[2] = __uint_as_float(w.w << 16); h1[3] = __uint_as_float(w.w & 0xffff0000u);
                    h0 = h0 + acc[ai][bj][m][0] * scale; h1 = h1 + acc[ai][bj][m][1] * scale;
                    *hp = pack8(h0, h1);
                    ss += ((h0[0] * h0[0] + h0[1] * h0[1]) + (h0[2] * h0[2] + h0[3] * h0[3])) + ((h1[0] * h1[0] + h1[1] * h1[1]) + (h1[2] * h1[2] + h1[3] * h1[3])); }
                ss += __shfl_xor(ss, 16); ss += __shfl_xor(ss, 32);
                if (fq == 0) stats[(size_t)row * 16 + u.pn * 4 + wc] = ss; EPI_FENCE(); }
    }
};
__device__ __forceinline__ int kv_row(int row) {
    if (row < 16384) return row + 64 * (row >> 12);
    if (row < 81920) return row + 64 * (4 + ((row - 16384) >> 13));
    const int q = (row - 81920) >> 6, i = (row - 81920) & 63;
    return (q < 4 ? 4096 * q + 4096 : 16384 + 8192 * (q - 4) + 8192) + 64 * q + i;
}
struct EpiWin {
    static constexpr bool PERM = true, AFTER_DRAIN = false;
    bf16_t *Q, *K, *V, *CB, *U; const float* stats; const float* qg; const float* kg; const float* rope;
    __device__ __forceinline__ void operator()(const f32x4 (&acc)[2][2][4][2], const Unit& u, int wr, int wc, int fr_in, int fq_in) const {
        int fr = fr_in, fq = fq_in; asm volatile("" : "+v"(fr), "+v"(fq));
        const int row0 = u.pm * BM + wr * 64 + fr, pn = u.pn;
        if (pn >= 5) {
            const int col0 = (pn - 5) * 128 + wc * 32 + 8 * fq;
#pragma unroll
            for (int ai = 0; ai < 2; ++ai)
#pragma unroll
                for (int m = 0; m < 4; ++m) { const int row = row0 + ai * HALF + m * 16; const float rs = row_rstd(stats, row, fq), rs2 = rs * rs;
                    const f32x4 o0 = acc[ai][0][m][0] * acc[ai][1][m][0] * rs2, o1 = acc[ai][0][m][1] * acc[ai][1][m][1] * rs2;
                    *(u32x4*)(U + (size_t)row * 512 + col0) = pack8(o0, o1); EPI_FENCE(); }
            return;
        }
        const int hd = 4 * pn + wc;
        const bool is_q = hd < 8, is_k = (hd >= 8 && hd < 10);
        bf16_t* dst; int ldd, cb;
        if (is_q) { dst = Q; ldd = 512; cb = hd * 64; } else if (is_k) { dst = K; ldd = 128; cb = (hd - 8) * 64; }
        else if (hd < 12) { dst = V; ldd = 128; cb = (hd - 10) * 64; } else { dst = CB; ldd = 512; cb = (hd - 12) * 64; }
        cb += 8 * fq;
        if (is_q || is_k) {
            const float* gp = (is_q ? qg : kg) + 8 * fq;
            const float osc = is_q ? (0.125f * 1.4426950408889634f) : 1.0f;
#pragma unroll
            for (int ai = 0; ai < 2; ++ai)
#pragma unroll
                for (int m = 0; m < 4; ++m) { const int row = row0 + ai * HALF + m * 16; const float rs = row_rstd(stats, row, fq);
                    f32x4 v00 = acc[ai][0][m][0] * rs, v01 = acc[ai][0][m][1] * rs, v10 = acc[ai][1][m][0] * rs, v11 = acc[ai][1][m][1] * rs;
                    float ss = ((v00[0] * v00[0] + v00[1] * v00[1]) + (v00[2] * v00[2] + v00[3] * v00[3])) + ((v01[0] * v01[0] + v01[1] * v01[1]) + (v01[2] * v01[2] + v01[3] * v01[3]))
                             + ((v10[0] * v10[0] + v10[1] * v10[1]) + (v10[2] * v10[2] + v10[3] * v10[3])) + ((v11[0] * v11[0] + v11[1] * v11[1]) + (v11[2] * v11[2] + v11[3] * v11[3]));
                    ss += __shfl_xor(ss, 16); ss += __shfl_xor(ss, 32);
                    const float rn = rsqrtf(ss * (1.0f / 64.0f) + RMS_EPS);
                    v00 = v00 * *(const f32x4*)gp * rn; v01 = v01 * *(const f32x4*)(gp + 4) * rn; v10 = v10 * *(const f32x4*)(gp + 32) * rn; v11 = v11 * *(const f32x4*)(gp + 36) * rn;
                    int rp = 0, cp = 0;
                    if (row < 81920) { const int nn = row & (row < 16384 ? 4095 : 8191); rp = nn >> 6; cp = nn & 63; }
                    const float* tr = rope + (size_t)rp * 32 + 8 * fq; const float* tc = rope + (size_t)cp * 32 + 8 * fq;
                    const f32x4 r0 = *(const f32x4*)tr, r1 = *(const f32x4*)(tr + 4), c0 = *(const f32x4*)tc, c1 = *(const f32x4*)(tc + 4);
                    f32x4 o00, o01, o10, o11;
                    o00[0] = v00[0] * r0[0] - v00[1] * r0[1]; o00[1] = v00[0] * r0[1] + v00[1] * r0[0]; o00[2] = v00[2] * r0[2] - v00[3] * r0[3]; o00[3] = v00[2] * r0[3] + v00[3] * r0[2];
                    o01[0] = v01[0] * r1[0] - v01[1] * r1[1]; o01[1] = v01[0] * r1[1] + v01[1] * r1[0]; o01[2] = v01[2] * r1[2] - v01[3] * r1[3]; o01[3] = v01[2] * r1[3] + v01[3] * r1[2];
                    o10[0] = v10[0] * c0[0] - v10[1] * c0[1]; o10[1] = v10[0] * c0[1] + v10[1] * c0[0]; o10[2] = v10[2] * c0[2] - v10[3] * c0[3]; o10[3] = v10[2] * c0[3] + v10[3] * c0[2];
                    o11[0] = v11[0] * c1[0] - v11[1] * c1[1]; o11[1] = v11[0] * c1[1] + v11[1] * c1[0]; o11[2] = v11[2] * c1[2] - v11[3] * c1[3]; o11[3] = v11[2] * c1[3] + v11[3] * c1[2];
                    bf16_t* dp = dst + (size_t)(is_k ? kv_row(row) : row) * ldd + cb;
                    *(u32x4*)dp = pack8(o00 * osc, o01 * osc); *(u32x4*)(dp + 32) = pack8(o10 * osc, o11 * osc); EPI_FENCE(); }
        } else {
#pragma unroll
            for (int ai = 0; ai < 2; ++ai)
#pragma unroll
                for (int m = 0; m < 4; ++m) { const int row = row0 + ai * HALF + m * 16; const float rs = row_rstd(stats, row, fq);
                    bf16_t* dp = dst + (size_t)(hd < 12 ? kv_row(row) : row) * ldd + cb;
                    *(u32x4*)dp = pack8(acc[ai][0][m][0] * rs, acc[ai][0][m][1] * rs); *(u32x4*)(dp + 32) = pack8(acc[ai][1][m][0] * rs, acc[ai][1][m][1] * rs); EPI_FENCE(); }
        }
    }
};

template <class Epi, class Sched, bool ALIGN_EPI = false, bool SP2 = false>
__device__ __forceinline__ void gemm_phase(PG8_LAS unsigned char* lds, const Gemm g, const Sched& S, const Epi& E) {
    int tid_ = threadIdx.x; asm volatile("" : "+v"(tid_));
    const int tid = tid_, wid = __builtin_amdgcn_readfirstlane(tid >> 6), lane = tid & 63, wr = wid >> 2, wc = wid & 3, fr = lane & 15, fq = lane >> 4;
    const int K = g.K, nt = K / BK;
    unsigned voffA[2], voffB[2];
#pragma unroll
    for (int i = 0; i < 2; ++i) { int R, C; stage_rc(tid * 16 + i * 8192, R, C); const int Rb = Epi::PERM ? ((R & ~31) + perm32(R & 31)) : R;
        voffA[i] = (unsigned)(R * K + C) * 2u; voffB[i] = (unsigned)(Rb * K + C) * 2u; }
    const size_t kstep = (size_t)(BK * 2);
    const size_t hstep = (size_t)HALF * K * 2;
    const size_t tstep = 2 * hstep;
    const unsigned ldsw = (unsigned)wid * 1024u;
    const int aoff = lds_byte(wr * 64 + fr, fq * 8), boff = lds_byte(wc * 32 + fr, fq * 8);
#define PG8_SA(b, h) (((b) * 2 + (h)) * HTB)
#define PG8_SB(b, h) ((4 + (b) * 2 + (h)) * HTB)
#define PG8_STAGE(bufoff, gbase, voff) do { _Pragma("unroll") for (int _i = 0; _i < 2; ++_i) \
        __builtin_amdgcn_global_load_lds((const unsigned*)((const char*)(gbase) + (voff)[_i]), (PG8_LAS unsigned*)(lds + (bufoff) + ldsw + _i * 8192), 16, 0, 0); } while (0)
#define PG8_LDA(dst, b, h) do { _Pragma("unroll") for (int m = 0; m < 4; ++m) _Pragma("unroll") for (int k = 0; k < 2; ++k) dst[m][k] = *(const PG8_LAS bf16x8*)(lds + PG8_SA(b, h) + aoff + m * 2048 + k * 1024); } while (0)
#define PG8_LDB(dst, b, h) do { _Pragma("unroll") for (int n = 0; n < 2; ++n) _Pragma("unroll") for (int k = 0; k < 2; ++k) dst[n][k] = *(const PG8_LAS bf16x8*)(lds + PG8_SB(b, h) + boff + n * 2048 + k * 1024); } while (0)
#define PG8_MMA(ai, bj, At, Bt) do { __builtin_amdgcn_s_setprio(1); _Pragma("unroll") for (int m = 0; m < 4; ++m) _Pragma("unroll") for (int n = 0; n < 2; ++n) _Pragma("unroll") for (int k = 0; k < 2; ++k) \
        acc[ai][bj][m][n] = __builtin_amdgcn_mfma_f32_16x16x32_bf16(Bt[n][k], At[m][k], acc[ai][bj][m][n], 0, 0, 0); __builtin_amdgcn_s_setprio(0); } while (0)
#define PG8_WAIT_V(n) asm volatile("s_waitcnt vmcnt(" #n ")" ::: "memory")
#define PG8_WAIT_L(n) asm volatile("s_waitcnt lgkmcnt(" #n ")" ::: "memory")
#define PG8_BAR __builtin_amdgcn_s_barrier()
#define PG8_SCHED __builtin_amdgcn_sched_barrier(0)
    Unit cur, nxt; int ui = 0;
    if (!S.next(0, cur)) return;
    f32x4 acc[2][2][4][2];
#pragma unroll
    for (int a = 0; a < 2; ++a)
#pragma unroll
        for (int b = 0; b < 2; ++b)
#pragma unroll
            for (int m = 0; m < 4; ++m)
#pragma unroll
                for (int n = 0; n < 2; ++n) acc[a][b][m][n] = (f32x4){0.f, 0.f, 0.f, 0.f};
    bf16x8 At[4][2], B0[2][2], B1[2][2];
    const char* cA = (const char*)g.A + (size_t)cur.pm * tstep; const char* cB = (const char*)g.Bt + (size_t)cur.pn * tstep;
    S.a_ready(cur);
    if constexpr (SP2) {
        PG8_STAGE(PG8_SB(0, 0), cB, voffB); PG8_STAGE(PG8_SB(0, 1), cB + hstep, voffB); PG8_STAGE(PG8_SA(0, 0), cA, voffA); PG8_STAGE(PG8_SA(0, 1), cA + hstep, voffA);
        if (wr == 1) PG8_BAR;
        PG8_WAIT_V(2); PG8_BAR;
        PG8_STAGE(PG8_SB(1, 0), cB + kstep, voffB); PG8_STAGE(PG8_SA(1, 0), cA + kstep, voffA); PG8_STAGE(PG8_SB(1, 1), cB + hstep + kstep, voffB);
        PG8_WAIT_V(6); PG8_BAR;
    } else {
        PG8_STAGE(PG8_SB(0, 0), cB, voffB); PG8_STAGE(PG8_SA(0, 0), cA, voffA); PG8_STAGE(PG8_SB(0, 1), cB + hstep, voffB); PG8_STAGE(PG8_SA(0, 1), cA + hstep, voffA);
        if (wr == 1) PG8_BAR;
        PG8_WAIT_V(4); PG8_BAR;
        PG8_STAGE(PG8_SB(1, 0), cB + kstep, voffB); PG8_STAGE(PG8_SA(1, 0), cA + kstep, voffA); PG8_STAGE(PG8_SB(1, 1), cB + hstep + kstep, voffB);
        PG8_WAIT_V(6); PG8_BAR;
    }
    for (;;) {
        const bool has_next = S.next(ui + 1, nxt);
        const char* nA = has_next ? (const char*)g.A + (size_t)nxt.pm * tstep : cA; const char* nB = has_next ? (const char*)g.Bt + (size_t)nxt.pn * tstep : cB;
        for (int t = 0; t < nt; t += 2) {
            const bool last = (t == nt - 2);
            const char* a1 = cA + (size_t)(t + 1) * kstep;
            const char* a2 = last ? nA : cA + (size_t)(t + 2) * kstep; const char* b2 = last ? nB : cB + (size_t)(t + 2) * kstep;
            const char* a3 = a2 + kstep; const char* b3 = b2 + kstep;
            if (last && has_next) S.a_ready(nxt);
            if constexpr (SP2) {
            PG8_LDB(B0, 0, 0); PG8_LDB(B1, 0, 1); PG8_SCHED; PG8_LDA(At, 0, 0); PG8_STAGE(PG8_SA(1, 1), a1 + hstep, voffA);
            PG8_WAIT_V(8); PG8_WAIT_L(0); PG8_BAR; PG8_MMA(0, 0, At, B0); PG8_MMA(0, 1, At, B1); PG8_BAR; PG8_SCHED;
            PG8_LDA(At, 0, 1); PG8_STAGE(PG8_SB(0, 0), b2, voffB); PG8_STAGE(PG8_SB(0, 1), b2 + hstep, voffB); PG8_STAGE(PG8_SA(0, 0), a2, voffA);
            PG8_WAIT_V(8); PG8_WAIT_L(0); PG8_BAR; PG8_MMA(1, 0, At, B0); PG8_MMA(1, 1, At, B1); PG8_BAR; PG8_SCHED;
            PG8_LDB(B0, 1, 0); PG8_LDB(B1, 1, 1); PG8_SCHED; PG8_LDA(At, 1, 0); PG8_STAGE(PG8_SA(0, 1), a2 + hstep, voffA);
            PG8_WAIT_V(8); PG8_WAIT_L(0); PG8_BAR; PG8_MMA(0, 0, At, B0); PG8_MMA(0, 1, At, B1); PG8_BAR; PG8_SCHED;
            PG8_LDA(At, 1, 1); PG8_STAGE(PG8_SB(1, 0), b3, voffB); PG8_STAGE(PG8_SB(1, 1), b3 + hstep, voffB); PG8_STAGE(PG8_SA(1, 0), a3, voffA);
            PG8_WAIT_V(8); PG8_WAIT_L(0); PG8_BAR; PG8_MMA(1, 0, At, B0); PG8_MMA(1, 1, At, B1); PG8_BAR; PG8_SCHED;
            } else {
            PG8_LDB(B0, 0, 0); PG8_SCHED; PG8_LDA(At, 0, 0); PG8_STAGE(PG8_SA(1, 1), a1 + hstep, voffA);
            PG8_WAIT_L(8); PG8_BAR; PG8_WAIT_L(0); PG8_MMA(0, 0, At, B0); PG8_BAR; PG8_SCHED;
            PG8_LDB(B1, 0, 1); PG8_STAGE(PG8_SB(0, 0), b2, voffB);
            PG8_BAR; PG8_WAIT_L(0); PG8_MMA(0, 1, At, B1); PG8_BAR;
            PG8_LDA(At, 0, 1); PG8_STAGE(PG8_SA(0, 0), a2, voffA);
            PG8_BAR; PG8_WAIT_L(0); PG8_MMA(1, 0, At, B0); PG8_BAR; PG8_SCHED;
            PG8_STAGE(PG8_SB(0, 1), b2 + hstep, voffB);
            PG8_WAIT_V(6); PG8_BAR; PG8_MMA(1, 1, At, B1); PG8_BAR;
            PG8_LDB(B0, 1, 0); PG8_SCHED; PG8_LDA(At, 1, 0); PG8_STAGE(PG8_SA(0, 1), a2 + hstep, voffA);
            PG8_WAIT_L(8); PG8_BAR; PG8_WAIT_L(0); PG8_MMA(0, 0, At, B0); PG8_BAR; PG8_SCHED;
            PG8_LDB(B1, 1, 1); PG8_STAGE(PG8_SB(1, 0), b3, voffB);
            PG8_BAR; PG8_WAIT_L(0); PG8_MMA(0, 1, At, B1); PG8_BAR;
            PG8_LDA(At, 1, 1); PG8_STAGE(PG8_SA(1, 0), a3, voffA);
            PG8_BAR; PG8_WAIT_L(0); PG8_MMA(1, 0, At, B0); PG8_BAR; PG8_SCHED;
            PG8_STAGE(PG8_SB(1, 1), b3 + hstep, voffB);
            PG8_WAIT_V(6); PG8_BAR; PG8_MMA(1, 1, At, B1); PG8_BAR;
            }
        }
        if constexpr (ALIGN_EPI) { if (wr == 0) PG8_BAR; }
        if constexpr (!Epi::AFTER_DRAIN) { E(acc, cur, wr, wc, fr, fq); S.done(cur); }
        if (!has_next) break;
#pragma unroll
        for (int a = 0; a < 2; ++a)
#pragma unroll
            for (int b = 0; b < 2; ++b)
#pragma unroll
                for (int m = 0; m < 4; ++m)
#pragma unroll
                    for (int n = 0; n < 2; ++n) acc[a][b][m][n] = (f32x4){0.f, 0.f, 0.f, 0.f};
        cur = nxt; cA = nA; cB = nB; ++ui;
        if constexpr (ALIGN_EPI) { if (wr == 1) PG8_BAR; }
    }
    PG8_WAIT_V(0);
    if constexpr (!ALIGN_EPI) { if (wr == 0) PG8_BAR; }
    PG8_BAR;
    if constexpr (Epi::AFTER_DRAIN) { E.fused(acc, cur, wr, wc, fr, fq, lds, wid, lane); S.done(cur); }
#undef PG8_SA
#undef PG8_SB
#undef PG8_STAGE
#undef PG8_LDA
#undef PG8_LDB
#undef PG8_MMA
#undef PG8_WAIT_V
#undef PG8_WAIT_L
#undef PG8_BAR
#undef PG8_SCHED
}
}

namespace attn_body {
using bf16=__hip_bfloat16;
using bf16x8=__attribute__((ext_vector_type(8)))short;
using s16x4=__attribute__((ext_vector_type(4)))short;
using f32x16=__attribute__((ext_vector_type(16)))float;
using u32x4=__attribute__((ext_vector_type(4)))unsigned;
constexpr int D=64,QP=512,KP=128,OP=1024;
typedef float f32x4 __attribute__((ext_vector_type(4)));
constexpr int NW=8,QBLK=32,QB=QBLK*NW,KVBLK=64;
__device__ __forceinline__ int crow(int r,int hi){return (r&3)+8*(r>>2)+4*hi;}
#define SBAR() __builtin_amdgcn_sched_barrier(0)
#define ATTN_STORE16(p,v) (*(u32x4*)(p)=(v))
__device__ __forceinline__ void mmask(f32x16&p0,f32x16&p1,bool any,bool all){
  const float NEG=-INFINITY;
  #pragma unroll
  for(int r=0;r<16;++r){p1[r]=any?NEG:p1[r]; p0[r]=((r>=8)?any:all)?NEG:p0[r];}
}
constexpr int NSLOT=3, SLOTB=8192;
constexpr int LDS_K=0, LDS_V=NSLOT*SLOTB, LDS_WS=2*NSLOT*SLOTB, LDS_OST=LDS_WS+NW*64*4, LDS_BYTES=LDS_OST+NW*4096;
constexpr float C2=0.125f*1.4426950408889634f;
__device__ __forceinline__ void glds16(const void*gsrc,unsigned lds_dst){unsigned keep;
  asm volatile("s_mov_b32 %0, m0\n\ts_mov_b32 m0, %2\n\ts_nop 0\n\tglobal_load_lds_dwordx4 %1, off\n\ts_mov_b32 m0, %0":"=&s"(keep):"v"(gsrc),"s"(lds_dst):"memory");}
__device__ __forceinline__ float max3f(float a,float b,float c){float r;asm("v_max3_f32 %0, %1, %2, %3":"=v"(r):"v"(a),"v"(b),"v"(c));return r;}
__device__ __forceinline__ float max2f(float a,float b){float r;asm("v_max_f32_e32 %0, %1, %2":"=v"(r):"v"(a),"v"(b));return r;}
__device__ __forceinline__ float fadd_s(float a,float b){float r;asm("v_add_f32_e32 %0, %1, %2":"=v"(r):"v"(a),"v"(b));return r;}
__device__ __forceinline__ float fsub_s(float a,float b){float r;asm("v_sub_f32_e32 %0, %1, %2":"=v"(r):"v"(a),"v"(b));return r;}
typedef float f32x2_t __attribute__((ext_vector_type(2))); typedef __bf16 bf16x2_t __attribute__((ext_vector_type(2)));
__device__ __forceinline__ unsigned cvtpk_s(float lo,float hi){f32x2_t v={lo,hi};bf16x2_t b=__builtin_convertvector(v,bf16x2_t);return __builtin_bit_cast(unsigned,b);}
#define WAIT_BAR(N) asm volatile("s_waitcnt vmcnt(" #N ") lgkmcnt(0)\n\ts_barrier":::"memory")

__device__ __forceinline__ void qkt(f32x16&p0,f32x16&p1,const char*Kslot,const bf16x8*qr,const f32x16&negm,int r32,int hi){
  const char*kb=Kslot+hi*1024+r32*16;
  #pragma unroll
  for(int d0=0;d0<4;++d0){
    const bf16x8 b0=*reinterpret_cast<const bf16x8*>(kb+d0*2048);
    const bf16x8 b1=*reinterpret_cast<const bf16x8*>(kb+d0*2048+512);
    if(d0==0){p0=__builtin_amdgcn_mfma_f32_32x32x16_bf16(b0,qr[0],negm,0,0,0);p1=__builtin_amdgcn_mfma_f32_32x32x16_bf16(b1,qr[0],negm,0,0,0);}
    else{p0=__builtin_amdgcn_mfma_f32_32x32x16_bf16(b0,qr[d0],p0,0,0,0);p1=__builtin_amdgcn_mfma_f32_32x32x16_bf16(b1,qr[d0],p1,0,0,0);}}
}
typedef __attribute__((address_space(3))) const char* lds_cptr;
typedef short v4i16_t __attribute__((ext_vector_type(4)));
__device__ __forceinline__ void kload8(bf16x8*kf,lds_cptr kp){
  kf[0]=*(const __attribute__((address_space(3))) bf16x8*)(kp);      kf[1]=*(const __attribute__((address_space(3))) bf16x8*)(kp+512);
  kf[2]=*(const __attribute__((address_space(3))) bf16x8*)(kp+2048); kf[3]=*(const __attribute__((address_space(3))) bf16x8*)(kp+2560);
  kf[4]=*(const __attribute__((address_space(3))) bf16x8*)(kp+4096); kf[5]=*(const __attribute__((address_space(3))) bf16x8*)(kp+4608);
  kf[6]=*(const __attribute__((address_space(3))) bf16x8*)(kp+6144); kf[7]=*(const __attribute__((address_space(3))) bf16x8*)(kp+6656);
}
__device__ __forceinline__ void kload2(bf16x8*kf,lds_cptr kp,int j){ kf[2*j]=*(const __attribute__((address_space(3))) bf16x8*)(kp+j*2048); kf[2*j+1]=*(const __attribute__((address_space(3))) bf16x8*)(kp+j*2048+512); }
__device__ __forceinline__ s16x4 vtr(lds_cptr p){ return __builtin_bit_cast(s16x4,__builtin_amdgcn_ds_read_tr16_b64_v4i16((__attribute__((address_space(3))) v4i16_t*)p)); }
__device__ __forceinline__ float rowmax(const f32x16&p0,const f32x16&p1){
  float a=max3f(p0[0],p0[1],p1[0]),b=max3f(p0[2],p0[3],p1[1]);a=max3f(a,p1[2],p1[3]);
  #pragma unroll
  for(int r=4;r<16;r+=4){a=max3f(a,p0[r],p0[r+1]);b=max3f(b,p0[r+2],p0[r+3]);a=max3f(a,p1[r],p1[r+1]);b=max3f(b,p1[r+2],p1[r+3]);}
  const float m=max2f(a,b);
  auto rr=__builtin_amdgcn_permlane32_swap(__float_as_uint(m),__float_as_uint(m),false,false);
  return max2f(__uint_as_float(rr[0]),__uint_as_float(rr[1]));
}
__device__ __forceinline__ void pv(f32x16*o,int vb,bf16x8 pa0,bf16x8 pa1,bf16x8 pa2,bf16x8 pa3){
  #pragma unroll
  for(int d0=0;d0<2;++d0){s16x4 lo[4],hi[4];
    #pragma unroll
    for(int ks=0;ks<4;++ks){
      asm volatile("ds_read_b64_tr_b16 %0,%1 offset:%c2":"=&v"(lo[ks]):"v"(vb),"i"(d0*4096+ks*1024):"memory");
      asm volatile("ds_read_b64_tr_b16 %0,%1 offset:%c2":"=&v"(hi[ks]):"v"(vb),"i"(d0*4096+ks*1024+512):"memory");}
    asm volatile("s_waitcnt lgkmcnt(0)":::"memory");SBAR();
    #define PK(k) (bf16x8){lo[k][0],lo[k][1],lo[k][2],lo[k][3],hi[k][0],hi[k][1],hi[k][2],hi[k][3]}
    o[d0]=__builtin_amdgcn_mfma_f32_32x32x16_bf16(pa0,PK(0),o[d0],0,0,0);
    o[d0]=__builtin_amdgcn_mfma_f32_32x32x16_bf16(pa1,PK(1),o[d0],0,0,0);
    o[d0]=__builtin_amdgcn_mfma_f32_32x32x16_bf16(pa2,PK(2),o[d0],0,0,0);
    o[d0]=__builtin_amdgcn_mfma_f32_32x32x16_bf16(pa3,PK(3),o[d0],0,0,0);
    #undef PK
  }
}

template<int THRL> __device__ __forceinline__ void attn_unit(long qrow0,int is_meta,long kvbase,int NR,long metarow,int h,const bf16*Q,const bf16*__restrict__ K,const bf16*__restrict__ V,bf16*O,char*shm){
  int tid_=threadIdx.x; asm volatile("":"+v"(tid_)); const int tid=tid_,lane=tid&63,r32=lane&31,hi=lane>>5; const int wid=__builtin_amdgcn_readfirstlane(tid>>6);
  const long qrow_l=is_meta?(metarow+(long)((wid*QBLK+r32)&63)):(qrow0+wid*QBLK+r32);
  const bf16*Qw=Q+qrow_l*QP+h*D;
  const bf16*Kh=K+(h>>2)*D,*Vh=V+(h>>2)*D;
  const unsigned lds0=(unsigned)(uintptr_t)shm;
  float*wsf=(float*)(shm+LDS_WS)+wid*64;
  const bf16*ksrc=Kh+(long)lane*KP+wid*8;
  const bf16*vsrc=Vh+(long)(16*(wid&3)+(lane>>2))*KP+(wid>>2)*32+(lane&3)*8;
  #define TROW(t) (kvbase+(long)(t)*KVBLK)
  const unsigned kdst=lds0+LDS_K+wid*1024, vdst=lds0+LDS_V+wid*1024;
  #define DMA_K(t,slot) glds16(ksrc+TROW(t)*KP,(unsigned)__builtin_amdgcn_readfirstlane(kdst+(slot)))
  #define DMA_V(t,slot) glds16(vsrc+TROW(t)*KP,(unsigned)__builtin_amdgcn_readfirstlane(vdst+(slot)))
  const int vb0=(int)(lds0+LDS_V)+((lane>>4)&1)*32+(lane&3)*8+(4*hi+((lane&15)>>2))*64;
  const char*Kbase=shm+LDS_K; bf16x8 kf[8];
  const lds_cptr shm3=(lds_cptr)shm; const lds_cptr kp0=shm3+LDS_K+hi*1024+r32*16; const lds_cptr vp0=shm3+LDS_V+((lane>>4)&1)*32+(lane&3)*8+(4*hi+((lane&15)>>2))*64;
  const int NT=NR+2;
  DMA_K(0,0);DMA_V(0,0);DMA_K(1,SLOTB);
  bf16x8 qr[4];
  #pragma unroll
  for(int d0=0;d0<4;++d0)qr[d0]=*reinterpret_cast<const bf16x8*>(&Qw[d0*16+hi*8]);
  float mhat=0.f,l_reg=0.f;f32x16 o[2];o[0]=f32x16{};o[1]=f32x16{};f32x16 negm=f32x16{};asm volatile("":"+v"(negm));
  #define CMASK(P0,P1,t) do{ mmask(P0,P1,(t)>=NT-2,(t)==NT-1); }while(0)
  bool resc=false;
  #define START(P0,P1) do{ const float rm=rowmax(P0,P1); resc=false; \
    { const float dl=rm; mhat=fadd_s(mhat,dl); \
      _Pragma("unroll") for(int r=0;r<16;++r){P0[r]=fsub_s(P0[r],dl);P1[r]=fsub_s(P1[r],dl);} \
      _Pragma("unroll") for(int r=0;r<16;++r)negm[r]=-mhat; asm volatile("":"+v"(negm)); } \
    _Pragma("unroll") for(int r=0;r<16;++r)P0[r]=__builtin_amdgcn_exp2f(P0[r]); }while(0)
  #define RESC() do{ if(resc){ asm volatile("s_waitcnt lgkmcnt(0)":::"memory"); \
      _Pragma("unroll") for(int d_=0;d_<2;++d_) _Pragma("unroll") for(int r=0;r<16;++r)o[d_][r]*=wsf[crow(r,hi)]; } }while(0)
  f32x16 pA0,pA1,pB0,pB1;
  int sl_prev=0,sl_cur=0,sl_next=SLOTB;
  #define ROT() do{sl_prev=sl_cur;sl_cur=sl_next;sl_next=(sl_next==(NSLOT-1)*SLOTB)?0:sl_next+SLOTB;}while(0)
  DMA_K(2,2*SLOTB);
  WAIT_BAR(3);
  qkt(pA0,pA1,Kbase,qr,negm,r32,hi);asm volatile("s_nop 15\n\ts_nop 7":"+v"(pA0),"+v"(pA1));
  START(pA0,pA1);
  _Pragma("unroll") for(int r=0;r<16;++r)pA1[r]=__builtin_amdgcn_exp2f(pA1[r]);
  WAIT_BAR(0);
  DMA_K(3,0);DMA_V(1,SLOTB);
  ROT();
  kload8(kf,kp0+sl_cur);
  WAIT_BAR(2);
  s16x4 vlo[8],vhi[8]; u32x4 pw0,pw1,pw2,pw3;
  #define PKW(P,B) cvtpk_s(P[B],P[B+1])
  #define PAF(k) __builtin_bit_cast(bf16x8,pw##k)
  #define VFR(i) (bf16x8){vlo[i][0],vlo[i][1],vlo[i][2],vlo[i][3],vhi[i][0],vhi[i][1],vhi[i][2],vhi[i][3]}
  #define PIN(x) asm volatile("":"+v"(x))
  #define MX3(a,b,c) __builtin_fmaxf(__builtin_fmaxf((a),(b)),(c))
  #define GAPA(MF,A0,A1,A2,A3,W0,W1,PW) do{ MF; sacc+=A0; sacc+=A1; sacc+=A2; sacc+=A3; PIN(sacc); W0; W1; PIN(PW); SBAR(); }while(0)
  #define EX(v) __builtin_amdgcn_exp2f(v)
  #define GAPB(MF,X,B) do{ MF; X[B]=EX(X[B]); X[B+1]=EX(X[B+1]); X[B+2]=EX(X[B+2]); X[B+3]=EX(X[B+3]); PIN(X); SBAR(); }while(0)
  #define VRD(i) do{ vlo[i]=vtr(vp_+(((i)>>2)*4096+((i)&3)*1024)); vhi[i]=vtr(vp_+(((i)>>2)*4096+((i)&3)*1024+512)); }while(0)
  #define KRD(G,j) do{ if(G){ kload2(kf,kp0+sl_next,j); SBAR(); } }while(0)
  #define STEP(C0,C1,P0,P1,t,GK,GV,GL) do{ SBAR(); \
    const lds_cptr vp_=vp0+sl_prev; \
    VRD(0); SBAR(); float sacc=(P0[0]+P0[1]); \
    GAPA(C0=__builtin_amdgcn_mfma_f32_32x32x16_bf16(kf[0],qr[0],negm,0,0,0), P0[2],P0[3],P0[4],P0[5],     pw0[0]=PKW(P0,0), pw0[1]=PKW(P0,2), pw0); \
    VRD(4); SBAR(); GAPA(C1=__builtin_amdgcn_mfma_f32_32x32x16_bf16(kf[1],qr[0],negm,0,0,0), P0[6],P0[7],P0[8],P0[9],     pw0[2]=PKW(P0,4), pw0[3]=PKW(P0,6), pw0); \
    VRD(1); SBAR(); GAPA(C0=__builtin_amdgcn_mfma_f32_32x32x16_bf16(kf[2],qr[1],C0,0,0,0),   P0[10],P0[11],P0[12],P0[13], pw1[0]=PKW(P0,8), pw1[1]=PKW(P0,10), pw1); \
    VRD(5); SBAR(); GAPA(C1=__builtin_amdgcn_mfma_f32_32x32x16_bf16(kf[3],qr[1],C1,0,0,0),   P0[14],P0[15],P1[0],P1[1],   pw1[2]=PKW(P0,12),pw1[3]=PKW(P0,14), pw1); \
    VRD(2); SBAR(); GAPA(C0=__builtin_amdgcn_mfma_f32_32x32x16_bf16(kf[4],qr[2],C0,0,0,0),   P1[2],P1[3],P1[4],P1[5],     pw2[0]=PKW(P1,0), pw2[1]=PKW(P1,2), pw2); \
    VRD(6); SBAR(); GAPA(C1=__builtin_amdgcn_mfma_f32_32x32x16_bf16(kf[5],qr[2],C1,0,0,0),   P1[6],P1[7],P1[8],P1[9],     pw2[2]=PKW(P1,4), pw2[3]=PKW(P1,6), pw2); \
    VRD(3); SBAR(); GAPA(C0=__builtin_amdgcn_mfma_f32_32x32x16_bf16(kf[6],qr[3],C0,0,0,0),   P1[10],P1[11],P1[12],P1[13], pw3[0]=PKW(P1,8), pw3[1]=PKW(P1,10), pw3); \
    VRD(7); SBAR(); GAPA(C1=__builtin_amdgcn_mfma_f32_32x32x16_bf16(kf[7],qr[3],C1,0,0,0),   P1[14],P1[15],0.f,0.f,       pw3[2]=PKW(P1,12),pw3[3]=PKW(P1,14), pw3); \
    l_reg+=sacc; \
    if(GK){DMA_K((t)+3,sl_cur);} if(GV){DMA_V((t)+1,sl_next);} \
    CMASK(C0,C1,t); \
    { float a=MX3(C0[0],C0[1],C1[0]),b=MX3(C0[2],C0[3],C1[1]); a=MX3(a,C1[2],C1[3]); \
      _Pragma("unroll") for(int r=4;r<16;r+=4){a=MX3(a,C0[r],C0[r+1]);b=MX3(b,C0[r+2],C0[r+3]);a=MX3(a,C1[r],C1[r+1]);b=MX3(b,C1[r+2],C1[r+3]);} \
      float rm=__builtin_fmaxf(a,b); { auto rr=__builtin_amdgcn_permlane32_swap(__float_as_uint(rm),__float_as_uint(rm),false,false); rm=__builtin_fmaxf(__uint_as_float(rr[0]),__uint_as_float(rr[1])); } \
      resc=false; \
      if(__builtin_expect(__any(rm>(float)THRL),0)){ const float dl=__builtin_fmaxf(rm,0.f); mhat+=dl; \
        _Pragma("unroll") for(int r=0;r<16;++r){C0[r]-=dl;C1[r]-=dl;} \
        _Pragma("unroll") for(int r=0;r<16;++r)negm[r]=-mhat; asm volatile("":"+v"(negm)); \
        const float f=__builtin_amdgcn_exp2f(-dl); l_reg*=f; if(hi==0)wsf[r32]=f; resc=true; } } \
    SBAR(); \
    GAPB(o[0]=__builtin_amdgcn_mfma_f32_32x32x16_bf16(PAF(0),VFR(0),o[0],0,0,0), C0,0); \
    GAPB(o[1]=__builtin_amdgcn_mfma_f32_32x32x16_bf16(PAF(0),VFR(4),o[1],0,0,0), C0,4); \
    KRD(GL,0); GAPB(o[0]=__builtin_amdgcn_mfma_f32_32x32x16_bf16(PAF(1),VFR(1),o[0],0,0,0), C0,8); \
    KRD(GL,1); GAPB(o[1]=__builtin_amdgcn_mfma_f32_32x32x16_bf16(PAF(1),VFR(5),o[1],0,0,0), C0,12); \
    KRD(GL,2); GAPB(o[0]=__builtin_amdgcn_mfma_f32_32x32x16_bf16(PAF(2),VFR(2),o[0],0,0,0), C1,0); \
    KRD(GL,3); GAPB(o[1]=__builtin_amdgcn_mfma_f32_32x32x16_bf16(PAF(2),VFR(6),o[1],0,0,0), C1,4); \
    GAPB(o[0]=__builtin_amdgcn_mfma_f32_32x32x16_bf16(PAF(3),VFR(3),o[0],0,0,0), C1,8); \
    GAPB(o[1]=__builtin_amdgcn_mfma_f32_32x32x16_bf16(PAF(3),VFR(7),o[1],0,0,0), C1,12); \
    }while(0)
  int t=1;
  #undef CMASK
  #define CMASK(P0,P1,t) do{}while(0)
  for(;t+5<NT;t+=2){
    STEP(pB0,pB1,pA0,pA1,t,true,true,true);     WAIT_BAR(2); RESC(); ROT();
    STEP(pA0,pA1,pB0,pB1,t+1,true,true,true);   WAIT_BAR(2); RESC(); ROT();
  }
  #undef CMASK
  #define CMASK(P0,P1,t) do{ mmask(P0,P1,(t)>=NT-2,(t)==NT-1); }while(0)
  #define ENDW(tt) do{ if((tt)+3<NT){WAIT_BAR(2);} else if((tt)+2<NT){WAIT_BAR(1);} else {WAIT_BAR(0);} }while(0)
  for(;t+1<NT;t+=2){
    STEP(pB0,pB1,pA0,pA1,t,(t+3<NT),(t+1<NT),(t+1<NT));       ENDW(t);   RESC(); ROT();
    STEP(pA0,pA1,pB0,pB1,t+1,(t+4<NT),(t+2<NT),(t+2<NT));     ENDW(t+1); RESC(); ROT();
  }
  STEP(pB0,pB1,pA0,pA1,NT-1,false,false,false); RESC();
  { float sacc=pB0[0]+pB0[1]; _Pragma("unroll") for(int r=2;r<16;++r)sacc+=pB0[r]; _Pragma("unroll") for(int r=0;r<16;++r)sacc+=pB1[r]; l_reg+=sacc;
    pw0=(u32x4){PKW(pB0,0),PKW(pB0,2),PKW(pB0,4),PKW(pB0,6)};pw1=(u32x4){PKW(pB0,8),PKW(pB0,10),PKW(pB0,12),PKW(pB0,14)};pw2=(u32x4){PKW(pB1,0),PKW(pB1,2),PKW(pB1,4),PKW(pB1,6)};pw3=(u32x4){PKW(pB1,8),PKW(pB1,10),PKW(pB1,12),PKW(pB1,14)};
    SBAR(); pv(o,vb0+sl_cur,PAF(0),PAF(1),PAF(2),PAF(3)); }
  #undef PKW
  #undef PAF
  #undef VFR
  #undef PIN
  #undef MX3
  #undef GAPA
  #undef GAPB
  #undef EX
  #undef VRD
  #undef KRD
  #undef STEP
  #undef ENDW
  {auto rr=__builtin_amdgcn_permlane32_swap(__float_as_uint(l_reg),__float_as_uint(l_reg),false,false);l_reg=__uint_as_float(rr[0])+__uint_as_float(rr[1]);}
  if(hi==0)wsf[32+r32]=l_reg;asm volatile("s_waitcnt lgkmcnt(0)":::"memory");
  float rli[16];
  #pragma unroll
  for(int r=0;r<16;++r)rli[r]=__builtin_amdgcn_rcpf(wsf[32+crow(r,hi)]);
  { bf16*stg=(bf16*)(shm+LDS_OST)+wid*2048;
    #pragma unroll
    for(int r=0;r<16;++r){const int orow=crow(r,hi);
      #pragma unroll
      for(int d0=0;d0<2;++d0)stg[orow*64+d0*32+r32]=__float2bfloat16(o[d0][r]*rli[r]);}
    asm volatile("s_waitcnt lgkmcnt(0)":::"memory");
    #pragma unroll
    for(int i=0;i<4;++i){const int row=i*8+(lane>>3),ch=lane&7; const u32x4 w=*(const u32x4*)(stg+row*64+ch*8);
      float x[8];
      #pragma unroll
      for(int e=0;e<4;++e){x[2*e]=__uint_as_float(w[e]<<16); x[2*e+1]=__uint_as_float(w[e]&0xffff0000u);}
      float ss=((x[0]*x[0]+x[1]*x[1])+(x[2]*x[2]+x[3]*x[3]))+((x[4]*x[4]+x[5]*x[5])+(x[6]*x[6]+x[7]*x[7]));
      ss+=__shfl_xor(ss,1); ss+=__shfl_xor(ss,2); ss+=__shfl_xor(ss,4);
      const float rn=rsqrtf(ss*(1.0f/64.0f)+1e-6f);
      u32x4 v; v.x=cvtpk_s(x[0]*rn,x[1]*rn); v.y=cvtpk_s(x[2]*rn,x[3]*rn); v.z=cvtpk_s(x[4]*rn,x[5]*rn); v.w=cvtpk_s(x[6]*rn,x[7]*rn);
      const long orow_g=is_meta?(metarow+row):(qrow0+wid*QBLK+row);
      const bool ok=(!is_meta)||(wid==0&&row<16);
      if(ok) ATTN_STORE16(O+orow_g*OP+h*D+ch*8,v);} }
  asm volatile("s_waitcnt lgkmcnt(0)\n\ts_barrier":::"memory");
  #undef DMA_K
  #undef TROW
  #undef DMA_V
  #undef CMASK
  #undef START
  #undef RESC
  #undef ROT
}
constexpr int ATTN_LDS_BYTES=LDS_BYTES;
#undef SBAR
#undef WAIT_BAR
}

constexpr int NWAVES = 8;
constexpr int DM = 1024, DFF = 2816, NIN = 2304, DEPTH = 4;
constexpr int NREAL = 81920, MB = 81920, MP = 82688;
constexpr int NSEQ = 12;
constexpr size_t MiB = 1u << 20;
constexpr size_t WS_CTL = 0, WS_ROPE = 4096, WS_STATS = 32768, WS_W = 6 * MiB, WS_H = 165 * MiB, WS_BIG = 327 * MiB;
constexpr size_t WS_END = WS_BIG + (size_t)MP * 2816 * 2;
constexpr size_t W_GU = (size_t)2 * DFF * DM, W_D = (size_t)DM * DFF, W_IN = (size_t)NIN * DM, W_OUT = (size_t)DM * DM;
constexpr size_t WL_1GU = 0, WL_1D = WL_1GU + W_GU, WL_IN = WL_1D + W_D, WL_OUT = WL_IN + W_IN, WL_2GU = WL_OUT + W_OUT, WL_2D = WL_2GU + W_GU, WL_SZ = WL_2D + W_D;
static_assert(WS_STATS + (size_t)MP * 16 * 4 <= WS_W && WS_W + WL_SZ * 2 * DEPTH <= WS_H && WS_H + (size_t)MP * DM * 2 <= WS_BIG, "ws map");
constexpr int RING_BYTES = 131072, LDS_BYTES = 147456;
static_assert(attn_body::ATTN_LDS_BYTES <= RING_BYTES, "attention LDS");

#define LAS __attribute__((address_space(3)))
typedef unsigned short bf16;
typedef unsigned v4u __attribute__((ext_vector_type(4)));
typedef float f32x4 __attribute__((ext_vector_type(4)));
__device__ __forceinline__ unsigned f2bf(float f) { unsigned u = __builtin_bit_cast(unsigned, f); return (u + 0x7fffu + ((u >> 16) & 1u)) >> 16; }
__device__ __forceinline__ unsigned pk2(float lo, float hi) { return f2bf(lo) | (f2bf(hi) << 16); }
__device__ __forceinline__ float bflo(unsigned w) { return __builtin_bit_cast(float, w << 16); }
__device__ __forceinline__ float bfhi(unsigned w) { return __builtin_bit_cast(float, w & 0xffff0000u); }
__device__ __forceinline__ float wave_sum(float v) {
#pragma unroll
    for (int o = 1; o < 64; o <<= 1) v += __shfl_xor(v, o);
    return v;
}
__device__ __forceinline__ void tr_item(const float* W, int K, int N, const float* gain, bf16* WT, int drow0, LAS float* scr, int k0, int n0, int lane) {
#pragma unroll 8
    for (int i = 0; i < 32; ++i) { const int kk = 2 * i + (lane >> 5); const float g = gain ? gain[k0 + kk] : 1.0f; scr[kk * 33 + (lane & 31)] = g * W[(size_t)(k0 + kk) * N + n0 + (lane & 31)]; }
    asm volatile("s_waitcnt lgkmcnt(0)" ::: "memory");
    const int c = lane & 7;
#pragma unroll
    for (int j = 0; j < 4; ++j) { const int n = (lane >> 3) + 8 * j; const LAS float* s = scr + (8 * c) * 33 + n;
        v4u o; o.x = pk2(s[0 * 33], s[1 * 33]); o.y = pk2(s[2 * 33], s[3 * 33]); o.z = pk2(s[4 * 33], s[5 * 33]); o.w = pk2(s[6 * 33], s[7 * 33]);
        *(v4u*)(WT + (size_t)(drow0 + n) * K + k0 + 8 * c) = o; }
    asm volatile("s_waitcnt lgkmcnt(0)" ::: "memory");
}
__device__ __forceinline__ int win_drow(int n0) {
    if (n0 < 1280) { const int hd = n0 >> 6, bj = (n0 >> 5) & 1; return 256 * (hd >> 2) + 128 * bj + 32 * (hd & 3); }
    if (n0 < 1792) { const int t = (n0 - 1280) >> 7, w = (n0 - 1280) & 127; return 1280 + 256 * t + w; }
    { const int t = (n0 - 1792) >> 7, w = (n0 - 1792) & 127; return 1280 + 256 * t + 128 + w; }
}
__device__ __forceinline__ long seq_base(int q) { return q < 4 ? 4096L * q : 16384L + 8192L * (q - 4); }

struct Args { const float* in[21]; float* out; unsigned char* ws; };

__global__ void __launch_bounds__(NWAVES * 64, 2) hymba_fwd(Args args) {
    extern __shared__ __attribute__((aligned(16))) unsigned char lds[];
    cg::grid_group grid = cg::this_grid();
    const int tid = threadIdx.x, lane0 = tid & 63, wave = __builtin_amdgcn_readfirstlane(tid >> 6);
    const int G = gridDim.x, bx = blockIdx.x;
    const int gw = bx * NWAVES + wave, NGW = G * NWAVES;
    unsigned char* ws = args.ws;
    unsigned* ctl = (unsigned*)(ws + WS_CTL);
    float* rope = (float*)(ws + WS_ROPE);
    float* stats = (float*)(ws + WS_STATS);
    bf16* Wb = (bf16*)(ws + WS_W);
    bf16* HB = (bf16*)(ws + WS_H);
    bf16* BIG = (bf16*)(ws + WS_BIG);
    bf16* ACT = BIG;
    bf16* Qb = BIG; bf16* Kb = BIG + (size_t)MP * 512; bf16* Vb = BIG + (size_t)MP * 640; bf16* CBb = BIG + (size_t)MP * 768; bf16* Ub = BIG + (size_t)MP * 1280; bf16* Yb = BIG + (size_t)MP * 1792;
    LAS unsigned char* ldsp = (LAS unsigned char*)lds;
    const float* x_prompt = args.in[0]; const float* x_sample = args.in[1]; const float* meta = args.in[2];

    {
        const int lane = lane0;
        if (bx == 0 && tid < 64) ctl[tid] = 0u;
        { const int gt = bx * (NWAVES * 64) + tid;
          if (gt < 2048) { const int pos = gt >> 4, i = gt & 15; const double fr = exp2(-(double)i * (13.287712379549449 / 16.0)); double s, c; sincos((double)pos * fr, &s, &c); rope[2 * gt] = (float)c; rope[2 * gt + 1] = (float)s; } }
        LAS float* scr = (LAS float*)(ldsp + wave * 16384);
        constexpr int I_GU = 16 * 88, I_D = 44 * 32, I_IN = 16 * 72, I_OUT = 16 * 32, I_L = 4 * I_GU + 2 * I_D + I_IN + I_OUT;
        for (int it = gw; it < DEPTH * I_L; it += NGW) {
            const int l = it / I_L; int r = it % I_L; bf16* WL = Wb + (size_t)l * WL_SZ;
            if (r < 4 * I_GU) { const int which = r / I_GU; r %= I_GU; const int kb = r / 88, nb = r % 88, n0 = 32 * nb;
                const float* W = args.in[(which < 2 ? 4 : 17) + (which & 1)] + (size_t)l * DM * DFF; const float* gn = args.in[which < 2 ? 3 : 16] + l * DM;
                tr_item(W, DM, DFF, gn, WL + (which < 2 ? WL_1GU : WL_2GU), 256 * (n0 >> 7) + (n0 & 127) + ((which & 1) ? 128 : 0), scr, 64 * kb, n0, lane); continue; }
            r -= 4 * I_GU;
            if (r < 2 * I_D) { const int which = r / I_D; r %= I_D; const int kb = r / 32, nb = r % 32;
                tr_item(args.in[which ? 19 : 6] + (size_t)l * DFF * DM, DFF, DM, nullptr, WL + (which ? WL_2D : WL_1D), 32 * nb, scr, 64 * kb, 32 * nb, lane); continue; }
            r -= 2 * I_D;
            if (r < I_IN) { const int kb = r / 72, nb = r % 72;
                tr_item(args.in[8] + (size_t)l * DM * NIN, DM, NIN, args.in[7] + l * DM, WL + WL_IN, win_drow(32 * nb), scr, 64 * kb, 32 * nb, lane); continue; }
            r -= I_IN;
            { const int kb = r / 32, nb = r % 32; const int k0 = 64 * kb;
              const float* gn = (k0 < 512) ? (args.in[13] + l * 512 + 0) : (args.in[14] + l * 512 - 512);
              tr_item(args.in[15] + (size_t)l * DM * DM, DM, DM, gn, WL + WL_OUT, 32 * nb, scr, k0, 32 * nb, lane); }
        }
        for (int row = gw; row < MP; row += NGW) {
            const float* src = nullptr;
            if (row < 16384) src = x_prompt + (size_t)row * DM; else if (row < NREAL) src = x_sample + (size_t)(row - 16384) * DM;
            else { const int i = (row - MB) & 63; if (i < 16) src = meta + (size_t)i * DM; }
            f32x4 v[4]; float ss = 0.f;
#pragma unroll
            for (int j = 0; j < 4; ++j) { v[j] = src ? ((const f32x4*)src)[lane + 64 * j] : (f32x4){0.f, 0.f, 0.f, 0.f}; ss += (v[j][0] * v[j][0] + v[j][1] * v[j][1]) + (v[j][2] * v[j][2] + v[j][3] * v[j][3]); }
            ss = wave_sum(ss);
#pragma unroll
            for (int j = 0; j < 4; ++j) {
                ((unsigned long long*)(HB + (size_t)row * DM))[lane + 64 * j] = (unsigned long long)pk2(v[j][0], v[j][1]) | ((unsigned long long)pk2(v[j][2], v[j][3]) << 32); }
            if (lane < 16) stats[(size_t)row * 16 + lane] = (lane == 0) ? ss : 0.f;
        }
    }
    grid.sync();

    for (int l = 0; l < DEPTH; ++l) {
        const bf16* WL = Wb + (size_t)l * WL_SZ;
        for (int s = 0; s < 2; ++s) {
            if (s == 1) {
#ifndef NO_WIN
                { pg8::Gemm g{HB, WL + WL_IN, MP, NIN, DM}; pg8::StaticOrder S; S.init(MP, NIN, G, bx);
                  pg8::EpiWin E{Qb, Kb, Vb, CBb, Ub, stats, args.in[9] + l * 64, args.in[10] + l * 64, rope};
                  pg8::gemm_phase<pg8::EpiWin, pg8::StaticOrder, true, true>(ldsp, g, S, E); }
#endif

                grid.sync();
                {
                    int lane = lane0; asm volatile("" : "+v"(lane));
                    const float* cw = args.in[11] + (size_t)l * 3 * 512; const float* cbias = args.in[12] + (size_t)l * 512;
                    f32x4 w0[2], w1[2], w2[2], bb[2];
#pragma unroll
                    for (int j = 0; j < 2; ++j) { w0[j] = *(const f32x4*)(cw + 8 * lane + 4 * j); w1[j] = *(const f32x4*)(cw + 512 + 8 * lane + 4 * j); w2[j] = *(const f32x4*)(cw + 1024 + 8 * lane + 4 * j); bb[j] = *(const f32x4*)(cbias + 8 * lane + 4 * j); }
                    for (int row = gw; row < MP; row += NGW) {
                        long prev = -1, next = -1; bool valid = true;
                        if (row < NREAL) { const int q = row < 16384 ? (row >> 12) : 4 + ((row - 16384) >> 13); const int nlen = row < 16384 ? 4096 : 8192; const int n = row & (nlen - 1);
                            prev = (n == 0) ? (long)(MB + 64 * q + 15) : (long)row - 1; next = (n == nlen - 1) ? -1L : (long)row + 1; }
                        else { const int q = (row - MB) >> 6, i = (row - MB) & 63; valid = i < 16; prev = (i == 0) ? -1L : (long)row - 1; next = (i == 15) ? seq_base(q) : (long)row + 1; }
                        v4u* yo = (v4u*)(Yb + (size_t)row * 1024 + 512) + lane;
                        if (!valid) { *yo = (v4u){0u, 0u, 0u, 0u}; *((v4u*)(Yb + (size_t)row * 1024) + lane) = (v4u){0u, 0u, 0u, 0u}; continue; }
                        const v4u uc = *((const v4u*)(Ub + (size_t)row * 512) + lane);
                        const v4u up = prev >= 0 ? *((const v4u*)(Ub + (size_t)prev * 512) + lane) : (v4u){0u, 0u, 0u, 0u};
                        const v4u un = next >= 0 ? *((const v4u*)(Ub + (size_t)next * 512) + lane) : (v4u){0u, 0u, 0u, 0u};
                        const v4u cbv = *((const v4u*)(CBb + (size_t)row * 512) + lane);
                        float y[8]; float ss = 0.f;
#pragma unroll
                        for (int e = 0; e < 8; ++e) { const int wi = e >> 1; const bool hi_ = e & 1;
                            const float a = hi_ ? bfhi(up[wi]) : bflo(up[wi]), b = hi_ ? bfhi(uc[wi]) : bflo(uc[wi]), c = hi_ ? bfhi(un[wi]) : bflo(un[wi]), d = hi_ ? bfhi(cbv[wi]) : bflo(cbv[wi]);
                            const float t = a * w0[e >> 2][e & 3] + b * w1[e >> 2][e & 3] + c * w2[e >> 2][e & 3] + bb[e >> 2][e & 3];
                            y[e] = d * t; ss += y[e] * y[e]; }
                        ss += __shfl_xor(ss, 1); ss += __shfl_xor(ss, 2); ss += __shfl_xor(ss, 4);
                        const float rn = rsqrtf(ss * (1.0f / 64.0f) + 1e-6f);
                        v4u o; o.x = pk2(y[0] * rn, y[1] * rn); o.y = pk2(y[2] * rn, y[3] * rn); o.z = pk2(y[4] * rn, y[5] * rn); o.w = pk2(y[6] * rn, y[7] * rn);
                        *yo = o;
                    }
                    __syncthreads();
                    LAS volatile unsigned* qslot = (LAS volatile unsigned*)(ldsp + RING_BYTES);
                    constexpr int NU_S = 8 * 8 * 33, NU_P = 4 * 8 * 17, NU = NU_S + NU_P;
                    for (;;) {
                        if (tid == 0) qslot[0] = atomicAdd(ctl + l, 1u);
                        __syncthreads();
                        const int idx = __builtin_amdgcn_readfirstlane((int)qslot[0]);
                        if (idx >= NU) break;
                        int q, rem, nqb;
                        if (idx < NU_S) { q = 4 + idx / 264; rem = idx % 264; nqb = 32; } else { const int i2 = idx - NU_S; q = i2 / 136; rem = i2 % 136; nqb = 16; }
                        const int h = rem / (nqb + 1), b = rem % (nqb + 1);
                        const long sb = seq_base(q);
#ifndef NO_ATT
                        attn_body::attn_unit<8>(sb + 256L * b, b == nqb ? 1 : 0, sb + 64L * q, nqb * 4, (long)(MB + 64 * q), h,
                            (const attn_body::bf16*)Qb, (const attn_body::bf16*)Kb, (const attn_body::bf16*)Vb, (attn_body::bf16*)Yb, (char*)lds);
#endif

                    }
                }
                grid.sync();
#ifndef NO_WOUT
                { const int Mr = (l == DEPTH - 1) ? NREAL : MP; pg8::Gemm g{Yb, WL + WL_OUT, Mr, DM, DM}; pg8::StaticOrder S; S.init(Mr, DM, G, bx);
                  pg8::EpiResid E{HB, stats, 1.0f};
                  pg8::gemm_phase<pg8::EpiResid, pg8::StaticOrder, true, true>(ldsp, g, S, E); }
#endif

                grid.sync();
            }
#ifndef NO_GU
            { const int Mr = (l == DEPTH - 1 && s == 1) ? NREAL : MP; pg8::Gemm g{HB, WL + (s ? WL_2GU : WL_1GU), Mr, 2 * DFF, DM}; pg8::StaticOrder S; S.init(Mr, 2 * DFF, G, bx);
              pg8::EpiGateUp E{ACT, stats, DFF};
              pg8::gemm_phase<pg8::EpiGateUp, pg8::StaticOrder, true, true>(ldsp, g, S, E); }
#endif

            grid.sync();
#ifndef NO_DOWN
            { const int Mr = (l == DEPTH - 1 && s == 1) ? NREAL : MP; pg8::Gemm g{ACT, WL + (s ? WL_2D : WL_1D), Mr, DM, DFF}; pg8::StaticOrder S; S.init(Mr, DM, G, bx);
              pg8::EpiResid E{HB, stats, 0.5f};
              pg8::gemm_phase<pg8::EpiResid, pg8::StaticOrder, true, true>(ldsp, g, S, E); }
#endif

            grid.sync();
        }
    }
    {
        int lane = lane0; asm volatile("" : "+v"(lane));
        const float* fn = args.in[20]; f32x4 gnv[4];
#pragma unroll
        for (int j = 0; j < 4; ++j) gnv[j] = ((const f32x4*)fn)[lane + 64 * j];
        for (int row = gw; row < NREAL; row += NGW) {
            f32x4 v[4]; float ss = 0.f;
#pragma unroll
            for (int j = 0; j < 4; ++j) { const unsigned long long w = ((const unsigned long long*)(HB + (size_t)row * DM))[lane + 64 * j]; const unsigned lo = (unsigned)w, hi = (unsigned)(w >> 32);
                v[j][0] = bflo(lo); v[j][1] = bfhi(lo); v[j][2] = bflo(hi); v[j][3] = bfhi(hi); ss += (v[j][0] * v[j][0] + v[j][1] * v[j][1]) + (v[j][2] * v[j][2] + v[j][3] * v[j][3]); }
            const float rs = rsqrtf(wave_sum(ss) * (1.0f / 1024.0f) + 1e-6f);
#pragma unroll
            for (int j = 0; j < 4; ++j) ((f32x4*)(args.out + (size_t)row * DM))[lane + 64 * j] = v[j] * rs * gnv[j];
        }
    }
}

extern "C" void kernel_launch(void* const* d_in, const int* in_sizes, int n_in, void* d_out, int out_size, void* d_ws, size_t ws_size, hipStream_t stream) {
    static int grid = 0;
    if (grid == 0) {
        if (n_in != 21 || out_size != NREAL * DM || ws_size < WS_END || in_sizes[8] != DEPTH * DM * NIN) {
            fprintf(stderr, "kernel_launch: unexpected shapes: n_in %d out %d ws %zu (need %zu) w_in %d\n", n_in, out_size, ws_size, (size_t)WS_END, n_in > 8 ? in_sizes[8] : -1); grid = -1; return; }
        int dev = 0, cus = 0, per_cu = 0;
        (void)hipGetDevice(&dev); (void)hipDeviceGetAttribute(&cus, hipDeviceAttributeMultiprocessorCount, dev);
        if (hipFuncSetAttribute((const void*)hymba_fwd, hipFuncAttributeMaxDynamicSharedMemorySize, LDS_BYTES) != hipSuccess) { fprintf(stderr, "kernel_launch: hipFuncSetAttribute failed\n"); grid = -1; return; }
        (void)hipOccupancyMaxActiveBlocksPerMultiprocessor(&per_cu, (const void*)hymba_fwd, NWAVES * 64, LDS_BYTES);
        if (per_cu < 1) { fprintf(stderr, "kernel_launch: occupancy query says %d blocks per CU\n", per_cu); per_cu = 1; }
        (void)hipGetLastError();
        grid = cus;
    }
    if (grid < 0) return;
    Args a{};
    for (int i = 0; i < 21; ++i) a.in[i] = (const float*)d_in[i];
    a.out = (float*)d_out; a.ws = (unsigned char*)d_ws;
    void* kargs[] = {&a};
    hipError_t e = hipLaunchCooperativeKernel((const void*)hymba_fwd, dim3(grid), dim3(NWAVES * 64), kargs, LDS_BYTES, stream);
    if (e != hipSuccess) fprintf(stderr, "cooperative launch failed: %s (grid %d)\n", hipGetErrorString(e), grid);
}
```

```cpp
#include <hip/hip_runtime.h>
#include <hip/hip_cooperative_groups.h>
#include <hip/hip_bf16.h>
#include <cstdio>
#include <cstdint>
#include <cmath>
namespace cg = cooperative_groups;
namespace pg8 {
#define PG8_LAS __attribute__((address_space(3)))
typedef unsigned short bf16_t;
typedef short bf16x8 __attribute__((ext_vector_type(8)));
typedef float f32x4 __attribute__((ext_vector_type(4)));
typedef unsigned u32x4 __attribute__((ext_vector_type(4)));
constexpr int BM = 256, BK = 64, HALF = 128, HTB = HALF * BK * 2  , STAGE_BYTES = 8 * HTB, NXCD = 8, WGM = 8;

__host__ __device__ __forceinline__ int lds_byte(int r, int c) { const int st = (r >> 4) * 2 + (c >> 5), rr = r & 15, cc = c & 31, ob = rr * 64 + cc * 2; return st * 1024 + (ob ^ (((ob >> 9) & 1) << 5)); }
__host__ __device__ __forceinline__ void stage_rc(int b, int& R, int& C) { const int st = b / 1024, sb = b % 1024, swz = sb ^ (((sb >> 9) & 1) << 5); R = (st >> 1) * 16 + swz / 64; C = (st & 1) * 32 + (swz % 64) / 2; }
__host__ __device__ __forceinline__ int perm32(int rho) { const int n = rho >> 4, i = rho & 15; return 8 * (i >> 2) + 4 * n + (i & 3); }

struct Unit { int pm, pn; };
struct Gemm { const bf16_t* A; const bf16_t* Bt; int M, N, K; };

struct StaticOrder {
    int nM, nN, nwg, G, c;
    __host__ __device__ void init(int M, int N, int G_, int c_) { nM = M / BM; nN = N / BM; nwg = nM * nN; G = G_; c = c_; }
    __host__ __device__ bool next(int i, Unit& u) const {
        const long L = (long)i * G + c; if (L >= nwg) return false;
        int wgid = (int)L; { const int q = nwg / NXCD, r = nwg % NXCD, xcd = wgid % NXCD, off = wgid / NXCD; wgid = (xcd < r ? xcd * (q + 1) : r * (q + 1) + (xcd - r) * q) + off; }
        const int nig = WGM * nN, gid = wgid / nig, fm = gid * WGM, gsz = (nM - fm) < WGM ? (nM - fm) : WGM;
        u.pm = fm + ((wgid % nig) % gsz); u.pn = (wgid % nig) / gsz; return true;
    }
    __device__ __forceinline__ void a_ready(const Unit&) const {}
    __device__ __forceinline__ void done(const Unit&) const {}
};

__device__ __forceinline__ unsigned cvt_pk_bf16(float lo, float hi) { unsigned r; asm volatile("v_cvt_pk_bf16_f32 %0, %1, %2" : "=v"(r) : "v"(lo), "v"(hi)); return r; }
constexpr float RMS_EPS = 1e-6f;
__device__ __forceinline__ float row_rstd(const float* stats, int row, int fq) {
    const f32x4 a = *(const f32x4*)(stats + (size_t)row * 16 + 4 * fq);
    float t = (a[0] + a[1]) + (a[2] + a[3]);
    t += __shfl_xor(t, 16); t += __shfl_xor(t, 32);
    return rsqrtf(t * (1.0f / 1024.0f) + RMS_EPS);
}
#define EPI_RS8(rsv) float rsv[8]; _Pragma("unroll") for (int ai_ = 0; ai_ < 2; ++ai_) _Pragma("unroll") for (int m_ = 0; m_ < 4; ++m_) rsv[ai_ * 4 + m_] = row_rstd(stats, row0 + ai_ * HALF + m_ * 16, fq); asm volatile("" ::: "memory")
#define EPI_FENCE() asm volatile("" ::: "memory")
__device__ __forceinline__ float silu_f(float x) { return x * __builtin_amdgcn_rcpf(1.0f + __builtin_amdgcn_exp2f(-1.4426950408889634f * x)); }
__device__ __forceinline__ u32x4 pack8(const f32x4 a, const f32x4 b) { u32x4 w; w.x = cvt_pk_bf16(a[0], a[1]); w.y = cvt_pk_bf16(a[2], a[3]); w.z = cvt_pk_bf16(b[0], b[1]); w.w = cvt_pk_bf16(b[2], b[3]); return w; }

struct EpiGateUp {
    static constexpr bool PERM = true, AFTER_DRAIN = false;
    bf16_t* O; const float* stats; int ldo;
    __device__ __forceinline__ void operator()(const f32x4 (&acc)[2][2][4][2], const Unit& u, int wr, int wc, int fr_in, int fq_in) const {
        int fr = fr_in, fq = fq_in; asm volatile("" : "+v"(fr), "+v"(fq));
        const int row0 = u.pm * BM + wr * 64 + fr, col0 = u.pn * 128 + wc * 32 + 8 * fq;
        EPI_RS8(rsv);
#pragma unroll
        for (int ai = 0; ai < 2; ++ai)
#pragma unroll
            for (int m = 0; m < 4; ++m) { const int row = row0 + ai * HALF + m * 16; const float rs = rsv[ai * 4 + m];
                f32x4 o0, o1;
#pragma unroll
                for (int e = 0; e < 4; ++e) { o0[e] = silu_f(acc[ai][0][m][0][e] * rs) * (acc[ai][1][m][0][e] * rs); o1[e] = silu_f(acc[ai][0][m][1][e] * rs) * (acc[ai][1][m][1][e] * rs); }
                *(u32x4*)(O + (size_t)row * ldo + col0) = pack8(o0, o1); EPI_FENCE(); }
    }
};
struct EpiResid {
    static constexpr bool PERM = true, AFTER_DRAIN = false;
    bf16_t* HB; float* stats; float scale;
    __device__ __forceinline__ void operator()(const f32x4 (&acc)[2][2][4][2], const Unit& u, int wr, int wc, int fr_in, int fq_in) const {
        int fr = fr_in, fq = fq_in; asm volatile("" : "+v"(fr), "+v"(fq));
        const int row0 = u.pm * BM + wr * 64 + fr, col0 = u.pn * BM + wc * 32 + 8 * fq;
#pragma unroll
        for (int ai = 0; ai < 2; ++ai)
#pragma unroll
            for (int m = 0; m < 4; ++m) { const int row = row0 + ai * HALF + m * 16; float ss = 0.f;
#pragma unroll
                for (int bj = 0; bj < 2; ++bj) { u32x4* hp = (u32x4*)(HB + (size_t)row * 1024 + col0 + bj * HALF);
                    const u32x4 w = *hp; f32x4 h0, h1;
                    h0[0] = __uint_as_float(w.x << 16); h0[1] = __uint_as_float(w.x & 0xffff0000u); h0[2] = __uint_as_float(w.y << 16); h0[3] = __uint_as_float(w.y & 0xffff0000u);
                    h1[0] = __uint_as_float(w.z << 16); h1[1] = __uint_as_float(w.z & 0xffff0000u); h1[2] = __uint_as_float(w.w << 16); h1[3] = __uint_as_float(w.w & 0xffff0000u);
                    h0 = h0 + acc[ai][bj][m][0] * scale; h1 = h1 + acc[ai][bj][m][1] * scale;
                    *hp = pack8(h0, h1);
                    ss += ((h0[0] * h0[0] + h0[1] * h0[1]) + (h0[2] * h0[2] + h0[3] * h0[3])) + ((h1[0] * h1[0] + h1[1] * h1[1]) + (h1[2] * h1[2] + h1[3] * h1[3])); }
                ss += __shfl_xor(ss, 16); ss += __shfl_xor(ss, 32);
                if (fq == 0) stats[(size_t)row * 16 + u.pn * 4 + wc] = ss; EPI_FENCE(); }
    }
};
__device__ __forceinline__ int kv_row(int row) {
    if (row < 16384) return row + 64 * (row >> 12);
    if (row < 81920) return row + 64 * (4 + ((row - 16384) >> 13));
    const int q = (row - 81920) >> 6, i = (row - 81920) & 63;
    return (q < 4 ? 4096 * q + 4096 : 16384 + 8192 * (q - 4) + 8192) + 64 * q + i;
}
struct EpiWin {
    static constexpr bool PERM = true, AFTER_DRAIN = false;
    bf16_t *Q, *K, *V, *CB, *U; const float* stats; const float* qg; const float* kg; const float* rope;
    __device__ __forceinline__ void operator()(const f32x4 (&acc)[2][2][4][2], const Unit& u, int wr, int wc, int fr_in, int fq_in) const {
        int fr = fr_in, fq = fq_in; asm volatile("" : "+v"(fr), "+v"(fq));
        const int row0 = u.pm * BM + wr * 64 + fr, pn = u.pn;
        if (pn >= 5) {
            const int col0 = (pn - 5) * 128 + wc * 32 + 8 * fq;
#pragma unroll
            for (int ai = 0; ai < 2; ++ai)
#pragma unroll
                for (int m = 0; m < 4; ++m) { const int row = row0 + ai * HALF + m * 16; const float rs = row_rstd(stats, row, fq), rs2 = rs * rs;
                    const f32x4 o0 = acc[ai][0][m][0] * acc[ai][1][m][0] * rs2, o1 = acc[ai][0][m][1] * acc[ai][1][m][1] * rs2;
                    *(u32x4*)(U + (size_t)row * 512 + col0) = pack8(o0, o1); EPI_FENCE(); }
            return;
        }
        const int hd = 4 * pn + wc;
        const bool is_q = hd < 8, is_k = (hd >= 8 && hd < 10);
        bf16_t* dst; int ldd, cb;
        if (is_q) { dst = Q; ldd = 512; cb = hd * 64; } else if (is_k) { dst = K; ldd = 128; cb = (hd - 8) * 64; }
        else if (hd < 12) { dst = V; ldd = 128; cb = (hd - 10) * 64; } else { dst = CB; ldd = 512; cb = (hd - 12) * 64; }
        cb += 8 * fq;
        if (is_q || is_k) {
            const float* gp = (is_q ? qg : kg) + 8 * fq;
            const float osc = is_q ? (0.125f * 1.4426950408889634f) : 1.0f;
#pragma unroll
            for (int ai = 0; ai < 2; ++ai)
#pragma unroll
                for (int m = 0; m < 4; ++m) { const int row = row0 + ai * HALF + m * 16; const float rs = row_rstd(stats, row, fq);
                    f32x4 v00 = acc[ai][0][m][0] * rs, v01 = acc[ai][0][m][1] * rs, v10 = acc[ai][1][m][0] * rs, v11 = acc[ai][1][m][1] * rs;
                    float ss = ((v00[0] * v00[0] + v00[1] * v00[1]) + (v00[2] * v00[2] + v00[3] * v00[3])) + ((v01[0] * v01[0] + v01[1] * v01[1]) + (v01[2] * v01[2] + v01[3] * v01[3]))
                             + ((v10[0] * v10[0] + v10[1] * v10[1]) + (v10[2] * v10[2] + v10[3] * v10[3])) + ((v11[0] * v11[0] + v11[1] * v11[1]) + (v11[2] * v11[2] + v11[3] * v11[3]));
                    ss += __shfl_xor(ss, 16); ss += __shfl_xor(ss, 32);
                    const float rn = rsqrtf(ss * (1.0f / 64.0f) + RMS_EPS);
                    v00 = v00 * *(const f32x4*)gp * rn; v01 = v01 * *(const f32x4*)(gp + 4) * rn; v10 = v10 * *(const f32x4*)(gp + 32) * rn; v11 = v11 * *(const f32x4*)(gp + 36) * rn;
                    int rp = 0, cp = 0;
                    if (row < 81920) { const int nn = row & (row < 16384 ? 4095 : 8191); rp = nn >> 6; cp = nn & 63; }
                    const float* tr = rope + (size_t)rp * 32 + 8 * fq; const float* tc = rope + (size_t)cp * 32 + 8 * fq;
                    const f32x4 r0 = *(const f32x4*)tr, r1 = *(const f32x4*)(tr + 4), c0 = *(const f32x4*)tc, c1 = *(const f32x4*)(tc + 4);
                    f32x4 o00, o01, o10, o11;
                    o00[0] = v00[0] * r0[0] - v00[1] * r0[1]; o00[1] = v00[0] * r0[1] + v00[1] * r0[0]; o00[2] = v00[2] * r0[2] - v00[3] * r0[3]; o00[3] = v00[2] * r0[3] + v00[3] * r0[2];
                    o01[0] = v01[0] * r1[0] - v01[1] * r1[1]; o01[1] = v01[0] * r1[1] + v01[1] * r1[0]; o01[2] = v01[2] * r1[2] - v01[3] * r1[3]; o01[3] = v01[2] * r1[3] + v01[3] * r1[2];
                    o10[0] = v10[0] * c0[0] - v10[1] * c0[1]; o10[1] = v10[0] * c0[1] + v10[1] * c0[0]; o10[2] = v10[2] * c0[2] - v10[3] * c0[3]; o10[3] = v10[2] * c0[3] + v10[3] * c0[2];
                    o11[0] = v11[0] * c1[0] - v11[1] * c1[1]; o11[1] = v11[0] * c1[1] + v11[1] * c1[0]; o11[2] = v11[2] * c1[2] - v11[3] * c1[3]; o11[3] = v11[2] * c1[3] + v11[3] * c1[2];
                    bf16_t* dp = dst + (size_t)(is_k ? kv_row(row) : row) * ldd + cb;
                    *(u32x4*)dp = pack8(o00 * osc, o01 * osc); *(u32x4*)(dp + 32) = pack8(o10 * osc, o11 * osc); EPI_FENCE(); }
        } else {
#pragma unroll
            for (int ai = 0; ai < 2; ++ai)
#pragma unroll
                for (int m = 0; m < 4; ++m) { const int row = row0 + ai * HALF + m * 16; const float rs = row_rstd(stats, row, fq);
                    bf16_t* dp = dst + (size_t)(hd < 12 ? kv_row(row) : row) * ldd + cb;
                    *(u32x4*)dp = pack8(acc[ai][0][m][0] * rs, acc[ai][0][m][1] * rs); *(u32x4*)(dp + 32) = pack8(acc[ai][1][m][0] * rs, acc[ai][1][m][1] * rs); EPI_FENCE(); }
        }
    }
};

template <class Epi, class Sched, bool ALIGN_EPI = false, bool SP2 = false>
__device__ __forceinline__ void gemm_phase(PG8_LAS unsigned char* lds, const Gemm g, const Sched& S, const Epi& E) {
    int tid_ = threadIdx.x; asm volatile("" : "+v"(tid_));
    const int tid = tid_, wid = __builtin_amdgcn_readfirstlane(tid >> 6), lane = tid & 63, wr = wid >> 2, wc = wid & 3, fr = lane & 15, fq = lane >> 4;
    const int K = g.K, nt = K / BK;
    unsigned voffA[2], voffB[2];
#pragma unroll
    for (int i = 0; i < 2; ++i) { int R, C; stage_rc(tid * 16 + i * 8192, R, C); const int Rb = Epi::PERM ? ((R & ~31) + perm32(R & 31)) : R;
        voffA[i] = (unsigned)(R * K + C) * 2u; voffB[i] = (unsigned)(Rb * K + C) * 2u; }
    const size_t kstep = (size_t)(BK * 2);
    const size_t hstep = (size_t)HALF * K * 2;
    const size_t tstep = 2 * hstep;
    const unsigned ldsw = (unsigned)wid * 1024u;
    const int aoff = lds_byte(wr * 64 + fr, fq * 8), boff = lds_byte(wc * 32 + fr, fq * 8);
#define PG8_SA(b, h) (((b) * 2 + (h)) * HTB)
#define PG8_SB(b, h) ((4 + (b) * 2 + (h)) * HTB)
#define PG8_STAGE(bufoff, gbase, voff) do { _Pragma("unroll") for (int _i = 0; _i < 2; ++_i) \
        __builtin_amdgcn_global_load_lds((const unsigned*)((const char*)(gbase) + (voff)[_i]), (PG8_LAS unsigned*)(lds + (bufoff) + ldsw + _i * 8192), 16, 0, 0); } while (0)
#define PG8_LDA(dst, b, h) do { _Pragma("unroll") for (int m = 0; m < 4; ++m) _Pragma("unroll") for (int k = 0; k < 2; ++k) dst[m][k] = *(const PG8_LAS bf16x8*)(lds + PG8_SA(b, h) + aoff + m * 2048 + k * 1024); } while (0)
#define PG8_LDB(dst, b, h) do { _Pragma("unroll") for (int n = 0; n < 2; ++n) _Pragma("unroll") for (int k = 0; k < 2; ++k) dst[n][k] = *(const PG8_LAS bf16x8*)(lds + PG8_SB(b, h) + boff + n * 2048 + k * 1024); } while (0)
#define PG8_MMA(ai, bj, At, Bt) do { __builtin_amdgcn_s_setprio(1); _Pragma("unroll") for (int m = 0; m < 4; ++m) _Pragma("unroll") for (int n = 0; n < 2; ++n) _Pragma("unroll") for (int k = 0; k < 2; ++k) \
        acc[ai][bj][m][n] = __builtin_amdgcn_mfma_f32_16x16x32_bf16(Bt[n][k], At[m][k], acc[ai][bj][m][n], 0, 0, 0); __builtin_amdgcn_s_setprio(0); } while (0)
#define PG8_WAIT_V(n) asm volatile("s_waitcnt vmcnt(" #n ")" ::: "memory")
#define PG8_WAIT_L(n) asm volatile("s_waitcnt lgkmcnt(" #n ")" ::: "memory")
#define PG8_BAR __builtin_amdgcn_s_barrier()
#define PG8_SCHED __builtin_amdgcn_sched_barrier(0)
    Unit cur, nxt; int ui = 0;
    if (!S.next(0, cur)) return;
    f32x4 acc[2][2][4][2];
#pragma unroll
    for (int a = 0; a < 2; ++a)
#pragma unroll
        for (int b = 0; b < 2; ++b)
#pragma unroll
            for (int m = 0; m < 4; ++m)
#pragma unroll
                for (int n = 0; n < 2; ++n) acc[a][b][m][n] = (f32x4){0.f, 0.f, 0.f, 0.f};
    bf16x8 At[4][2], B0[2][2], B1[2][2];
    const char* cA = (const char*)g.A + (size_t)cur.pm * tstep; const char* cB = (const char*)g.Bt + (size_t)cur.pn * tstep;
    S.a_ready(cur);
    if constexpr (SP2) {
        PG8_STAGE(PG8_SB(0, 0), cB, voffB); PG8_STAGE(PG8_SB(0, 1), cB + hstep, voffB); PG8_STAGE(PG8_SA(0, 0), cA, voffA); PG8_STAGE(PG8_SA(0, 1), cA + hstep, voffA);
        if (wr == 1) PG8_BAR;
        PG8_WAIT_V(2); PG8_BAR;
        PG8_STAGE(PG8_SB(1, 0), cB + kstep, voffB); PG8_STAGE(PG8_SA(1, 0), cA + kstep, voffA); PG8_STAGE(PG8_SB(1, 1), cB + hstep + kstep, voffB);
        PG8_WAIT_V(6); PG8_BAR;
    } else {
        PG8_STAGE(PG8_SB(0, 0), cB, voffB); PG8_STAGE(PG8_SA(0, 0), cA, voffA); PG8_STAGE(PG8_SB(0, 1), cB + hstep, voffB); PG8_STAGE(PG8_SA(0, 1), cA + hstep, voffA);
        if (wr == 1) PG8_BAR;
        PG8_WAIT_V(4); PG8_BAR;
        PG8_STAGE(PG8_SB(1, 0), cB + kstep, voffB); PG8_STAGE(PG8_SA(1, 0), cA + kstep, voffA); PG8_STAGE(PG8_SB(1, 1), cB + hstep + kstep, voffB);
        PG8_WAIT_V(6); PG8_BAR;
    }
    for (;;) {
        const bool has_next = S.next(ui + 1, nxt);
        const char* nA = has_next ? (const char*)g.A + (size_t)nxt.pm * tstep : cA; const char* nB = has_next ? (const char*)g.Bt + (size_t)nxt.pn * tstep : cB;
        for (int t = 0; t < nt; t += 2) {
            const bool last = (t == nt - 2);
            const char* a1 = cA + (size_t)(t + 1) * kstep;
            const char* a2 = last ? nA : cA + (size_t)(t + 2) * kstep; const char* b2 = last ? nB : cB + (size_t)(t + 2) * kstep;
            const char* a3 = a2 + kstep; const char* b3 = b2 + kstep;
            if (last && has_next) S.a_ready(nxt);
            if constexpr (SP2) {
            PG8_LDB(B0, 0, 0); PG8_LDB(B1, 0, 1); PG8_SCHED; PG8_LDA(At, 0, 0); PG8_STAGE(PG8_SA(1, 1), a1 + hstep, voffA);
            PG8_WAIT_V(8); PG8_WAIT_L(0); PG8_BAR; PG8_MMA(0, 0, At, B0); PG8_MMA(0, 1, At, B1); PG8_BAR; PG8_SCHED;
            PG8_LDA(At, 0, 1); PG8_STAGE(PG8_SB(0, 0), b2, voffB); PG8_STAGE(PG8_SB(0, 1), b2 + hstep, voffB); PG8_STAGE(PG8_SA(0, 0), a2, voffA);
            PG8_WAIT_V(8); PG8_WAIT_L(0); PG8_BAR; PG8_MMA(1, 0, At, B0); PG8_MMA(1, 1, At, B1); PG8_BAR; PG8_SCHED;
            PG8_LDB(B0, 1, 0); PG8_LDB(B1, 1, 1); PG8_SCHED; PG8_LDA(At, 1, 0); PG8_STAGE(PG8_SA(0, 1), a2 + hstep, voffA);
            PG8_WAIT_V(8); PG8_WAIT_L(0); PG8_BAR; PG8_MMA(0, 0, At, B0); PG8_MMA(0, 1, At, B1); PG8_BAR; PG8_SCHED;
            PG8_LDA(At, 1, 1); PG8_STAGE(PG8_SB(1, 0), b3, voffB); PG8_STAGE(PG8_SB(1, 1), b3 + hstep, voffB); PG8_STAGE(PG8_SA(1, 0), a3, voffA);
            PG8_WAIT_V(8); PG8_WAIT_L(0); PG8_BAR; PG8_MMA(1, 0, At, B0); PG8_MMA(1, 1, At, B1); PG8_BAR; PG8_SCHED;
            } else {
            PG8_LDB(B0, 0, 0); PG8_SCHED; PG8_LDA(At, 0, 0); PG8_STAGE(PG8_SA(1, 1), a1 + hstep, voffA);
            PG8_WAIT_L(8); PG8_BAR; PG8_WAIT_L(0); PG8_MMA(0, 0, At, B0); PG8_BAR; PG8_SCHED;
            PG8_LDB(B1, 0, 1); PG8_STAGE(PG8_SB(0, 0), b2, voffB);
            PG8_BAR; PG8_WAIT_L(0); PG8_MMA(0, 1, At, B1); PG8_BAR;
            PG8_LDA(At, 0, 1); PG8_STAGE(PG8_SA(0, 0), a2, voffA);
            PG8_BAR; PG8_WAIT_L(0); PG8_MMA(1, 0, At, B0); PG8_BAR; PG8_SCHED;
            PG8_STAGE(PG8_SB(0, 1), b2 + hstep, voffB);
            PG8_WAIT_V(6); PG8_BAR; PG8_MMA(1, 1, At, B1); PG8_BAR;
            PG8_LDB(B0, 1, 0); PG8_SCHED; PG8_LDA(At, 1, 0); PG8_STAGE(PG8_SA(0, 1), a2 + hstep, voffA);
            PG8_WAIT_L(8); PG8_BAR; PG8_WAIT_L(0); PG8_MMA(0, 0, At, B0); PG8_BAR; PG8_SCHED;
            PG8_LDB(B1, 1, 1); PG8_STAGE(PG8_SB(1, 0), b3, voffB);
            PG8_BAR; PG8_WAIT_L(0); PG8_MMA(0, 1, At, B1); PG8_BAR;
            PG8_LDA(At, 1, 1); PG8_STAGE(PG8_SA(1, 0), a3, voffA);
            PG8_BAR; PG8_WAIT_L(0); PG8_MMA(1, 0, At, B0); PG8_BAR; PG8_SCHED;
            PG8_STAGE(PG8_SB(1, 1), b3 + hstep, voffB);
            PG8_WAIT_V(6); PG8_BAR; PG8_MMA(1, 1, At, B1); PG8_BAR;
            }
        }
        if constexpr (ALIGN_EPI) { if (wr == 0) PG8_BAR; }
        if constexpr (!Epi::AFTER_DRAIN) { E(acc, cur, wr, wc, fr, fq); S.done(cur); }
        if (!has_next) break;
#pragma unroll
        for (int a = 0; a < 2; ++a)
#pragma unroll
            for (int b = 0; b < 2; ++b)
#pragma unroll
                for (int m = 0; m < 4; ++m)
#pragma unroll
                    for (int n = 0; n < 2; ++n) acc[a][b][m][n] = (f32x4){0.f, 0.f, 0.f, 0.f};
        cur = nxt; cA = nA; cB = nB; ++ui;
        if constexpr (ALIGN_EPI) { if (wr == 1) PG8_BAR; }
    }
    PG8_WAIT_V(0);
    if constexpr (!ALIGN_EPI) { if (wr == 0) PG8_BAR; }
    PG8_BAR;
    if constexpr (Epi::AFTER_DRAIN) { E.fused(acc, cur, wr, wc, fr, fq, lds, wid, lane); S.done(cur); }
#undef PG8_SA
#undef PG8_SB
#undef PG8_STAGE
#undef PG8_LDA
#undef PG8_LDB
#undef PG8_MMA
#undef PG8_WAIT_V
#undef PG8_WAIT_L
#undef PG8_BAR
#undef PG8_SCHED
}
}

namespace attn_body {
using bf16=__hip_bfloat16;
using bf16x8=__attribute__((ext_vector_type(8)))short;
using s16x4=__attribute__((ext_vector_type(4)))short;
using f32x16=__attribute__((ext_vector_type(16)))float;
using u32x4=__attribute__((ext_vector_type(4)))unsigned;
constexpr int D=64,QP=512,KP=128,OP=1024;
typedef float f32x4 __attribute__((ext_vector_type(4)));
constexpr int NW=8,QBLK=32,QB=QBLK*NW,KVBLK=64;
__device__ __forceinline__ int crow(int r,int hi){return (r&3)+8*(r>>2)+4*hi;}
#define SBAR() __builtin_amdgcn_sched_barrier(0)
#define ATTN_STORE16(p,v) (*(u32x4*)(p)=(v))
__device__ __forceinline__ void mmask(f32x16&p0,f32x16&p1,bool any,bool all){
  const float NEG=-INFINITY;
  #pragma unroll
  for(int r=0;r<16;++r){p1[r]=any?NEG:p1[r]; p0[r]=((r>=8)?any:all)?NEG:p0[r];}
}
constexpr int NSLOT=3, SLOTB=8192;
constexpr int LDS_K=0, LDS_V=NSLOT*SLOTB, LDS_WS=2*NSLOT*SLOTB, LDS_OST=LDS_WS+NW*64*4, LDS_BYTES=LDS_OST+NW*4096;
constexpr float C2=0.125f*1.4426950408889634f;
__device__ __forceinline__ void glds16(const void*gsrc,unsigned lds_dst){unsigned keep;
  asm volatile("s_mov_b32 %0, m0\n\ts_mov_b32 m0, %2\n\ts_nop 0\n\tglobal_load_lds_dwordx4 %1, off\n\ts_mov_b32 m0, %0":"=&s"(keep):"v"(gsrc),"s"(lds_dst):"memory");}
__device__ __forceinline__ float max3f(float a,float b,float c){float r;asm("v_max3_f32 %0, %1, %2, %3":"=v"(r):"v"(a),"v"(b),"v"(c));return r;}
__device__ __forceinline__ float max2f(float a,float b){float r;asm("v_max_f32_e32 %0, %1, %2":"=v"(r):"v"(a),"v"(b));return r;}
__device__ __forceinline__ float fadd_s(float a,float b){float r;asm("v_add_f32_e32 %0, %1, %2":"=v"(r):"v"(a),"v"(b));return r;}
__device__ __forceinline__ float fsub_s(float a,float b){float r;asm("v_sub_f32_e32 %0, %1, %2":"=v"(r):"v"(a),"v"(b));return r;}
typedef float f32x2_t __attribute__((ext_vector_type(2))); typedef __bf16 bf16x2_t __attribute__((ext_vector_type(2)));
__device__ __forceinline__ unsigned cvtpk_s(float lo,float hi){f32x2_t v={lo,hi};bf16x2_t b=__builtin_convertvector(v,bf16x2_t);return __builtin_bit_cast(unsigned,b);}
#define WAIT_BAR(N) asm volatile("s_waitcnt vmcnt(" #N ") lgkmcnt(0)\n\ts_barrier":::"memory")

__device__ __forceinline__ void qkt(f32x16&p0,f32x16&p1,const char*Kslot,const bf16x8*qr,const f32x16&negm,int r32,int hi){
  const char*kb=Kslot+hi*1024+r32*16;
  #pragma unroll
  for(int d0=0;d0<4;++d0){
    const bf16x8 b0=*reinterpret_cast<const bf16x8*>(kb+d0*2048);
    const bf16x8 b1=*reinterpret_cast<const bf16x8*>(kb+d0*2048+512);
    if(d0==0){p0=__builtin_amdgcn_mfma_f32_32x32x16_bf16(b0,qr[0],negm,0,0,0);p1=__builtin_amdgcn_mfma_f32_32x32x16_bf16(b1,qr[0],negm,0,0,0);}
    else{p0=__builtin_amdgcn_mfma_f32_32x32x16_bf16(b0,qr[d0],p0,0,0,0);p1=__builtin_amdgcn_mfma_f32_32x32x16_bf16(b1,qr[d0],p1,0,0,0);}}
}
typedef __attribute__((address_space(3))) const char* lds_cptr;
typedef short v4i16_t __attribute__((ext_vector_type(4)));
__device__ __forceinline__ void kload8(bf16x8*kf,lds_cptr kp){
  kf[0]=*(const __attribute__((address_space(3))) bf16x8*)(kp);      kf[1]=*(const __attribute__((address_space(3))) bf16x8*)(kp+512);
  kf[2]=*(const __attribute__((address_space(3))) bf16x8*)(kp+2048); kf[3]=*(const __attribute__((address_space(3))) bf16x8*)(kp+2560);
  kf[4]=*(const __attribute__((address_space(3))) bf16x8*)(kp+4096); kf[5]=*(const __attribute__((address_space(3))) bf16x8*)(kp+4608);
  kf[6]=*(const __attribute__((address_space(3))) bf16x8*)(kp+6144); kf[7]=*(const __attribute__((address_space(3))) bf16x8*)(kp+6656);
}
__device__ __forceinline__ void kload2(bf16x8*kf,lds_cptr kp,int j){ kf[2*j]=*(const __attribute__((address_space(3))) bf16x8*)(kp+j*2048); kf[2*j+1]=*(const __attribute__((address_space(3))) bf16x8*)(kp+j*2048+512); }
__device__ __forceinline__ s16x4 vtr(lds_cptr p){ return __builtin_bit_cast(s16x4,__builtin_amdgcn_ds_read_tr16_b64_v4i16((__attribute__((address_space(3))) v4i16_t*)p)); }
__device__ __forceinline__ float rowmax(const f32x16&p0,const f32x16&p1){
  float a=max3f(p0[0],p0[1],p1[0]),b=max3f(p0[2],p0[3],p1[1]);a=max3f(a,p1[2],p1[3]);
  #pragma unroll
  for(int r=4;r<16;r+=4){a=max3f(a,p0[r],p0[r+1]);b=max3f(b,p0[r+2],p0[r+3]);a=max3f(a,p1[r],p1[r+1]);b=max3f(b,p1[r+2],p1[r+3]);}
  const float m=max2f(a,b);
  auto rr=__builtin_amdgcn_permlane32_swap(__float_as_uint(m),__float_as_uint(m),false,false);
  return max2f(__uint_as_float(rr[0]),__uint_as_float(rr[1]));
}
__device__ __forceinline__ void pv(f32x16*o,int vb,bf16x8 pa0,bf16x8 pa1,bf16x8 pa2,bf16x8 pa3){
  #pragma unroll
  for(int d0=0;d0<2;++d0){s16x4 lo[4],hi[4];
    #pragma unroll
    for(int ks=0;ks<4;++ks){
      asm volatile("ds_read_b64_tr_b16 %0,%1 offset:%c2":"=&v"(lo[ks]):"v"(vb),"i"(d0*4096+ks*1024):"memory");
      asm volatile("ds_read_b64_tr_b16 %0,%1 offset:%c2":"=&v"(hi[ks]):"v"(vb),"i"(d0*4096+ks*1024+512):"memory");}
    asm volatile("s_waitcnt lgkmcnt(0)":::"memory");SBAR();
    #define PK(k) (bf16x8){lo[k][0],lo[k][1],lo[k][2],lo[k][3],hi[k][0],hi[k][1],hi[k][2],hi[k][3]}
    o[d0]=__builtin_amdgcn_mfma_f32_32x32x16_bf16(pa0,PK(0),o[d0],0,0,0);
    o[d0]=__builtin_amdgcn_mfma_f32_32x32x16_bf16(pa1,PK(1),o[d0],0,0,0);
    o[d0]=__builtin_amdgcn_mfma_f32_32x32x16_bf16(pa2,PK(2),o[d0],0,0,0);
    o[d0]=__builtin_amdgcn_mfma_f32_32x32x16_bf16(pa3,PK(3),o[d0],0,0,0);
    #undef PK
  }
}

template<int THRL> __device__ __forceinline__ void attn_unit(long qrow0,int is_meta,long kvbase,int NR,long metarow,int h,const bf16*Q,const bf16*__restrict__ K,const bf16*__restrict__ V,bf16*O,char*shm){
  int tid_=threadIdx.x; asm volatile("":"+v"(tid_)); const int tid=tid_,lane=tid&63,r32=lane&31,hi=lane>>5; const int wid=__builtin_amdgcn_readfirstlane(tid>>6);
  const long qrow_l=is_meta?(metarow+(long)(r32&15)):(qrow0+wid*QBLK+r32);
  const int h_l=is_meta?(h+2*(wid&1)+(r32>>4)):h;
  const bf16*Qw=Q+qrow_l*QP+h_l*D;
  const bf16*Kh=K+(h>>2)*D,*Vh=V+(h>>2)*D;
  const unsigned lds0=(unsigned)(uintptr_t)shm;
  float*wsf=(float*)(shm+LDS_WS)+wid*64;
  const bf16*ksrc=Kh+(long)lane*KP+wid*8;
  const bf16*vsrc=Vh+(long)(16*(wid&3)+(lane>>2))*KP+(wid>>2)*32+(lane&3)*8;
  #define TROW(t) (kvbase+(long)(t)*KVBLK)
  const unsigned kdst=lds0+LDS_K+wid*1024, vdst=lds0+LDS_V+wid*1024;
  #define DMA_K(t,slot) glds16(ksrc+TROW(t)*KP,(unsigned)__builtin_amdgcn_readfirstlane(kdst+(slot)))
  #define DMA_V(t,slot) glds16(vsrc+TROW(t)*KP,(unsigned)__builtin_amdgcn_readfirstlane(vdst+(slot)))
  const int vb0=(int)(lds0+LDS_V)+((lane>>4)&1)*32+(lane&3)*8+(4*hi+((lane&15)>>2))*64;
  const char*Kbase=shm+LDS_K; bf16x8 kf[8];
  const lds_cptr shm3=(lds_cptr)shm; const lds_cptr kp0=shm3+LDS_K+hi*1024+r32*16; const lds_cptr vp0=shm3+LDS_V+((lane>>4)&1)*32+(lane&3)*8+(4*hi+((lane&15)>>2))*64;
  const int NT=NR+2;
  DMA_K(0,0);DMA_V(0,0);DMA_K(1,SLOTB);
  bf16x8 qr[4];
  #pragma unroll
  for(int d0=0;d0<4;++d0)qr[d0]=*reinterpret_cast<const bf16x8*>(&Qw[d0*16+hi*8]);
  float mhat=0.f,l_reg=0.f;f32x16 o[2];o[0]=f32x16{};o[1]=f32x16{};f32x16 negm=f32x16{};asm volatile("":"+v"(negm));
  #define CMASK(P0,P1,t) do{ mmask(P0,P1,(t)>=NT-2,(t)==NT-1); }while(0)
  bool resc=false;
  #define START(P0,P1) do{ const float rm=rowmax(P0,P1); resc=false; \
    { const float dl=rm; mhat=fadd_s(mhat,dl); \
      _Pragma("unroll") for(int r=0;r<16;++r){P0[r]=fsub_s(P0[r],dl);P1[r]=fsub_s(P1[r],dl);} \
      _Pragma("unroll") for(int r=0;r<16;++r)negm[r]=-mhat; asm volatile("":"+v"(negm)); } \
    _Pragma("unroll") for(int r=0;r<16;++r)P0[r]=__builtin_amdgcn_exp2f(P0[r]); }while(0)
  #define RESC() do{ if(resc){ asm volatile("s_waitcnt lgkmcnt(0)":::"memory"); \
      _Pragma("unroll") for(int d_=0;d_<2;++d_) _Pragma("unroll") for(int r=0;r<16;++r)o[d_][r]*=wsf[crow(r,hi)]; } }while(0)
  f32x16 pA0,pA1,pB0,pB1;
  int sl_prev=0,sl_cur=0,sl_next=SLOTB;
  #define ROT() do{sl_prev=sl_cur;sl_cur=sl_next;sl_next=(sl_next==(NSLOT-1)*SLOTB)?0:sl_next+SLOTB;}while(0)
  DMA_K(2,2*SLOTB);
  WAIT_BAR(3);
  qkt(pA0,pA1,Kbase,qr,negm,r32,hi);asm volatile("s_nop 15\n\ts_nop 7":"+v"(pA0),"+v"(pA1));
  START(pA0,pA1);
  _Pragma("unroll") for(int r=0;r<16;++r)pA1[r]=__builtin_amdgcn_exp2f(pA1[r]);
  WAIT_BAR(0);
  DMA_K(3,0);DMA_V(1,SLOTB);
  ROT();
  kload8(kf,kp0+sl_cur);
  WAIT_BAR(2);
  s16x4 vlo[8],vhi[8]; u32x4 pw0,pw1,pw2,pw3;
  #define PKW(P,B) cvtpk_s(P[B],P[B+1])
  #define PAF(k) __builtin_bit_cast(bf16x8,pw##k)
  #define VFR(i) (bf16x8){vlo[i][0],vlo[i][1],vlo[i][2],vlo[i][3],vhi[i][0],vhi[i][1],vhi[i][2],vhi[i][3]}
  #define PIN(x) asm volatile("":"+v"(x))
  #define MX3(a,b,c) __builtin_fmaxf(__builtin_fmaxf((a),(b)),(c))
  #define GAPA(MF,A0,A1,A2,A3,W0,W1,PW) do{ MF; sacc+=A0; sacc+=A1; sacc+=A2; sacc+=A3; PIN(sacc); W0; W1; PIN(PW); SBAR(); }while(0)
  #define EX(v) __builtin_amdgcn_exp2f(v)
  #define GAPB(MF,X,B) do{ MF; X[B]=EX(X[B]); X[B+1]=EX(X[B+1]); X[B+2]=EX(X[B+2]); X[B+3]=EX(X[B+3]); PIN(X); SBAR(); }while(0)
  #define VRD(i) do{ vlo[i]=vtr(vp_+(((i)>>2)*4096+((i)&3)*1024)); vhi[i]=vtr(vp_+(((i)>>2)*4096+((i)&3)*1024+512)); }while(0)
  #define KRD(G,j) do{ if(G){ kload2(kf,kp0+sl_next,j); SBAR(); } }while(0)
  #define STEP(C0,C1,P0,P1,t,GK,GV,GL) do{ SBAR(); \
    const lds_cptr vp_=vp0+sl_prev; \
    VRD(0); SBAR(); float sacc=(P0[0]+P0[1]); \
    GAPA(C0=__builtin_amdgcn_mfma_f32_32x32x16_bf16(kf[0],qr[0],negm,0,0,0), P0[2],P0[3],P0[4],P0[5],     pw0[0]=PKW(P0,0), pw0[1]=PKW(P0,2), pw0); \
    VRD(4); SBAR(); GAPA(C1=__builtin_amdgcn_mfma_f32_32x32x16_bf16(kf[1],qr[0],negm,0,0,0), P0[6],P0[7],P0[8],P0[9],     pw0[2]=PKW(P0,4), pw0[3]=PKW(P0,6), pw0); \
    VRD(1); SBAR(); GAPA(C0=__builtin_amdgcn_mfma_f32_32x32x16_bf16(kf[2],qr[1],C0,0,0,0),   P0[10],P0[11],P0[12],P0[13], pw1[0]=PKW(P0,8), pw1[1]=PKW(P0,10), pw1); \
    VRD(5); SBAR(); GAPA(C1=__builtin_amdgcn_mfma_f32_32x32x16_bf16(kf[3],qr[1],C1,0,0,0),   P0[14],P0[15],P1[0],P1[1],   pw1[2]=PKW(P0,12),pw1[3]=PKW(P0,14), pw1); \
    VRD(2); SBAR(); GAPA(C0=__builtin_amdgcn_mfma_f32_32x32x16_bf16(kf[4],qr[2],C0,0,0,0),   P1[2],P1[3],P1[4],P1[5],     pw2[0]=PKW(P1,0), pw2[1]=PKW(P1,2), pw2); \
    VRD(6); SBAR(); GAPA(C1=__builtin_amdgcn_mfma_f32_32x32x16_bf16(kf[5],qr[2],C1,0,0,0),   P1[6],P1[7],P1[8],P1[9],     pw2[2]=PKW(P1,4), pw2[3]=PKW(P1,6), pw2); \
    VRD(3); SBAR(); GAPA(C0=__builtin_amdgcn_mfma_f32_32x32x16_bf16(kf[6],qr[3],C0,0,0,0),   P1[10],P1[11],P1[12],P1[13], pw3[0]=PKW(P1,8), pw3[1]=PKW(P1,10), pw3); \
    VRD(7); SBAR(); GAPA(C1=__builtin_amdgcn_mfma_f32_32x32x16_bf16(kf[7],qr[3],C1,0,0,0),   P1[14],P1[15],0.f,0.f,       pw3[2]=PKW(P1,12),pw3[3]=PKW(P1,14), pw3); \
    l_reg+=sacc; \
    if(GK){DMA_K((t)+3,sl_cur);} if(GV){DMA_V((t)+1,sl_next);} \
    CMASK(C0,C1,t); \
    { float a=MX3(C0[0],C0[1],C1[0]),b=MX3(C0[2],C0[3],C1[1]); a=MX3(a,C1[2],C1[3]); \
      _Pragma("unroll") for(int r=4;r<16;r+=4){a=MX3(a,C0[r],C0[r+1]);b=MX3(b,C0[r+2],C0[r+3]);a=MX3(a,C1[r],C1[r+1]);b=MX3(b,C1[r+2],C1[r+3]);} \
      float rm=__builtin_fmaxf(a,b); { auto rr=__builtin_amdgcn_permlane32_swap(__float_as_uint(rm),__float_as_uint(rm),false,false); rm=__builtin_fmaxf(__uint_as_float(rr[0]),__uint_as_float(rr[1])); } \
      resc=false; \
      if(__builtin_expect(__any(rm>(float)THRL),0)){ const float dl=__builtin_fmaxf(rm,0.f); mhat+=dl; \
        _Pragma("unroll") for(int r=0;r<16;++r){C0[r]-=dl;C1[r]-=dl;} \
        _Pragma("unroll") for(int r=0;r<16;++r)negm[r]=-mhat; asm volatile("":"+v"(negm)); \
        const float f=__builtin_amdgcn_exp2f(-dl); l_reg*=f; if(hi==0)wsf[r32]=f; resc=true; } } \
    SBAR(); \
    GAPB(o[0]=__builtin_amdgcn_mfma_f32_32x32x16_bf16(PAF(0),VFR(0),o[0],0,0,0), C0,0); \
    GAPB(o[1]=__builtin_amdgcn_mfma_f32_32x32x16_bf16(PAF(0),VFR(4),o[1],0,0,0), C0,4); \
    KRD(GL,0); GAPB(o[0]=__builtin_amdgcn_mfma_f32_32x32x16_bf16(PAF(1),VFR(1),o[0],0,0,0), C0,8); \
    KRD(GL,1); GAPB(o[1]=__builtin_amdgcn_mfma_f32_32x32x16_bf16(PAF(1),VFR(5),o[1],0,0,0), C0,12); \
    KRD(GL,2); GAPB(o[0]=__builtin_amdgcn_mfma_f32_32x32x16_bf16(PAF(2),VFR(2),o[0],0,0,0), C1,0); \
    KRD(GL,3); GAPB(o[1]=__builtin_amdgcn_mfma_f32_32x32x16_bf16(PAF(2),VFR(6),o[1],0,0,0), C1,4); \
    GAPB(o[0]=__builtin_amdgcn_mfma_f32_32x32x16_bf16(PAF(3),VFR(3),o[0],0,0,0), C1,8); \
    GAPB(o[1]=__builtin_amdgcn_mfma_f32_32x32x16_bf16(PAF(3),VFR(7),o[1],0,0,0), C1,12); \
    }while(0)
  int t=1;
  #undef CMASK
  #define CMASK(P0,P1,t) do{}while(0)
  for(;t+5<NT;t+=2){
    STEP(pB0,pB1,pA0,pA1,t,true,true,true);     WAIT_BAR(2); RESC(); ROT();
    STEP(pA0,pA1,pB0,pB1,t+1,true,true,true);   WAIT_BAR(2); RESC(); ROT();
  }
  #undef CMASK
  #define CMASK(P0,P1,t) do{ mmask(P0,P1,(t)>=NT-2,(t)==NT-1); }while(0)
  #define ENDW(tt) do{ if((tt)+3<NT){WAIT_BAR(2);} else if((tt)+2<NT){WAIT_BAR(1);} else {WAIT_BAR(0);} }while(0)
  for(;t+1<NT;t+=2){
    STEP(pB0,pB1,pA0,pA1,t,(t+3<NT),(t+1<NT),(t+1<NT));       ENDW(t);   RESC(); ROT();
    STEP(pA0,pA1,pB0,pB1,t+1,(t+4<NT),(t+2<NT),(t+2<NT));     ENDW(t+1); RESC(); ROT();
  }
  STEP(pB0,pB1,pA0,pA1,NT-1,false,false,false); RESC();
  { float sacc=pB0[0]+pB0[1]; _Pragma("unroll") for(int r=2;r<16;++r)sacc+=pB0[r]; _Pragma("unroll") for(int r=0;r<16;++r)sacc+=pB1[r]; l_reg+=sacc;
    pw0=(u32x4){PKW(pB0,0),PKW(pB0,2),PKW(pB0,4),PKW(pB0,6)};pw1=(u32x4){PKW(pB0,8),PKW(pB0,10),PKW(pB0,12),PKW(pB0,14)};pw2=(u32x4){PKW(pB1,0),PKW(pB1,2),PKW(pB1,4),PKW(pB1,6)};pw3=(u32x4){PKW(pB1,8),PKW(pB1,10),PKW(pB1,12),PKW(pB1,14)};
    SBAR(); pv(o,vb0+sl_cur,PAF(0),PAF(1),PAF(2),PAF(3)); }
  #undef PKW
  #undef PAF
  #undef VFR
  #undef PIN
  #undef MX3
  #undef GAPA
  #undef GAPB
  #undef EX
  #undef VRD
  #undef KRD
  #undef STEP
  #undef ENDW
  {auto rr=__builtin_amdgcn_permlane32_swap(__float_as_uint(l_reg),__float_as_uint(l_reg),false,false);l_reg=__uint_as_float(rr[0])+__uint_as_float(rr[1]);}
  if(hi==0)wsf[32+r32]=l_reg;asm volatile("s_waitcnt lgkmcnt(0)":::"memory");
  float rli[16];
  #pragma unroll
  for(int r=0;r<16;++r)rli[r]=__builtin_amdgcn_rcpf(wsf[32+crow(r,hi)]);
  { bf16*stg=(bf16*)(shm+LDS_OST)+wid*2048;
    #pragma unroll
    for(int r=0;r<16;++r){const int orow=crow(r,hi);
      #pragma unroll
      for(int d0=0;d0<2;++d0)stg[orow*64+d0*32+r32]=__float2bfloat16(o[d0][r]*rli[r]);}
    asm volatile("s_waitcnt lgkmcnt(0)":::"memory");
    #pragma unroll
    for(int i=0;i<4;++i){const int row=i*8+(lane>>3),ch=lane&7; const u32x4 w=*(const u32x4*)(stg+row*64+ch*8);
      float x[8];
      #pragma unroll
      for(int e=0;e<4;++e){x[2*e]=__uint_as_float(w[e]<<16); x[2*e+1]=__uint_as_float(w[e]&0xffff0000u);}
      float ss=((x[0]*x[0]+x[1]*x[1])+(x[2]*x[2]+x[3]*x[3]))+((x[4]*x[4]+x[5]*x[5])+(x[6]*x[6]+x[7]*x[7]));
      ss+=__shfl_xor(ss,1); ss+=__shfl_xor(ss,2); ss+=__shfl_xor(ss,4);
      const float rn=rsqrtf(ss*(1.0f/64.0f)+1e-6f);
      u32x4 v; v.x=cvtpk_s(x[0]*rn,x[1]*rn); v.y=cvtpk_s(x[2]*rn,x[3]*rn); v.z=cvtpk_s(x[4]*rn,x[5]*rn); v.w=cvtpk_s(x[6]*rn,x[7]*rn);
      const long orow_g=is_meta?(metarow+(row&15)):(qrow0+wid*QBLK+row);
      const int h_o=is_meta?(h+2*wid+(row>>4)):h;
      const bool ok=(!is_meta)||(wid<2);
      if(ok) ATTN_STORE16(O+orow_g*OP+h_o*D+ch*8,v);} }
  asm volatile("s_waitcnt lgkmcnt(0)\n\ts_barrier":::"memory");
  #undef DMA_K
  #undef TROW
  #undef DMA_V
  #undef CMASK
  #undef START
  #undef RESC
  #undef ROT
}
constexpr int ATTN_LDS_BYTES=LDS_BYTES;
#undef SBAR
#undef WAIT_BAR
}

constexpr int NWAVES = 8;
constexpr int DM = 1024, DFF = 2816, NIN = 2304, DEPTH = 4;
constexpr int NREAL = 81920, MB = 81920, MP = 82688;
constexpr int NSEQ = 12;
constexpr size_t MiB = 1u << 20;
constexpr size_t WS_CTL = 0, WS_ROPE = 4096, WS_STATS = 32768, WS_W = 6 * MiB, WS_H = 165 * MiB, WS_BIG = 327 * MiB;
constexpr size_t WS_END = WS_BIG + (size_t)MP * 2816 * 2;
constexpr size_t W_GU = (size_t)2 * DFF * DM, W_D = (size_t)DM * DFF, W_IN = (size_t)NIN * DM, W_OUT = (size_t)DM * DM;
constexpr size_t WL_1GU = 0, WL_1D = WL_1GU + W_GU, WL_IN = WL_1D + W_D, WL_OUT = WL_IN + W_IN, WL_2GU = WL_OUT + W_OUT, WL_2D = WL_2GU + W_GU, WL_SZ = WL_2D + W_D;
static_assert(WS_STATS + (size_t)MP * 16 * 4 <= WS_W && WS_W + WL_SZ * 2 * DEPTH <= WS_H && WS_H + (size_t)MP * DM * 2 <= WS_BIG, "ws map");
constexpr int RING_BYTES = 131072, LDS_BYTES = 147456;
static_assert(attn_body::ATTN_LDS_BYTES <= RING_BYTES, "attention LDS");

#define LAS __attribute__((address_space(3)))
typedef unsigned short bf16;
typedef unsigned v4u __attribute__((ext_vector_type(4)));
typedef float f32x4 __attribute__((ext_vector_type(4)));
__device__ __forceinline__ unsigned f2bf(float f) { unsigned u = __builtin_bit_cast(unsigned, f); return (u + 0x7fffu + ((u >> 16) & 1u)) >> 16; }
__device__ __forceinline__ unsigned pk2(float lo, float hi) { return f2bf(lo) | (f2bf(hi) << 16); }
__device__ __forceinline__ float bflo(unsigned w) { return __builtin_bit_cast(float, w << 16); }
__device__ __forceinline__ float bfhi(unsigned w) { return __builtin_bit_cast(float, w & 0xffff0000u); }
__device__ __forceinline__ float wave_sum(float v) {
#pragma unroll
    for (int o = 1; o < 64; o <<= 1) v += __shfl_xor(v, o);
    return v;
}
__device__ __forceinline__ void tr_item(const float* W, int K, int N, const float* gain, bf16* WT, int drow0, LAS float* scr, int k0, int n0, int lane) {
#pragma unroll 8
    for (int i = 0; i < 32; ++i) { const int kk = 2 * i + (lane >> 5); const float g = gain ? gain[k0 + kk] : 1.0f; scr[kk * 33 + (lane & 31)] = g * W[(size_t)(k0 + kk) * N + n0 + (lane & 31)]; }
    asm volatile("s_waitcnt lgkmcnt(0)" ::: "memory");
    const int c = lane & 7;
#pragma unroll
    for (int j = 0; j < 4; ++j) { const int n = (lane >> 3) + 8 * j; const LAS float* s = scr + (8 * c) * 33 + n;
        v4u o; o.x = pk2(s[0 * 33], s[1 * 33]); o.y = pk2(s[2 * 33], s[3 * 33]); o.z = pk2(s[4 * 33], s[5 * 33]); o.w = pk2(s[6 * 33], s[7 * 33]);
        *(v4u*)(WT + (size_t)(drow0 + n) * K + k0 + 8 * c) = o; }
    asm volatile("s_waitcnt lgkmcnt(0)" ::: "memory");
}
__device__ __forceinline__ int win_drow(int n0) {
    if (n0 < 1280) { const int hd = n0 >> 6, bj = (n0 >> 5) & 1; return 256 * (hd >> 2) + 128 * bj + 32 * (hd & 3); }
    if (n0 < 1792) { const int t = (n0 - 1280) >> 7, w = (n0 - 1280) & 127; return 1280 + 256 * t + w; }
    { const int t = (n0 - 1792) >> 7, w = (n0 - 1792) & 127; return 1280 + 256 * t + 128 + w; }
}
__device__ __forceinline__ long seq_base(int q) { return q < 4 ? 4096L * q : 16384L + 8192L * (q - 4); }

struct Args { const float* in[21]; float* out; unsigned char* ws; };

__global__ void __launch_bounds__(NWAVES * 64, 2) hymba_fwd(Args args) {
    extern __shared__ __attribute__((aligned(16))) unsigned char lds[];
    cg::grid_group grid = cg::this_grid();
    const int tid = threadIdx.x, lane0 = tid & 63, wave = __builtin_amdgcn_readfirstlane(tid >> 6);
    const int G = gridDim.x, bx = blockIdx.x;
    const int gw = bx * NWAVES + wave, NGW = G * NWAVES;
    unsigned char* ws = args.ws;
    unsigned* ctl = (unsigned*)(ws + WS_CTL);
    float* rope = (float*)(ws + WS_ROPE);
    float* stats = (float*)(ws + WS_STATS);
    bf16* Wb = (bf16*)(ws + WS_W);
    bf16* HB = (bf16*)(ws + WS_H);
    bf16* BIG = (bf16*)(ws + WS_BIG);
    bf16* ACT = BIG;
    bf16* Qb = BIG; bf16* Kb = BIG + (size_t)MP * 512; bf16* Vb = BIG + (size_t)MP * 640; bf16* CBb = BIG + (size_t)MP * 768; bf16* Ub = BIG + (size_t)MP * 1280; bf16* Yb = BIG + (size_t)MP * 1792;
    LAS unsigned char* ldsp = (LAS unsigned char*)lds;
    const float* x_prompt = args.in[0]; const float* x_sample = args.in[1]; const float* meta = args.in[2];

    {
        const int lane = lane0;
        if (bx == 0 && tid < 64) ctl[tid] = 0u;
        { const int gt = bx * (NWAVES * 64) + tid;
          if (gt < 2048) { const int pos = gt >> 4, i = gt & 15; const double fr = exp2(-(double)i * (13.287712379549449 / 16.0)); double s, c; sincos((double)pos * fr, &s, &c); rope[2 * gt] = (float)c; rope[2 * gt + 1] = (float)s; } }
        LAS float* scr = (LAS float*)(ldsp + wave * 16384);
        constexpr int I_GU = 16 * 88, I_D = 44 * 32, I_IN = 16 * 72, I_OUT = 16 * 32, I_L = 4 * I_GU + 2 * I_D + I_IN + I_OUT;
        for (int it = gw; it < DEPTH * I_L; it += NGW) {
            const int l = it / I_L; int r = it % I_L; bf16* WL = Wb + (size_t)l * WL_SZ;
            if (r < 4 * I_GU) { const int which = r / I_GU; r %= I_GU; const int kb = r / 88, nb = r % 88, n0 = 32 * nb;
                const float* W = args.in[(which < 2 ? 4 : 17) + (which & 1)] + (size_t)l * DM * DFF; const float* gn = args.in[which < 2 ? 3 : 16] + l * DM;
                tr_item(W, DM, DFF, gn, WL + (which < 2 ? WL_1GU : WL_2GU), 256 * (n0 >> 7) + (n0 & 127) + ((which & 1) ? 128 : 0), scr, 64 * kb, n0, lane); continue; }
            r -= 4 * I_GU;
            if (r < 2 * I_D) { const int which = r / I_D; r %= I_D; const int kb = r / 32, nb = r % 32;
                tr_item(args.in[which ? 19 : 6] + (size_t)l * DFF * DM, DFF, DM, nullptr, WL + (which ? WL_2D : WL_1D), 32 * nb, scr, 64 * kb, 32 * nb, lane); continue; }
            r -= 2 * I_D;
            if (r < I_IN) { const int kb = r / 72, nb = r % 72;
                tr_item(args.in[8] + (size_t)l * DM * NIN, DM, NIN, args.in[7] + l * DM, WL + WL_IN, win_drow(32 * nb), scr, 64 * kb, 32 * nb, lane); continue; }
            r -= I_IN;
            { const int kb = r / 32, nb = r % 32; const int k0 = 64 * kb;
              const float* gn = (k0 < 512) ? (args.in[13] + l * 512 + 0) : (args.in[14] + l * 512 - 512);
              tr_item(args.in[15] + (size_t)l * DM * DM, DM, DM, gn, WL + WL_OUT, 32 * nb, scr, k0, 32 * nb, lane); }
        }
        for (int row = gw; row < MP; row += NGW) {
            const float* src = nullptr;
            if (row < 16384) src = x_prompt + (size_t)row * DM; else if (row < NREAL) src = x_sample + (size_t)(row - 16384) * DM;
            else { const int i = (row - MB) & 63; if (i < 16) src = meta + (size_t)i * DM; }
            f32x4 v[4]; float ss = 0.f;
#pragma unroll
            for (int j = 0; j < 4; ++j) { v[j] = src ? ((const f32x4*)src)[lane + 64 * j] : (f32x4){0.f, 0.f, 0.f, 0.f}; ss += (v[j][0] * v[j][0] + v[j][1] * v[j][1]) + (v[j][2] * v[j][2] + v[j][3] * v[j][3]); }
            ss = wave_sum(ss);
#pragma unroll
            for (int j = 0; j < 4; ++j) {
                ((unsigned long long*)(HB + (size_t)row * DM))[lane + 64 * j] = (unsigned long long)pk2(v[j][0], v[j][1]) | ((unsigned long long)pk2(v[j][2], v[j][3]) << 32); }
            if (lane < 16) stats[(size_t)row * 16 + lane] = (lane == 0) ? ss : 0.f;
        }
    }
    grid.sync();

    for (int l = 0; l < DEPTH; ++l) {
        const bf16* WL = Wb + (size_t)l * WL_SZ;
        for (int s = 0; s < 2; ++s) {
            if (s == 1) {
#ifndef NO_WIN
                { pg8::Gemm g{HB, WL + WL_IN, MP, NIN, DM}; pg8::StaticOrder S; S.init(MP, NIN, G, bx);
                  pg8::EpiWin E{Qb, Kb, Vb, CBb, Ub, stats, args.in[9] + l * 64, args.in[10] + l * 64, rope};
                  pg8::gemm_phase<pg8::EpiWin, pg8::StaticOrder, true, true>(ldsp, g, S, E); }
#endif

                grid.sync();
                {
                    int lane = lane0; asm volatile("" : "+v"(lane));
                    const float* cw = args.in[11] + (size_t)l * 3 * 512; const float* cbias = args.in[12] + (size_t)l * 512;
                    LAS volatile unsigned* qslot = (LAS volatile unsigned*)(ldsp + RING_BYTES);
                    constexpr int UPG_S = 4 * 32 + 1, UPG_P = 4 * 16 + 1, NU_S = 8 * 2 * UPG_S, NU_P = 4 * 2 * UPG_P, NU = NU_S + NU_P, NCH = MP / 64;
                    for (;;) {
                        if (tid == 0) qslot[0] = atomicAdd(ctl + l, 1u);
                        __syncthreads();
                        const int idx = __builtin_amdgcn_readfirstlane((int)qslot[0]);
                        if (idx >= NU + NCH) break;
                        if (idx < NU) {
                            int q, rem, nqb;
                            if (idx < NU_S) { q = 4 + idx / (2 * UPG_S); rem = idx % (2 * UPG_S); nqb = 32; } else { const int i2 = idx - NU_S; q = i2 / (2 * UPG_P); rem = i2 % (2 * UPG_P); nqb = 16; }
                            const int upg = 4 * nqb + 1, kvg = rem / upg, r2 = rem % upg;
                            const int is_meta = (r2 == 4 * nqb) ? 1 : 0, h = is_meta ? 4 * kvg : 4 * kvg + r2 / nqb, b = is_meta ? 0 : r2 % nqb;
                            const long sb = seq_base(q);
#ifndef NO_ATT
                            attn_body::attn_unit<8>(sb + 256L * b, is_meta, sb + 64L * q, nqb * 4, (long)(MB + 64 * q), h,
                                (const attn_body::bf16*)Qb, (const attn_body::bf16*)Kb, (const attn_body::bf16*)Vb, (attn_body::bf16*)Yb, (char*)lds);
#endif
                        } else {
                            f32x4 w0[2], w1[2], w2[2], bb[2];
#pragma unroll
                            for (int j = 0; j < 2; ++j) { w0[j] = *(const f32x4*)(cw + 8 * lane + 4 * j); w1[j] = *(const f32x4*)(cw + 512 + 8 * lane + 4 * j); w2[j] = *(const f32x4*)(cw + 1024 + 8 * lane + 4 * j); bb[j] = *(const f32x4*)(cbias + 8 * lane + 4 * j); }
                            const int rbase = (idx - NU) * 64 + wave * 8;
                            for (int rr = 0; rr < 8; ++rr) {
                                const int row = rbase + rr;
                                long prev = -1, next = -1; bool valid = true;
                                if (row < NREAL) { const int q = row < 16384 ? (row >> 12) : 4 + ((row - 16384) >> 13); const int nlen = row < 16384 ? 4096 : 8192; const int n = row & (nlen - 1);
                                    prev = (n == 0) ? (long)(MB + 64 * q + 15) : (long)row - 1; next = (n == nlen - 1) ? -1L : (long)row + 1; }
                                else { const int q = (row - MB) >> 6, i = (row - MB) & 63; valid = i < 16; prev = (i == 0) ? -1L : (long)row - 1; next = (i == 15) ? seq_base(q) : (long)row + 1; }
                                v4u* yo = (v4u*)(Yb + (size_t)row * 1024 + 512) + lane;
                                if (!valid) { *yo = (v4u){0u, 0u, 0u, 0u}; *((v4u*)(Yb + (size_t)row * 1024) + lane) = (v4u){0u, 0u, 0u, 0u}; continue; }
                                const v4u uc = *((const v4u*)(Ub + (size_t)row * 512) + lane);
                                const v4u up = prev >= 0 ? *((const v4u*)(Ub + (size_t)prev * 512) + lane) : (v4u){0u, 0u, 0u, 0u};
                                const v4u un = next >= 0 ? *((const v4u*)(Ub + (size_t)next * 512) + lane) : (v4u){0u, 0u, 0u, 0u};
                                const v4u cbv = *((const v4u*)(CBb + (size_t)row * 512) + lane);
                                float y[8]; float ss = 0.f;
#pragma unroll
                                for (int e = 0; e < 8; ++e) { const int wi = e >> 1; const bool hi_ = e & 1;
                                    const float a = hi_ ? bfhi(up[wi]) : bflo(up[wi]), b = hi_ ? bfhi(uc[wi]) : bflo(uc[wi]), c = hi_ ? bfhi(un[wi]) : bflo(un[wi]), d = hi_ ? bfhi(cbv[wi]) : bflo(cbv[wi]);
                                    const float t = a * w0[e >> 2][e & 3] + b * w1[e >> 2][e & 3] + c * w2[e >> 2][e & 3] + bb[e >> 2][e & 3];
                                    y[e] = d * t; ss += y[e] * y[e]; }
                                ss += __shfl_xor(ss, 1); ss += __shfl_xor(ss, 2); ss += __shfl_xor(ss, 4);
                                const float rn = rsqrtf(ss * (1.0f / 64.0f) + 1e-6f);
                                v4u o; o.x = pk2(y[0] * rn, y[1] * rn); o.y = pk2(y[2] * rn, y[3] * rn); o.z = pk2(y[4] * rn, y[5] * rn); o.w = pk2(y[6] * rn, y[7] * rn);
                                *yo = o;
                            }
                            __syncthreads();
                        }
                    }
                }
                grid.sync();
#ifndef NO_WOUT
                { const int Mr = (l == DEPTH - 1) ? NREAL : MP; pg8::Gemm g{Yb, WL + WL_OUT, Mr, DM, DM}; pg8::StaticOrder S; S.init(Mr, DM, G, bx);
                  pg8::EpiResid E{HB, stats, 1.0f};
                  pg8::gemm_phase<pg8::EpiResid, pg8::StaticOrder, true, true>(ldsp, g, S, E); }
#endif

                grid.sync();
            }
#ifndef NO_GU
            { const int Mr = (l == DEPTH - 1 && s == 1) ? NREAL : MP; pg8::Gemm g{HB, WL + (s ? WL_2GU : WL_1GU), Mr, 2 * DFF, DM}; pg8::StaticOrder S; S.init(Mr, 2 * DFF, G, bx);
              pg8::EpiGateUp E{ACT, stats, DFF};
              pg8::gemm_phase<pg8::EpiGateUp, pg8::StaticOrder, true, true>(ldsp, g, S, E); }
#endif

            grid.sync();
#ifndef NO_DOWN
            { const int Mr = (l == DEPTH - 1 && s == 1) ? NREAL : MP; pg8::Gemm g{ACT, WL + (s ? WL_2D : WL_1D), Mr, DM, DFF}; pg8::StaticOrder S; S.init(Mr, DM, G, bx);
              pg8::EpiResid E{HB, stats, 0.5f};
              pg8::gemm_phase<pg8::EpiResid, pg8::StaticOrder, true, true>(ldsp, g, S, E); }
#endif

            grid.sync();
        }
    }
    {
        int lane = lane0; asm volatile("" : "+v"(lane));
        const float* fn = args.in[20]; f32x4 gnv[4];
#pragma unroll
        for (int j = 0; j < 4; ++j) gnv[j] = ((const f32x4*)fn)[lane + 64 * j];
        for (int row = gw; row < NREAL; row += NGW) {
            f32x4 v[4]; float ss = 0.f;
#pragma unroll
            for (int j = 0; j < 4; ++j) { const unsigned long long w = ((const unsigned long long*)(HB + (size_t)row * DM))[lane + 64 * j]; const unsigned lo = (unsigned)w, hi = (unsigned)(w >> 32);
                v[j][0] = bflo(lo); v[j][1] = bfhi(lo); v[j][2] = bflo(hi); v[j][3] = bfhi(hi); ss += (v[j][0] * v[j][0] + v[j][1] * v[j][1]) + (v[j][2] * v[j][2] + v[j][3] * v[j][3]); }
            const float rs = rsqrtf(wave_sum(ss) * (1.0f / 1024.0f) + 1e-6f);
#pragma unroll
            for (int j = 0; j < 4; ++j) ((f32x4*)(args.out + (size_t)row * DM))[lane + 64 * j] = v[j] * rs * gnv[j];
        }
    }
}

extern "C" void kernel_launch(void* const* d_in, const int* in_sizes, int n_in, void* d_out, int out_size, void* d_ws, size_t ws_size, hipStream_t stream) {
    static int grid = 0;
    if (grid == 0) {
        if (n_in != 21 || out_size != NREAL * DM || ws_size < WS_END || in_sizes[8] != DEPTH * DM * NIN) {
            fprintf(stderr, "kernel_launch: unexpected shapes: n_in %d out %d ws %zu (need %zu) w_in %d\n", n_in, out_size, ws_size, (size_t)WS_END, n_in > 8 ? in_sizes[8] : -1); grid = -1; return; }
        int dev = 0, cus = 0, per_cu = 0;
        (void)hipGetDevice(&dev); (void)hipDeviceGetAttribute(&cus, hipDeviceAttributeMultiprocessorCount, dev);
        if (hipFuncSetAttribute((const void*)hymba_fwd, hipFuncAttributeMaxDynamicSharedMemorySize, LDS_BYTES) != hipSuccess) { fprintf(stderr, "kernel_launch: hipFuncSetAttribute failed\n"); grid = -1; return; }
        (void)hipOccupancyMaxActiveBlocksPerMultiprocessor(&per_cu, (const void*)hymba_fwd, NWAVES * 64, LDS_BYTES);
        if (per_cu < 1) { fprintf(stderr, "kernel_launch: occupancy query says %d blocks per CU\n", per_cu); per_cu = 1; }
        (void)hipGetLastError();
        grid = cus;
    }
    if (grid < 0) return;
    Args a{};
    for (int i = 0; i < 21; ++i) a.in[i] = (const float*)d_in[i];
    a.out = (float*)d_out; a.ws = (unsigned char*)d_ws;
    void* kargs[] = {&a};
    hipError_t e = hipLaunchCooperativeKernel((const void*)hymba_fwd, dim3(grid), dim3(NWAVES * 64), kargs, LDS_BYTES, stream);
    if (e != hipSuccess) fprintf(stderr, "cooperative launch failed: %s (grid %d)\n", hipGetErrorString(e), grid);
}
```

```cpp
#include <hip/hip_runtime.h>
#include <hip/hip_cooperative_groups.h>
#include <hip/hip_bf16.h>
#include <cstdio>
#include <cstdint>
#include <cmath>
namespace cg = cooperative_groups;
namespace pg8 {
#define PG8_LAS __attribute__((address_space(3)))
typedef unsigned short bf16_t;
typedef short bf16x8 __attribute__((ext_vector_type(8)));
typedef float f32x4 __attribute__((ext_vector_type(4)));
typedef unsigned u32x4 __attribute__((ext_vector_type(4)));
constexpr int BM = 256, BK = 64, HALF = 128, HTB = HALF * BK * 2  , STAGE_BYTES = 8 * HTB, NXCD = 8, WGM = 8;

__host__ __device__ __forceinline__ int lds_byte(int r, int c) { const int st = (r >> 4) * 2 + (c >> 5), rr = r & 15, cc = c & 31, ob = rr * 64 + cc * 2; return st * 1024 + (ob ^ (((ob >> 9) & 1) << 5)); }
__host__ __device__ __forceinline__ void stage_rc(int b, int& R, int& C) { const int st = b / 1024, sb = b % 1024, swz = sb ^ (((sb >> 9) & 1) << 5); R = (st >> 1) * 16 + swz / 64; C = (st & 1) * 32 + (swz % 64) / 2; }
__host__ __device__ __forceinline__ int perm32(int rho) { const int n = rho >> 4, i = rho & 15; return 8 * (i >> 2) + 4 * n + (i & 3); }

struct Unit { int pm, pn; };
struct Gemm { const bf16_t* A; const bf16_t* Bt; int M, N, K; };

struct StaticOrder {
    int nM, nN, nwg, G, c;
    __host__ __device__ void init(int M, int N, int G_, int c_) { nM = M / BM; nN = N / BM; nwg = nM * nN; G = G_; c = c_; }
    __host__ __device__ bool next(int i, Unit& u) const {
        const long L = (long)i * G + c; if (L >= nwg) return false;
        int wgid = (int)L; { const int q = nwg / NXCD, r = nwg % NXCD, xcd = wgid % NXCD, off = wgid / NXCD; wgid = (xcd < r ? xcd * (q + 1) : r * (q + 1) + (xcd - r) * q) + off; }
        const int nig = WGM * nN, gid = wgid / nig, fm = gid * WGM, gsz = (nM - fm) < WGM ? (nM - fm) : WGM;
        u.pm = fm + ((wgid % nig) % gsz); u.pn = (wgid % nig) / gsz; return true;
    }
    __device__ __forceinline__ void a_ready(const Unit&) const {}
    __device__ __forceinline__ void done(const Unit&) const {}
};

__device__ __forceinline__ unsigned cvt_pk_bf16(float lo, float hi) { unsigned r; asm volatile("v_cvt_pk_bf16_f32 %0, %1, %2" : "=v"(r) : "v"(lo), "v"(hi)); return r; }
constexpr float RMS_EPS = 1e-6f;
__device__ __forceinline__ float row_rstd(const float* stats, int row, int fq) {
    const f32x4 a = *(const f32x4*)(stats + (size_t)row * 16 + 4 * fq);
    float t = (a[0] + a[1]) + (a[2] + a[3]);
    t += __shfl_xor(t, 16); t += __shfl_xor(t, 32);
    return rsqrtf(t * (1.0f / 1024.0f) + RMS_EPS);
}
#define EPI_RS8(rsv) float rsv[8]; _Pragma("unroll") for (int ai_ = 0; ai_ < 2; ++ai_) _Pragma("unroll") for (int m_ = 0; m_ < 4; ++m_) rsv[ai_ * 4 + m_] = row_rstd(stats, row0 + ai_ * HALF + m_ * 16, fq); asm volatile("" ::: "memory")
#define EPI_FENCE() asm volatile("" ::: "memory")
__device__ __forceinline__ float silu_f(float x) { return x * __builtin_amdgcn_rcpf(1.0f + __builtin_amdgcn_exp2f(-1.4426950408889634f * x)); }
__device__ __forceinline__ u32x4 pack8(const f32x4 a, const f32x4 b) { u32x4 w; w.x = cvt_pk_bf16(a[0], a[1]); w.y = cvt_pk_bf16(a[2], a[3]); w.z = cvt_pk_bf16(b[0], b[1]); w.w = cvt_pk_bf16(b[2], b[3]); return w; }

struct EpiGateUp {
    static constexpr bool PERM = true, AFTER_DRAIN = false;
    bf16_t* O; const float* stats; int ldo;
    __device__ __forceinline__ void operator()(const f32x4 (&acc)[2][2][4][2], const Unit& u, int wr, int wc, int fr_in, int fq_in) const {
        int fr = fr_in, fq = fq_in; asm volatile("" : "+v"(fr), "+v"(fq));
        const int row0 = u.pm * BM + wr * 64 + fr, col0 = u.pn * 128 + wc * 32 + 8 * fq;
        EPI_RS8(rsv);
#pragma unroll
        for (int ai = 0; ai < 2; ++ai)
#pragma unroll
            for (int m = 0; m < 4; ++m) { const int row = row0 + ai * HALF + m * 16; const float rs = rsv[ai * 4 + m], c1 = -1.4426950408889634f * rs, rs2 = rs * rs;
                float t[8], gu[8];
#pragma unroll
                for (int e = 0; e < 8; ++e) { const float g = acc[ai][0][m][e >> 2][e & 3]; t[e] = __builtin_amdgcn_exp2f(g * c1); gu[e] = g * acc[ai][1][m][e >> 2][e & 3]; }
#pragma unroll
                for (int e = 0; e < 8; ++e) t[e] = __builtin_amdgcn_rcpf(1.0f + t[e]);
                f32x4 o0, o1;
#pragma unroll
                for (int e = 0; e < 4; ++e) { o0[e] = gu[e] * (t[e] * rs2); o1[e] = gu[4 + e] * (t[4 + e] * rs2); }
                *(u32x4*)(O + (size_t)row * ldo + col0) = pack8(o0, o1); EPI_FENCE(); }
    }
};
struct EpiResid {
    static constexpr bool PERM = true, AFTER_DRAIN = false;
    bf16_t* HB; float* stats; float scale;
    __device__ __forceinline__ void operator()(const f32x4 (&acc)[2][2][4][2], const Unit& u, int wr, int wc, int fr_in, int fq_in) const {
        int fr = fr_in, fq = fq_in; asm volatile("" : "+v"(fr), "+v"(fq));
        const int row0 = u.pm * BM + wr * 64 + fr, col0 = u.pn * BM + wc * 32 + 8 * fq;
#pragma unroll
        for (int ai = 0; ai < 2; ++ai)
#pragma unroll
            for (int m = 0; m < 4; ++m) { const int row = row0 + ai * HALF + m * 16; float ss = 0.f;
#pragma unroll
                for (int bj = 0; bj < 2; ++bj) { u32x4* hp = (u32x4*)(HB + (size_t)row * 1024 + col0 + bj * HALF);
                    const u32x4 w = *hp; f32x4 h0, h1;
                    h0[0] = __uint_as_float(w.x << 16); h0[1] = __uint_as_float(w.x & 0xffff0000u); h0[2] = __uint_as_float(w.y << 16); h0[3] = __uint_as_float(w.y & 0xffff0000u);
                    h1[0] = __uint_as_float(w.z << 16); h1[1] = __uint_as_float(w.z & 0xffff0000u); h1[2] = __uint_as_float(w.w << 16); h1[3] = __uint_as_float(w.w & 0xffff0000u);
                    h0 = h0 + acc[ai][bj][m][0] * scale; h1 = h1 + acc[ai][bj][m][1] * scale;
                    *hp = pack8(h0, h1);
                    ss += ((h0[0] * h0[0] + h0[1] * h0[1]) + (h0[2] * h0[2] + h0[3] * h0[3])) + ((h1[0] * h1[0] + h1[1] * h1[1]) + (h1[2] * h1[2] + h1[3] * h1[3])); }
                ss += __shfl_xor(ss, 16); ss += __shfl_xor(ss, 32);
                if (fq == 0) stats[(size_t)row * 16 + u.pn * 4 + wc] = ss; EPI_FENCE(); }
    }
};
__device__ __forceinline__ int kv_row(int row) {
    if (row < 16384) return row + 64 * (row >> 12);
    if (row < 81920) return row + 64 * (4 + ((row - 16384) >> 13));
    const int q = (row - 81920) >> 6, i = (row - 81920) & 63;
    return (q < 4 ? 4096 * q + 4096 : 16384 + 8192 * (q - 4) + 8192) + 64 * q + i;
}
struct EpiWin {
    static constexpr bool PERM = true, AFTER_DRAIN = false;
    bf16_t *Q, *K, *V, *CB, *U; const float* stats; const float* qg; const float* kg; const float* rope;
    __device__ __forceinline__ void operator()(const f32x4 (&acc)[2][2][4][2], const Unit& u, int wr, int wc, int fr_in, int fq_in) const {
        int fr = fr_in, fq = fq_in; asm volatile("" : "+v"(fr), "+v"(fq));
        const int row0 = u.pm * BM + wr * 64 + fr, pn = u.pn;
        if (pn >= 5) {
            const int col0 = (pn - 5) * 128 + wc * 32 + 8 * fq;
#pragma unroll
            for (int ai = 0; ai < 2; ++ai)
#pragma unroll
                for (int m = 0; m < 4; ++m) { const int row = row0 + ai * HALF + m * 16; const float rs = row_rstd(stats, row, fq), rs2 = rs * rs;
                    const f32x4 o0 = acc[ai][0][m][0] * acc[ai][1][m][0] * rs2, o1 = acc[ai][0][m][1] * acc[ai][1][m][1] * rs2;
                    *(u32x4*)(U + (size_t)row * 512 + col0) = pack8(o0, o1); EPI_FENCE(); }
            return;
        }
        const int hd = 4 * pn + wc;
        const bool is_q = hd < 8, is_k = (hd >= 8 && hd < 10);
        bf16_t* dst; int ldd, cb;
        if (is_q) { dst = Q; ldd = 512; cb = hd * 64; } else if (is_k) { dst = K; ldd = 128; cb = (hd - 8) * 64; }
        else if (hd < 12) { dst = V; ldd = 128; cb = (hd - 10) * 64; } else { dst = CB; ldd = 512; cb = (hd - 12) * 64; }
        cb += 8 * fq;
        if (is_q || is_k) {
            const float* gp = (is_q ? qg : kg) + 8 * fq;
            const float osc = is_q ? (0.125f * 1.4426950408889634f) : 1.0f;
#pragma unroll
            for (int ai = 0; ai < 2; ++ai)
#pragma unroll
                for (int m = 0; m < 4; ++m) { const int row = row0 + ai * HALF + m * 16; const float rs = row_rstd(stats, row, fq);
                    f32x4 v00 = acc[ai][0][m][0] * rs, v01 = acc[ai][0][m][1] * rs, v10 = acc[ai][1][m][0] * rs, v11 = acc[ai][1][m][1] * rs;
                    float ss = ((v00[0] * v00[0] + v00[1] * v00[1]) + (v00[2] * v00[2] + v00[3] * v00[3])) + ((v01[0] * v01[0] + v01[1] * v01[1]) + (v01[2] * v01[2] + v01[3] * v01[3]))
                             + ((v10[0] * v10[0] + v10[1] * v10[1]) + (v10[2] * v10[2] + v10[3] * v10[3])) + ((v11[0] * v11[0] + v11[1] * v11[1]) + (v11[2] * v11[2] + v11[3] * v11[3]));
                    ss += __shfl_xor(ss, 16); ss += __shfl_xor(ss, 32);
                    const float rn = rsqrtf(ss * (1.0f / 64.0f) + RMS_EPS);
                    v00 = v00 * *(const f32x4*)gp * rn; v01 = v01 * *(const f32x4*)(gp + 4) * rn; v10 = v10 * *(const f32x4*)(gp + 32) * rn; v11 = v11 * *(const f32x4*)(gp + 36) * rn;
                    int rp = 0, cp = 0;
                    if (row < 81920) { const int nn = row & (row < 16384 ? 4095 : 8191); rp = nn >> 6; cp = nn & 63; }
                    const float* tr = rope + (size_t)rp * 32 + 8 * fq; const float* tc = rope + (size_t)cp * 32 + 8 * fq;
                    const f32x4 r0 = *(const f32x4*)tr, r1 = *(const f32x4*)(tr + 4), c0 = *(const f32x4*)tc, c1 = *(const f32x4*)(tc + 4);
                    f32x4 o00, o01, o10, o11;
                    o00[0] = v00[0] * r0[0] - v00[1] * r0[1]; o00[1] = v00[0] * r0[1] + v00[1] * r0[0]; o00[2] = v00[2] * r0[2] - v00[3] * r0[3]; o00[3] = v00[2] * r0[3] + v00[3] * r0[2];
                    o01[0] = v01[0] * r1[0] - v01[1] * r1[1]; o01[1] = v01[0] * r1[1] + v01[1] * r1[0]; o01[2] = v01[2] * r1[2] - v01[3] * r1[3]; o01[3] = v01[2] * r1[3] + v01[3] * r1[2];
                    o10[0] = v10[0] * c0[0] - v10[1] * c0[1]; o10[1] = v10[0] * c0[1] + v10[1] * c0[0]; o10[2] = v10[2] * c0[2] - v10[3] * c0[3]; o10[3] = v10[2] * c0[3] + v10[3] * c0[2];
                    o11[0] = v11[0] * c1[0] - v11[1] * c1[1]; o11[1] = v11[0] * c1[1] + v11[1] * c1[0]; o11[2] = v11[2] * c1[2] - v11[3] * c1[3]; o11[3] = v11[2] * c1[3] + v11[3] * c1[2];
                    bf16_t* dp = dst + (size_t)(is_k ? kv_row(row) : row) * ldd + cb;
                    *(u32x4*)dp = pack8(o00 * osc, o01 * osc); *(u32x4*)(dp + 32) = pack8(o10 * osc, o11 * osc); EPI_FENCE(); }
        } else {
#pragma unroll
            for (int ai = 0; ai < 2; ++ai)
#pragma unroll
                for (int m = 0; m < 4; ++m) { const int row = row0 + ai * HALF + m * 16; const float rs = row_rstd(stats, row, fq);
                    bf16_t* dp = dst + (size_t)(hd < 12 ? kv_row(row) : row) * ldd + cb;
                    *(u32x4*)dp = pack8(acc[ai][0][m][0] * rs, acc[ai][0][m][1] * rs); *(u32x4*)(dp + 32) = pack8(acc[ai][1][m][0] * rs, acc[ai][1][m][1] * rs); EPI_FENCE(); }
        }
    }
};

template <class Epi, class Sched, bool ALIGN_EPI = false, bool SP2 = false>
__device__ __forceinline__ void gemm_phase(PG8_LAS unsigned char* lds, const Gemm g, const Sched& S, const Epi& E) {
    int tid_ = threadIdx.x; asm volatile("" : "+v"(tid_));
    const int tid = tid_, wid = __builtin_amdgcn_readfirstlane(tid >> 6), lane = tid & 63, wr = wid >> 2, wc = wid & 3, fr = lane & 15, fq = lane >> 4;
    const int K = g.K, nt = K / BK;
    unsigned voffA[2], voffB[2];
#pragma unroll
    for (int i = 0; i < 2; ++i) { int R, C; stage_rc(tid * 16 + i * 8192, R, C); const int Rb = Epi::PERM ? ((R & ~31) + perm32(R & 31)) : R;
        voffA[i] = (unsigned)(R * K + C) * 2u; voffB[i] = (unsigned)(Rb * K + C) * 2u; }
    const size_t kstep = (size_t)(BK * 2);
    const size_t hstep = (size_t)HALF * K * 2;
    const size_t tstep = 2 * hstep;
    const unsigned ldsw = (unsigned)wid * 1024u;
    const int aoff = lds_byte(wr * 64 + fr, fq * 8), boff = lds_byte(wc * 32 + fr, fq * 8);
#define PG8_SA(b, h) (((b) * 2 + (h)) * HTB)
#define PG8_SB(b, h) ((4 + (b) * 2 + (h)) * HTB)
#define PG8_STAGE(bufoff, gbase, voff) do { _Pragma("unroll") for (int _i = 0; _i < 2; ++_i) \
        __builtin_amdgcn_global_load_lds((const unsigned*)((const char*)(gbase) + (voff)[_i]), (PG8_LAS unsigned*)(lds + (bufoff) + ldsw + _i * 8192), 16, 0, 0); } while (0)
#define PG8_LDA(dst, b, h) do { _Pragma("unroll") for (int m = 0; m < 4; ++m) _Pragma("unroll") for (int k = 0; k < 2; ++k) dst[m][k] = *(const PG8_LAS bf16x8*)(lds + PG8_SA(b, h) + aoff + m * 2048 + k * 1024); } while (0)
#define PG8_LDB(dst, b, h) do { _Pragma("unroll") for (int n = 0; n < 2; ++n) _Pragma("unroll") for (int k = 0; k < 2; ++k) dst[n][k] = *(const PG8_LAS bf16x8*)(lds + PG8_SB(b, h) + boff + n * 2048 + k * 1024); } while (0)
#define PG8_MMA(ai, bj, At, Bt) do { __builtin_amdgcn_s_setprio(1); _Pragma("unroll") for (int m = 0; m < 4; ++m) _Pragma("unroll") for (int n = 0; n < 2; ++n) _Pragma("unroll") for (int k = 0; k < 2; ++k) \
        acc[ai][bj][m][n] = __builtin_amdgcn_mfma_f32_16x16x32_bf16(Bt[n][k], At[m][k], acc[ai][bj][m][n], 0, 0, 0); __builtin_amdgcn_s_setprio(0); } while (0)
#define PG8_WAIT_V(n) asm volatile("s_waitcnt vmcnt(" #n ")" ::: "memory")
#define PG8_WAIT_L(n) asm volatile("s_waitcnt lgkmcnt(" #n ")" ::: "memory")
#define PG8_BAR __builtin_amdgcn_s_barrier()
#define PG8_SCHED __builtin_amdgcn_sched_barrier(0)
    Unit cur, nxt; int ui = 0;
    if (!S.next(0, cur)) return;
    f32x4 acc[2][2][4][2];
#pragma unroll
    for (int a = 0; a < 2; ++a)
#pragma unroll
        for (int b = 0; b < 2; ++b)
#pragma unroll
            for (int m = 0; m < 4; ++m)
#pragma unroll
                for (int n = 0; n < 2; ++n) acc[a][b][m][n] = (f32x4){0.f, 0.f, 0.f, 0.f};
    bf16x8 At[4][2], B0[2][2], B1[2][2];
    const char* cA = (const char*)g.A + (size_t)cur.pm * tstep; const char* cB = (const char*)g.Bt + (size_t)cur.pn * tstep;
    S.a_ready(cur);
    if constexpr (SP2) {
        PG8_STAGE(PG8_SB(0, 0), cB, voffB); PG8_STAGE(PG8_SB(0, 1), cB + hstep, voffB); PG8_STAGE(PG8_SA(0, 0), cA, voffA); PG8_STAGE(PG8_SA(0, 1), cA + hstep, voffA);
        if (wr == 1) PG8_BAR;
        PG8_WAIT_V(2); PG8_BAR;
        PG8_STAGE(PG8_SB(1, 0), cB + kstep, voffB); PG8_STAGE(PG8_SA(1, 0), cA + kstep, voffA); PG8_STAGE(PG8_SB(1, 1), cB + hstep + kstep, voffB);
        PG8_WAIT_V(6); PG8_BAR;
    } else {
        PG8_STAGE(PG8_SB(0, 0), cB, voffB); PG8_STAGE(PG8_SA(0, 0), cA, voffA); PG8_STAGE(PG8_SB(0, 1), cB + hstep, voffB); PG8_STAGE(PG8_SA(0, 1), cA + hstep, voffA);
        if (wr == 1) PG8_BAR;
        PG8_WAIT_V(4); PG8_BAR;
        PG8_STAGE(PG8_SB(1, 0), cB + kstep, voffB); PG8_STAGE(PG8_SA(1, 0), cA + kstep, voffA); PG8_STAGE(PG8_SB(1, 1), cB + hstep + kstep, voffB);
        PG8_WAIT_V(6); PG8_BAR;
    }
    for (;;) {
        const bool has_next = S.next(ui + 1, nxt);
        const char* nA = has_next ? (const char*)g.A + (size_t)nxt.pm * tstep : cA; const char* nB = has_next ? (const char*)g.Bt + (size_t)nxt.pn * tstep : cB;
        for (int t = 0; t < nt; t += 2) {
            const bool last = (t == nt - 2);
            const char* a1 = cA + (size_t)(t + 1) * kstep;
            const char* a2 = last ? nA : cA + (size_t)(t + 2) * kstep; const char* b2 = last ? nB : cB + (size_t)(t + 2) * kstep;
            const char* a3 = a2 + kstep; const char* b3 = b2 + kstep;
            if (last && has_next) S.a_ready(nxt);
            if constexpr (SP2) {
            PG8_LDB(B0, 0, 0); PG8_LDB(B1, 0, 1); PG8_SCHED; PG8_LDA(At, 0, 0); PG8_STAGE(PG8_SA(1, 1), a1 + hstep, voffA);
            PG8_WAIT_V(8); PG8_WAIT_L(0); PG8_BAR; PG8_MMA(0, 0, At, B0); PG8_MMA(0, 1, At, B1); PG8_BAR; PG8_SCHED;
            PG8_LDA(At, 0, 1); PG8_STAGE(PG8_SB(0, 0), b2, voffB); PG8_STAGE(PG8_SB(0, 1), b2 + hstep, voffB); PG8_STAGE(PG8_SA(0, 0), a2, voffA);
            PG8_WAIT_V(8); PG8_WAIT_L(0); PG8_BAR; PG8_MMA(1, 0, At, B0); PG8_MMA(1, 1, At, B1); PG8_BAR; PG8_SCHED;
            PG8_LDB(B0, 1, 0); PG8_LDB(B1, 1, 1); PG8_SCHED; PG8_LDA(At, 1, 0); PG8_STAGE(PG8_SA(0, 1), a2 + hstep, voffA);
            PG8_WAIT_V(8); PG8_WAIT_L(0); PG8_BAR; PG8_MMA(0, 0, At, B0); PG8_MMA(0, 1, At, B1); PG8_BAR; PG8_SCHED;
            PG8_LDA(At, 1, 1); PG8_STAGE(PG8_SB(1, 0), b3, voffB); PG8_STAGE(PG8_SB(1, 1), b3 + hstep, voffB); PG8_STAGE(PG8_SA(1, 0), a3, voffA);
            PG8_WAIT_V(8); PG8_WAIT_L(0); PG8_BAR; PG8_MMA(1, 0, At, B0); PG8_MMA(1, 1, At, B1); PG8_BAR; PG8_SCHED;
            } else {
            PG8_LDB(B0, 0, 0); PG8_SCHED; PG8_LDA(At, 0, 0); PG8_STAGE(PG8_SA(1, 1), a1 + hstep, voffA);
            PG8_WAIT_L(8); PG8_BAR; PG8_WAIT_L(0); PG8_MMA(0, 0, At, B0); PG8_BAR; PG8_SCHED;
            PG8_LDB(B1, 0, 1); PG8_STAGE(PG8_SB(0, 0), b2, voffB);
            PG8_BAR; PG8_WAIT_L(0); PG8_MMA(0, 1, At, B1); PG8_BAR;
            PG8_LDA(At, 0, 1); PG8_STAGE(PG8_SA(0, 0), a2, voffA);
            PG8_BAR; PG8_WAIT_L(0); PG8_MMA(1, 0, At, B0); PG8_BAR; PG8_SCHED;
            PG8_STAGE(PG8_SB(0, 1), b2 + hstep, voffB);
            PG8_WAIT_V(6); PG8_BAR; PG8_MMA(1, 1, At, B1); PG8_BAR;
            PG8_LDB(B0, 1, 0); PG8_SCHED; PG8_LDA(At, 1, 0); PG8_STAGE(PG8_SA(0, 1), a2 + hstep, voffA);
            PG8_WAIT_L(8); PG8_BAR; PG8_WAIT_L(0); PG8_MMA(0, 0, At, B0); PG8_BAR; PG8_SCHED;
            PG8_LDB(B1, 1, 1); PG8_STAGE(PG8_SB(1, 0), b3, voffB);
            PG8_BAR; PG8_WAIT_L(0); PG8_MMA(0, 1, At, B1); PG8_BAR;
            PG8_LDA(At, 1, 1); PG8_STAGE(PG8_SA(1, 0), a3, voffA);
            PG8_BAR; PG8_WAIT_L(0); PG8_MMA(1, 0, At, B0); PG8_BAR; PG8_SCHED;
            PG8_STAGE(PG8_SB(1, 1), b3 + hstep, voffB);
            PG8_WAIT_V(6); PG8_BAR; PG8_MMA(1, 1, At, B1); PG8_BAR;
            }
        }
        if constexpr (ALIGN_EPI) { if (wr == 0) PG8_BAR; }
        if constexpr (!Epi::AFTER_DRAIN) { E(acc, cur, wr, wc, fr, fq); S.done(cur); }
        if (!has_next) break;
#pragma unroll
        for (int a = 0; a < 2; ++a)
#pragma unroll
            for (int b = 0; b < 2; ++b)
#pragma unroll
                for (int m = 0; m < 4; ++m)
#pragma unroll
                    for (int n = 0; n < 2; ++n) acc[a][b][m][n] = (f32x4){0.f, 0.f, 0.f, 0.f};
        cur = nxt; cA = nA; cB = nB; ++ui;
        if constexpr (ALIGN_EPI) { if (wr == 1) PG8_BAR; }
    }
    PG8_WAIT_V(0);
    if constexpr (!ALIGN_EPI) { if (wr == 0) PG8_BAR; }
    PG8_BAR;
    if constexpr (Epi::AFTER_DRAIN) { E.fused(acc, cur, wr, wc, fr, fq, lds, wid, lane); S.done(cur); }
#undef PG8_SA
#undef PG8_SB
#undef PG8_STAGE
#undef PG8_LDA
#undef PG8_LDB
#undef PG8_MMA
#undef PG8_WAIT_V
#undef PG8_WAIT_L
#undef PG8_BAR
#undef PG8_SCHED
}
}

namespace attn_body {
using bf16=__hip_bfloat16;
using bf16x8=__attribute__((ext_vector_type(8)))short;
using s16x4=__attribute__((ext_vector_type(4)))short;
using f32x16=__attribute__((ext_vector_type(16)))float;
using u32x4=__attribute__((ext_vector_type(4)))unsigned;
constexpr int D=64,QP=512,KP=128,OP=1024;
typedef float f32x4 __attribute__((ext_vector_type(4)));
constexpr int NW=8,QBLK=32,QB=QBLK*NW,KVBLK=64;
__device__ __forceinline__ int crow(int r,int hi){return (r&3)+8*(r>>2)+4*hi;}
#define SBAR() __builtin_amdgcn_sched_barrier(0)
#define ATTN_STORE16(p,v) (*(u32x4*)(p)=(v))
__device__ __forceinline__ void mmask(f32x16&p0,f32x16&p1,bool any,bool all){
  const float NEG=-INFINITY;
  #pragma unroll
  for(int r=0;r<16;++r){p1[r]=any?NEG:p1[r]; p0[r]=((r>=8)?any:all)?NEG:p0[r];}
}
constexpr int NSLOT=3, SLOTB=8192;
constexpr int LDS_K=0, LDS_V=NSLOT*SLOTB, LDS_WS=2*NSLOT*SLOTB, LDS_OST=LDS_WS+NW*64*4, LDS_BYTES=LDS_OST+NW*4096;
constexpr float C2=0.125f*1.4426950408889634f;
__device__ __forceinline__ void glds16(const void*gsrc,unsigned lds_dst){unsigned keep;
  asm volatile("s_mov_b32 %0, m0\n\ts_mov_b32 m0, %2\n\ts_nop 0\n\tglobal_load_lds_dwordx4 %1, off\n\ts_mov_b32 m0, %0":"=&s"(keep):"v"(gsrc),"s"(lds_dst):"memory");}
__device__ __forceinline__ float max3f(float a,float b,float c){float r;asm("v_max3_f32 %0, %1, %2, %3":"=v"(r):"v"(a),"v"(b),"v"(c));return r;}
__device__ __forceinline__ float max2f(float a,float b){float r;asm("v_max_f32_e32 %0, %1, %2":"=v"(r):"v"(a),"v"(b));return r;}
__device__ __forceinline__ float fadd_s(float a,float b){float r;asm("v_add_f32_e32 %0, %1, %2":"=v"(r):"v"(a),"v"(b));return r;}
__device__ __forceinline__ float fsub_s(float a,float b){float r;asm("v_sub_f32_e32 %0, %1, %2":"=v"(r):"v"(a),"v"(b));return r;}
typedef float f32x2_t __attribute__((ext_vector_type(2))); typedef __bf16 bf16x2_t __attribute__((ext_vector_type(2)));
__device__ __forceinline__ unsigned cvtpk_s(float lo,float hi){f32x2_t v={lo,hi};bf16x2_t b=__builtin_convertvector(v,bf16x2_t);return __builtin_bit_cast(unsigned,b);}
#define WAIT_BAR(N) asm volatile("s_waitcnt vmcnt(" #N ") lgkmcnt(0)\n\ts_barrier":::"memory")

__device__ __forceinline__ void qkt(f32x16&p0,f32x16&p1,const char*Kslot,const bf16x8*qr,const f32x16&negm,int r32,int hi){
  const char*kb=Kslot+hi*1024+r32*16;
  #pragma unroll
  for(int d0=0;d0<4;++d0){
    const bf16x8 b0=*reinterpret_cast<const bf16x8*>(kb+d0*2048);
    const bf16x8 b1=*reinterpret_cast<const bf16x8*>(kb+d0*2048+512);
    if(d0==0){p0=__builtin_amdgcn_mfma_f32_32x32x16_bf16(b0,qr[0],negm,0,0,0);p1=__builtin_amdgcn_mfma_f32_32x32x16_bf16(b1,qr[0],negm,0,0,0);}
    else{p0=__builtin_amdgcn_mfma_f32_32x32x16_bf16(b0,qr[d0],p0,0,0,0);p1=__builtin_amdgcn_mfma_f32_32x32x16_bf16(b1,qr[d0],p1,0,0,0);}}
}
typedef __attribute__((address_space(3))) const char* lds_cptr;
typedef short v4i16_t __attribute__((ext_vector_type(4)));
__device__ __forceinline__ void kload8(bf16x8*kf,lds_cptr kp){
  kf[0]=*(const __attribute__((address_space(3))) bf16x8*)(kp);      kf[1]=*(const __attribute__((address_space(3))) bf16x8*)(kp+512);
  kf[2]=*(const __attribute__((address_space(3))) bf16x8*)(kp+2048); kf[3]=*(const __attribute__((address_space(3))) bf16x8*)(kp+2560);
  kf[4]=*(const __attribute__((address_space(3))) bf16x8*)(kp+4096); kf[5]=*(const __attribute__((address_space(3))) bf16x8*)(kp+4608);
  kf[6]=*(const __attribute__((address_space(3))) bf16x8*)(kp+6144); kf[7]=*(const __attribute__((address_space(3))) bf16x8*)(kp+6656);
}
__device__ __forceinline__ void kload2(bf16x8*kf,lds_cptr kp,int j){ kf[2*j]=*(const __attribute__((address_space(3))) bf16x8*)(kp+j*2048); kf[2*j+1]=*(const __attribute__((address_space(3))) bf16x8*)(kp+j*2048+512); }
__device__ __forceinline__ s16x4 vtr(lds_cptr p){ return __builtin_bit_cast(s16x4,__builtin_amdgcn_ds_read_tr16_b64_v4i16((__attribute__((address_space(3))) v4i16_t*)p)); }
__device__ __forceinline__ float rowmax(const f32x16&p0,const f32x16&p1){
  float a=max3f(p0[0],p0[1],p1[0]),b=max3f(p0[2],p0[3],p1[1]);a=max3f(a,p1[2],p1[3]);
  #pragma unroll
  for(int r=4;r<16;r+=4){a=max3f(a,p0[r],p0[r+1]);b=max3f(b,p0[r+2],p0[r+3]);a=max3f(a,p1[r],p1[r+1]);b=max3f(b,p1[r+2],p1[r+3]);}
  const float m=max2f(a,b);
  auto rr=__builtin_amdgcn_permlane32_swap(__float_as_uint(m),__float_as_uint(m),false,false);
  return max2f(__uint_as_float(rr[0]),__uint_as_float(rr[1]));
}
__device__ __forceinline__ void pv(f32x16*o,int vb,bf16x8 pa0,bf16x8 pa1,bf16x8 pa2,bf16x8 pa3){
  #pragma unroll
  for(int d0=0;d0<2;++d0){s16x4 lo[4],hi[4];
    #pragma unroll
    for(int ks=0;ks<4;++ks){
      asm volatile("ds_read_b64_tr_b16 %0,%1 offset:%c2":"=&v"(lo[ks]):"v"(vb),"i"(d0*4096+ks*1024):"memory");
      asm volatile("ds_read_b64_tr_b16 %0,%1 offset:%c2":"=&v"(hi[ks]):"v"(vb),"i"(d0*4096+ks*1024+512):"memory");}
    asm volatile("s_waitcnt lgkmcnt(0)":::"memory");SBAR();
    #define PK(k) (bf16x8){lo[k][0],lo[k][1],lo[k][2],lo[k][3],hi[k][0],hi[k][1],hi[k][2],hi[k][3]}
    o[d0]=__builtin_amdgcn_mfma_f32_32x32x16_bf16(pa0,PK(0),o[d0],0,0,0);
    o[d0]=__builtin_amdgcn_mfma_f32_32x32x16_bf16(pa1,PK(1),o[d0],0,0,0);
    o[d0]=__builtin_amdgcn_mfma_f32_32x32x16_bf16(pa2,PK(2),o[d0],0,0,0);
    o[d0]=__builtin_amdgcn_mfma_f32_32x32x16_bf16(pa3,PK(3),o[d0],0,0,0);
    #undef PK
  }
}

template<int THRL> __device__ __forceinline__ void attn_unit(long qrow0,int is_meta,long kvbase,int NR,long metarow,int h,const bf16*Q,const bf16*__restrict__ K,const bf16*__restrict__ V,bf16*O,char*shm){
  int tid_=threadIdx.x; asm volatile("":"+v"(tid_)); const int tid=tid_,lane=tid&63,r32=lane&31,hi=lane>>5; const int wid=__builtin_amdgcn_readfirstlane(tid>>6);
  const long qrow_l=is_meta?(metarow+(long)(r32&15)):(qrow0+wid*QBLK+r32);
  const int h_l=is_meta?(h+2*(wid&1)+(r32>>4)):h;
  const bf16*Qw=Q+qrow_l*QP+h_l*D;
  const bf16*Kh=K+(h>>2)*D,*Vh=V+(h>>2)*D;
  const unsigned lds0=(unsigned)(uintptr_t)shm;
  float*wsf=(float*)(shm+LDS_WS)+wid*64;
  const bf16*ksrc=Kh+(long)lane*KP+wid*8;
  const bf16*vsrc=Vh+(long)(16*(wid&3)+(lane>>2))*KP+(wid>>2)*32+(lane&3)*8;
  #define TROW(t) (kvbase+(long)(t)*KVBLK)
  const unsigned kdst=lds0+LDS_K+wid*1024, vdst=lds0+LDS_V+wid*1024;
  #define DMA_K(t,slot) glds16(ksrc+TROW(t)*KP,(unsigned)__builtin_amdgcn_readfirstlane(kdst+(slot)))
  #define DMA_V(t,slot) glds16(vsrc+TROW(t)*KP,(unsigned)__builtin_amdgcn_readfirstlane(vdst+(slot)))
  const int vb0=(int)(lds0+LDS_V)+((lane>>4)&1)*32+(lane&3)*8+(4*hi+((lane&15)>>2))*64;
  const char*Kbase=shm+LDS_K; bf16x8 kf[8];
  const lds_cptr shm3=(lds_cptr)shm; const lds_cptr kp0=shm3+LDS_K+hi*1024+r32*16; const lds_cptr vp0=shm3+LDS_V+((lane>>4)&1)*32+(lane&3)*8+(4*hi+((lane&15)>>2))*64;
  const int NT=NR+2;
  DMA_K(0,0);DMA_V(0,0);DMA_K(1,SLOTB);
  bf16x8 qr[4];
  #pragma unroll
  for(int d0=0;d0<4;++d0)qr[d0]=*reinterpret_cast<const bf16x8*>(&Qw[d0*16+hi*8]);
  float mhat=0.f,l_reg=0.f;f32x16 o[2];o[0]=f32x16{};o[1]=f32x16{};f32x16 negm=f32x16{};asm volatile("":"+v"(negm));
  #define CMASK(P0,P1,t) do{ mmask(P0,P1,(t)>=NT-2,(t)==NT-1); }while(0)
  bool resc=false;
  #define START(P0,P1) do{ const float rm=rowmax(P0,P1); resc=false; \
    { const float dl=rm; mhat=fadd_s(mhat,dl); \
      _Pragma("unroll") for(int r=0;r<16;++r){P0[r]=fsub_s(P0[r],dl);P1[r]=fsub_s(P1[r],dl);} \
      _Pragma("unroll") for(int r=0;r<16;++r)negm[r]=-mhat; asm volatile("":"+v"(negm)); } \
    _Pragma("unroll") for(int r=0;r<16;++r)P0[r]=__builtin_amdgcn_exp2f(P0[r]); }while(0)
  #define RESC() do{ if(resc){ asm volatile("s_waitcnt lgkmcnt(0)":::"memory"); \
      _Pragma("unroll") for(int d_=0;d_<2;++d_) _Pragma("unroll") for(int r=0;r<16;++r)o[d_][r]*=wsf[crow(r,hi)]; } }while(0)
  f32x16 pA0,pA1,pB0,pB1;
  int sl_prev=0,sl_cur=0,sl_next=SLOTB;
  #define ROT() do{sl_prev=sl_cur;sl_cur=sl_next;sl_next=(sl_next==(NSLOT-1)*SLOTB)?0:sl_next+SLOTB;}while(0)
  DMA_K(2,2*SLOTB);
  WAIT_BAR(3);
  qkt(pA0,pA1,Kbase,qr,negm,r32,hi);asm volatile("s_nop 15\n\ts_nop 7":"+v"(pA0),"+v"(pA1));
  START(pA0,pA1);
  _Pragma("unroll") for(int r=0;r<16;++r)pA1[r]=__builtin_amdgcn_exp2f(pA1[r]);
  WAIT_BAR(0);
  DMA_K(3,0);DMA_V(1,SLOTB);
  ROT();
  kload8(kf,kp0+sl_cur);
  WAIT_BAR(2);
  s16x4 vlo[8],vhi[8]; u32x4 pw0,pw1,pw2,pw3;
  #define PKW(P,B) cvtpk_s(P[B],P[B+1])
  #define PAF(k) __builtin_bit_cast(bf16x8,pw##k)
  #define VFR(i) (bf16x8){vlo[i][0],vlo[i][1],vlo[i][2],vlo[i][3],vhi[i][0],vhi[i][1],vhi[i][2],vhi[i][3]}
  #define PIN(x) asm volatile("":"+v"(x))
  #define MX3(a,b,c) __builtin_fmaxf(__builtin_fmaxf((a),(b)),(c))
  #define GAPA(MF,A0,A1,A2,A3,W0,W1,PW) do{ MF; sacc+=A0; sacc+=A1; sacc+=A2; sacc+=A3; PIN(sacc); W0; W1; PIN(PW); SBAR(); }while(0)
  #define EX(v) __builtin_amdgcn_exp2f(v)
  #define GAPB(MF,X,B) do{ MF; X[B]=EX(X[B]); X[B+1]=EX(X[B+1]); X[B+2]=EX(X[B+2]); X[B+3]=EX(X[B+3]); PIN(X); SBAR(); }while(0)
  #define VRD(i) do{ vlo[i]=vtr(vp_+(((i)>>2)*4096+((i)&3)*1024)); vhi[i]=vtr(vp_+(((i)>>2)*4096+((i)&3)*1024+512)); }while(0)
  #define KRD(G,j) do{ if(G){ kload2(kf,kp0+sl_next,j); SBAR(); } }while(0)
  #define STEP(C0,C1,P0,P1,t,GK,GV,GL) do{ SBAR(); \
    const lds_cptr vp_=vp0+sl_prev; \
    VRD(0); SBAR(); float sacc=(P0[0]+P0[1]); \
    GAPA(C0=__builtin_amdgcn_mfma_f32_32x32x16_bf16(kf[0],qr[0],negm,0,0,0), P0[2],P0[3],P0[4],P0[5],     pw0[0]=PKW(P0,0), pw0[1]=PKW(P0,2), pw0); \
    VRD(4); SBAR(); GAPA(C1=__builtin_amdgcn_mfma_f32_32x32x16_bf16(kf[1],qr[0],negm,0,0,0), P0[6],P0[7],P0[8],P0[9],     pw0[2]=PKW(P0,4), pw0[3]=PKW(P0,6), pw0); \
    VRD(1); SBAR(); GAPA(C0=__builtin_amdgcn_mfma_f32_32x32x16_bf16(kf[2],qr[1],C0,0,0,0),   P0[10],P0[11],P0[12],P0[13], pw1[0]=PKW(P0,8), pw1[1]=PKW(P0,10), pw1); \
    VRD(5); SBAR(); GAPA(C1=__builtin_amdgcn_mfma_f32_32x32x16_bf16(kf[3],qr[1],C1,0,0,0),   P0[14],P0[15],P1[0],P1[1],   pw1[2]=PKW(P0,12),pw1[3]=PKW(P0,14), pw1); \
    VRD(2); SBAR(); GAPA(C0=__builtin_amdgcn_mfma_f32_32x32x16_bf16(kf[4],qr[2],C0,0,0,0),   P1[2],P1[3],P1[4],P1[5],     pw2[0]=PKW(P1,0), pw2[1]=PKW(P1,2), pw2); \
    VRD(6); SBAR(); GAPA(C1=__builtin_amdgcn_mfma_f32_32x32x16_bf16(kf[5],qr[2],C1,0,0,0),   P1[6],P1[7],P1[8],P1[9],     pw2[2]=PKW(P1,4), pw2[3]=PKW(P1,6), pw2); \
    VRD(3); SBAR(); GAPA(C0=__builtin_amdgcn_mfma_f32_32x32x16_bf16(kf[6],qr[3],C0,0,0,0),   P1[10],P1[11],P1[12],P1[13], pw3[0]=PKW(P1,8), pw3[1]=PKW(P1,10), pw3); \
    VRD(7); SBAR(); GAPA(C1=__builtin_amdgcn_mfma_f32_32x32x16_bf16(kf[7],qr[3],C1,0,0,0),   P1[14],P1[15],0.f,0.f,       pw3[2]=PKW(P1,12),pw3[3]=PKW(P1,14), pw3); \
    l_reg+=sacc; \
    if(GK){DMA_K((t)+3,sl_cur);} if(GV){DMA_V((t)+1,sl_next);} \
    CMASK(C0,C1,t); \
    { float a=MX3(C0[0],C0[1],C1[0]),b=MX3(C0[2],C0[3],C1[1]); a=MX3(a,C1[2],C1[3]); \
      _Pragma("unroll") for(int r=4;r<16;r+=4){a=MX3(a,C0[r],C0[r+1]);b=MX3(b,C0[r+2],C0[r+3]);a=MX3(a,C1[r],C1[r+1]);b=MX3(b,C1[r+2],C1[r+3]);} \
      float rm=__builtin_fmaxf(a,b); { auto rr=__builtin_amdgcn_permlane32_swap(__float_as_uint(rm),__float_as_uint(rm),false,false); rm=__builtin_fmaxf(__uint_as_float(rr[0]),__uint_as_float(rr[1])); } \
      resc=false; \
      if(__builtin_expect(__any(rm>(float)THRL),0)){ const float dl=__builtin_fmaxf(rm,0.f); mhat+=dl; \
        _Pragma("unroll") for(int r=0;r<16;++r){C0[r]-=dl;C1[r]-=dl;} \
        _Pragma("unroll") for(int r=0;r<16;++r)negm[r]=-mhat; asm volatile("":"+v"(negm)); \
        const float f=__builtin_amdgcn_exp2f(-dl); l_reg*=f; if(hi==0)wsf[r32]=f; resc=true; } } \
    SBAR(); \
    GAPB(o[0]=__builtin_amdgcn_mfma_f32_32x32x16_bf16(PAF(0),VFR(0),o[0],0,0,0), C0,0); \
    GAPB(o[1]=__builtin_amdgcn_mfma_f32_32x32x16_bf16(PAF(0),VFR(4),o[1],0,0,0), C0,4); \
    KRD(GL,0); GAPB(o[0]=__builtin_amdgcn_mfma_f32_32x32x16_bf16(PAF(1),VFR(1),o[0],0,0,0), C0,8); \
    KRD(GL,1); GAPB(o[1]=__builtin_amdgcn_mfma_f32_32x32x16_bf16(PAF(1),VFR(5),o[1],0,0,0), C0,12); \
    KRD(GL,2); GAPB(o[0]=__builtin_amdgcn_mfma_f32_32x32x16_bf16(PAF(2),VFR(2),o[0],0,0,0), C1,0); \
    KRD(GL,3); GAPB(o[1]=__builtin_amdgcn_mfma_f32_32x32x16_bf16(PAF(2),VFR(6),o[1],0,0,0), C1,4); \
    GAPB(o[0]=__builtin_amdgcn_mfma_f32_32x32x16_bf16(PAF(3),VFR(3),o[0],0,0,0), C1,8); \
    GAPB(o[1]=__builtin_amdgcn_mfma_f32_32x32x16_bf16(PAF(3),VFR(7),o[1],0,0,0), C1,12); \
    }while(0)
  int t=1;
  #undef CMASK
  #define CMASK(P0,P1,t) do{}while(0)
  for(;t+5<NT;t+=2){
    STEP(pB0,pB1,pA0,pA1,t,true,true,true);     WAIT_BAR(2); RESC(); ROT();
    STEP(pA0,pA1,pB0,pB1,t+1,true,true,true);   WAIT_BAR(2); RESC(); ROT();
  }
  #undef CMASK
  #define CMASK(P0,P1,t) do{ mmask(P0,P1,(t)>=NT-2,(t)==NT-1); }while(0)
  #define ENDW(tt) do{ if((tt)+3<NT){WAIT_BAR(2);} else if((tt)+2<NT){WAIT_BAR(1);} else {WAIT_BAR(0);} }while(0)
  for(;t+1<NT;t+=2){
    STEP(pB0,pB1,pA0,pA1,t,(t+3<NT),(t+1<NT),(t+1<NT));       ENDW(t);   RESC(); ROT();
    STEP(pA0,pA1,pB0,pB1,t+1,(t+4<NT),(t+2<NT),(t+2<NT));     ENDW(t+1); RESC(); ROT();
  }
  STEP(pB0,pB1,pA0,pA1,NT-1,false,false,false); RESC();
  { float sacc=pB0[0]+pB0[1]; _Pragma("unroll") for(int r=2;r<16;++r)sacc+=pB0[r]; _Pragma("unroll") for(int r=0;r<16;++r)sacc+=pB1[r]; l_reg+=sacc;
    pw0=(u32x4){PKW(pB0,0),PKW(pB0,2),PKW(pB0,4),PKW(pB0,6)};pw1=(u32x4){PKW(pB0,8),PKW(pB0,10),PKW(pB0,12),PKW(pB0,14)};pw2=(u32x4){PKW(pB1,0),PKW(pB1,2),PKW(pB1,4),PKW(pB1,6)};pw3=(u32x4){PKW(pB1,8),PKW(pB1,10),PKW(pB1,12),PKW(pB1,14)};
    SBAR(); pv(o,vb0+sl_cur,PAF(0),PAF(1),PAF(2),PAF(3)); }
  #undef PKW
  #undef PAF
  #undef VFR
  #undef PIN
  #undef MX3
  #undef GAPA
  #undef GAPB
  #undef EX
  #undef VRD
  #undef KRD
  #undef STEP
  #undef ENDW
  {auto rr=__builtin_amdgcn_permlane32_swap(__float_as_uint(l_reg),__float_as_uint(l_reg),false,false);l_reg=__uint_as_float(rr[0])+__uint_as_float(rr[1]);}
  if(hi==0)wsf[32+r32]=l_reg;asm volatile("s_waitcnt lgkmcnt(0)":::"memory");
  float rli[16];
  #pragma unroll
  for(int r=0;r<16;++r)rli[r]=__builtin_amdgcn_rcpf(wsf[32+crow(r,hi)]);
  { bf16*stg=(bf16*)(shm+LDS_OST)+wid*2048;
    #pragma unroll
    for(int r=0;r<16;++r){const int orow=crow(r,hi);
      #pragma unroll
      for(int d0=0;d0<2;++d0)stg[orow*64+d0*32+r32]=__float2bfloat16(o[d0][r]*rli[r]);}
    asm volatile("s_waitcnt lgkmcnt(0)":::"memory");
    #pragma unroll
    for(int i=0;i<4;++i){const int row=i*8+(lane>>3),ch=lane&7; const u32x4 w=*(const u32x4*)(stg+row*64+ch*8);
      float x[8];
      #pragma unroll
      for(int e=0;e<4;++e){x[2*e]=__uint_as_float(w[e]<<16); x[2*e+1]=__uint_as_float(w[e]&0xffff0000u);}
      float ss=((x[0]*x[0]+x[1]*x[1])+(x[2]*x[2]+x[3]*x[3]))+((x[4]*x[4]+x[5]*x[5])+(x[6]*x[6]+x[7]*x[7]));
      ss+=__shfl_xor(ss,1); ss+=__shfl_xor(ss,2); ss+=__shfl_xor(ss,4);
      const float rn=rsqrtf(ss*(1.0f/64.0f)+1e-6f);
      u32x4 v; v.x=cvtpk_s(x[0]*rn,x[1]*rn); v.y=cvtpk_s(x[2]*rn,x[3]*rn); v.z=cvtpk_s(x[4]*rn,x[5]*rn); v.w=cvtpk_s(x[6]*rn,x[7]*rn);
      const long orow_g=is_meta?(metarow+(row&15)):(qrow0+wid*QBLK+row);
      const int h_o=is_meta?(h+2*wid+(row>>4)):h;
      const bool ok=(!is_meta)||(wid<2);
      if(ok) ATTN_STORE16(O+orow_g*OP+h_o*D+ch*8,v);} }
  asm volatile("s_waitcnt lgkmcnt(0)\n\ts_barrier":::"memory");
  #undef DMA_K
  #undef TROW
  #undef DMA_V
  #undef CMASK
  #undef START
  #undef RESC
  #undef ROT
}
constexpr int ATTN_LDS_BYTES=LDS_BYTES;
#undef SBAR
#undef WAIT_BAR
}

constexpr int NWAVES = 8;
constexpr int DM = 1024, DFF = 2816, NIN = 2304, DEPTH = 4;
constexpr int NREAL = 81920, MB = 81920, MP = 82688;
constexpr int NSEQ = 12;
constexpr size_t MiB = 1u << 20;
constexpr size_t WS_CTL = 0, WS_ROPE = 65536, WS_STATS = 131072, WS_W = 6 * MiB, WS_H = 165 * MiB, WS_BIG = 327 * MiB;
constexpr size_t WS_END = WS_BIG + (size_t)MP * 2816 * 2;
constexpr size_t W_GU = (size_t)2 * DFF * DM, W_D = (size_t)DM * DFF, W_IN = (size_t)NIN * DM, W_OUT = (size_t)DM * DM;
constexpr size_t WL_1GU = 0, WL_1D = WL_1GU + W_GU, WL_IN = WL_1D + W_D, WL_OUT = WL_IN + W_IN, WL_2GU = WL_OUT + W_OUT, WL_2D = WL_2GU + W_GU, WL_SZ = WL_2D + W_D;
static_assert(WS_STATS + (size_t)MP * 16 * 4 <= WS_W && WS_W + WL_SZ * 2 * DEPTH <= WS_H && WS_H + (size_t)MP * DM * 2 <= WS_BIG, "ws map");
constexpr int CTL_WORDS = 16384, CW_BAR = 4096;
constexpr int RING_BYTES = 131072, LDS_BYTES = 147456;
static_assert(attn_body::ATTN_LDS_BYTES <= RING_BYTES, "attention LDS");

#define LAS __attribute__((address_space(3)))
typedef unsigned short bf16;
typedef unsigned v4u __attribute__((ext_vector_type(4)));
typedef float f32x4 __attribute__((ext_vector_type(4)));
__device__ __forceinline__ unsigned f2bf(float f) { unsigned u = __builtin_bit_cast(unsigned, f); return (u + 0x7fffu + ((u >> 16) & 1u)) >> 16; }
__device__ __forceinline__ unsigned pk2(float lo, float hi) { return f2bf(lo) | (f2bf(hi) << 16); }
__device__ __forceinline__ float bflo(unsigned w) { return __builtin_bit_cast(float, w << 16); }
__device__ __forceinline__ float bfhi(unsigned w) { return __builtin_bit_cast(float, w & 0xffff0000u); }
__device__ __forceinline__ float wave_sum(float v) {
#pragma unroll
    for (int o = 1; o < 64; o <<= 1) v += __shfl_xor(v, o);
    return v;
}
__device__ __forceinline__ void tr_item(const float* W, int K, int N, const float* gain, bf16* WT, int drow0, LAS float* scr, int k0, int n0, int lane) {
#pragma unroll 16
    for (int i = 0; i < 32; ++i) { const int kk = 2 * i + (lane >> 5); const float g = gain ? gain[k0 + kk] : 1.0f; scr[kk * 33 + (lane & 31)] = g * W[(size_t)(k0 + kk) * N + n0 + (lane & 31)]; }
    asm volatile("s_waitcnt lgkmcnt(0)" ::: "memory");
    const int c = lane & 7;
#pragma unroll
    for (int j = 0; j < 4; ++j) { const int n = (lane >> 3) + 8 * j; const LAS float* s = scr + (8 * c) * 33 + n;
        v4u o; o.x = pk2(s[0 * 33], s[1 * 33]); o.y = pk2(s[2 * 33], s[3 * 33]); o.z = pk2(s[4 * 33], s[5 * 33]); o.w = pk2(s[6 * 33], s[7 * 33]);
        *(v4u*)(WT + (size_t)(drow0 + n) * K + k0 + 8 * c) = o; }
    asm volatile("s_waitcnt lgkmcnt(0)" ::: "memory");
}
__device__ __forceinline__ int win_drow(int n0) {
    if (n0 < 1280) { const int hd = n0 >> 6, bj = (n0 >> 5) & 1; return 256 * (hd >> 2) + 128 * bj + 32 * (hd & 3); }
    if (n0 < 1792) { const int t = (n0 - 1280) >> 7, w = (n0 - 1280) & 127; return 1280 + 256 * t + w; }
    { const int t = (n0 - 1792) >> 7, w = (n0 - 1792) & 127; return 1280 + 256 * t + 128 + w; }
}
__device__ __forceinline__ long seq_base(int q) { return q < 4 ? 4096L * q : 16384L + 8192L * (q - 4); }

#define GAS __attribute__((address_space(1)))
#define XB_TMO      128
#define XB_XCNT(j)  (256  + 64 * (j))
#define XB_XSUB(j)  (1280 + 64 * (j))
#define XB_XGEN(j)  (2304 + 64 * (j))
#define XB_TOP      3328
#define XB_TOPGEN   3392
#define XCD_BAR_WORDS 3456
#define XB_SPIN_CAP (1u << 18)

__device__ __forceinline__ unsigned xb_ld(unsigned* p)              { return __hip_atomic_load(p, __ATOMIC_RELAXED, __HIP_MEMORY_SCOPE_AGENT); }
__device__ __forceinline__ unsigned xb_add(unsigned* p, unsigned v) { return __hip_atomic_fetch_add(p, v, __ATOMIC_RELAXED, __HIP_MEMORY_SCOPE_AGENT); }
__device__ __forceinline__ unsigned xb_xcc_id() { return (unsigned)__builtin_amdgcn_s_getreg((3 << 11) | 20) & 0xFu; }
#define XB_SPIN(cond, bar) do { unsigned _sp = 0; while (cond) { __builtin_amdgcn_s_sleep(1); \
    if ((++_sp & 255u) == 0u) { if (xb_ld(&(bar)[XB_TMO])) break; if (_sp > XB_SPIN_CAP) { atomicAdd(&(bar)[XB_TMO], 1u); break; } } } } while (0)

struct XcdBarrier {
    unsigned* bar; unsigned x;
    volatile LAS unsigned* st;
};

__device__ __forceinline__ XcdBarrier xcd_barrier_post(unsigned* bar, volatile LAS unsigned* st) {
    XcdBarrier b; b.bar = bar; b.x = xb_xcc_id(); b.st = st;
    if (threadIdx.x == 0) (void)xb_add(&bar[XB_XCNT(b.x)], 1u);
    return b;
}
__device__ __forceinline__ void xcd_barrier_complete(unsigned* bar, unsigned x, unsigned& nloc, unsigned& nx) {
    const unsigned G = gridDim.x * gridDim.y * gridDim.z;
    unsigned sum, cnt, mine, sp = 0u;
    for (;;) {
        sum = 0u; cnt = 0u; mine = 0u;
#pragma unroll
        for (unsigned j = 0; j < 16; ++j) { const unsigned c = xb_ld(&bar[XB_XCNT(j)]); sum += c; cnt += (c > 0u) ? 1u : 0u; mine = (j == x) ? c : mine; }
        if (sum == G) break;
        __builtin_amdgcn_s_sleep(1);
        if ((++sp & 255u) == 0u) { if (xb_ld(&bar[XB_TMO])) break; if (sp > XB_SPIN_CAP) { atomicAdd(&bar[XB_TMO], 1u); break; } }
    }
    nloc = mine > 0u ? mine : 1u; nx = cnt > 0u ? cnt : 1u;
}

__device__ __forceinline__ void xcd_barrier(const XcdBarrier& b) {
    asm volatile("s_waitcnt vmcnt(0)" ::: "memory");
    __syncthreads();
    if (threadIdx.x == 0) {
        unsigned* bar = b.bar;
        __builtin_amdgcn_s_waitcnt(0);
        unsigned nloc = b.st[0], nx = b.st[1];
        if (nloc == 0u) { xcd_barrier_complete(bar, b.x, nloc, nx); b.st[0] = nloc; b.st[1] = nx; }
        const unsigned old = xb_add(&bar[XB_XSUB(b.x)], 1u);
        const unsigned gen = old / nloc;
        if (old + 1u == (gen + 1u) * nloc) {
            __builtin_amdgcn_fence(__ATOMIC_RELEASE, "agent");
            asm volatile("s_waitcnt vmcnt(0)" ::: "memory");
            const unsigned og = xb_add(&bar[XB_TOP], 1u);
            const unsigned tg = og / nx;
            if (og + 1u == (tg + 1u) * nx) xb_add(&bar[XB_TOPGEN], 1u);
            else XB_SPIN(xb_ld(&bar[XB_TOPGEN]) == tg, bar);
            __builtin_amdgcn_fence(__ATOMIC_ACQUIRE, "agent");
            xb_add(&bar[XB_XGEN(b.x)], 1u);
            asm volatile("s_waitcnt vmcnt(0)" ::: "memory");
        } else {
            XB_SPIN(xb_ld(&bar[XB_XGEN(b.x)]) == gen, bar);
            __builtin_amdgcn_fence(__ATOMIC_ACQUIRE, "agent");
            asm volatile("s_waitcnt vmcnt(0)" ::: "memory");
        }
    }
    __syncthreads();
}

static_assert(CW_BAR + XCD_BAR_WORDS <= CTL_WORDS && CTL_WORDS * 4 <= (int)WS_ROPE, "ctl map");

struct Args { const float* in[21]; float* out; unsigned char* ws; };

__global__ void __launch_bounds__(NWAVES * 64, 2) hymba_fwd(Args args) {
    extern __shared__ __attribute__((aligned(16))) unsigned char lds[];
    cg::grid_group grid = cg::this_grid();
    const int tid = threadIdx.x, lane0 = tid & 63, wave = __builtin_amdgcn_readfirstlane(tid >> 6);
    const int G = gridDim.x, bx = blockIdx.x;
    const int gw = bx * NWAVES + wave, NGW = G * NWAVES;
    unsigned char* ws = args.ws;
    unsigned* ctl = (unsigned*)(ws + WS_CTL);
    float* rope = (float*)(ws + WS_ROPE);
    float* stats = (float*)(ws + WS_STATS);
    bf16* Wb = (bf16*)(ws + WS_W);
    bf16* HB = (bf16*)(ws + WS_H);
    bf16* BIG = (bf16*)(ws + WS_BIG);
    bf16* ACT = BIG;
    bf16* Qb = BIG; bf16* Kb = BIG + (size_t)MP * 512; bf16* Vb = BIG + (size_t)MP * 640; bf16* CBb = BIG + (size_t)MP * 768; bf16* Ub = BIG + (size_t)MP * 1280; bf16* Yb = BIG + (size_t)MP * 1792;
    LAS unsigned char* ldsp = (LAS unsigned char*)lds;
    const float* x_prompt = args.in[0]; const float* x_sample = args.in[1]; const float* meta = args.in[2];

    {
        const int lane = lane0;
        for (int i = bx * (NWAVES * 64) + tid; i < CTL_WORDS; i += G * NWAVES * 64) ctl[i] = 0u;
        if (tid < 2) ((LAS unsigned*)(ldsp + RING_BYTES + 128))[tid] = 0u;
        { const int gt = bx * (NWAVES * 64) + tid;
          if (gt < 2048) { const int pos = gt >> 4, i = gt & 15; const double fr = exp2(-(double)i * (13.287712379549449 / 16.0)); double s, c; sincos((double)pos * fr, &s, &c); rope[2 * gt] = (float)c; rope[2 * gt + 1] = (float)s; } }
        LAS float* scr = (LAS float*)(ldsp + wave * 16384);
        constexpr int I_GU = 16 * 88, I_D = 44 * 32, I_IN = 16 * 72, I_OUT = 16 * 32, I_L = 4 * I_GU + 2 * I_D + I_IN + I_OUT;
        for (int it = gw; it < DEPTH * I_L; it += NGW) {
            const int l = it / I_L; int r = it % I_L; bf16* WL = Wb + (size_t)l * WL_SZ;
            if (r < 4 * I_GU) { const int which = r / I_GU; r %= I_GU; const int kb = r / 88, nb = r % 88, n0 = 32 * nb;
                const float* W = args.in[(which < 2 ? 4 : 17) + (which & 1)] + (size_t)l * DM * DFF; const float* gn = args.in[which < 2 ? 3 : 16] + l * DM;
                tr_item(W, DM, DFF, gn, WL + (which < 2 ? WL_1GU : WL_2GU), 256 * (n0 >> 7) + (n0 & 127) + ((which & 1) ? 128 : 0), scr, 64 * kb, n0, lane); continue; }
            r -= 4 * I_GU;
            if (r < 2 * I_D) { const int which = r / I_D; r %= I_D; const int kb = r / 32, nb = r % 32;
                tr_item(args.in[which ? 19 : 6] + (size_t)l * DFF * DM, DFF, DM, nullptr, WL + (which ? WL_2D : WL_1D), 32 * nb, scr, 64 * kb, 32 * nb, lane); continue; }
            r -= 2 * I_D;
            if (r < I_IN) { const int kb = r / 72, nb = r % 72;
                tr_item(args.in[8] + (size_t)l * DM * NIN, DM, NIN, args.in[7] + l * DM, WL + WL_IN, win_drow(32 * nb), scr, 64 * kb, 32 * nb, lane); continue; }
            r -= I_IN;
            { const int kb = r / 32, nb = r % 32; const int k0 = 64 * kb;
              const float* gn = (k0 < 512) ? (args.in[13] + l * 512 + 0) : (args.in[14] + l * 512 - 512);
              tr_item(args.in[15] + (size_t)l * DM * DM, DM, DM, gn, WL + WL_OUT, 32 * nb, scr, k0, 32 * nb, lane); }
        }
        for (int row0 = gw; row0 < MP; row0 += 2 * NGW) {
            f32x4 v[2][4]; float ss[2]; const int rows[2] = {row0, row0 + NGW};
#pragma unroll
            for (int r = 0; r < 2; ++r) { const int row = rows[r]; const float* src = nullptr;
                if (row < 16384) src = x_prompt + (size_t)row * DM; else if (row < NREAL) src = x_sample + (size_t)(row - 16384) * DM;
                else if (row < MP) { const int i = (row - MB) & 63; if (i < 16) src = meta + (size_t)i * DM; }
#pragma unroll
                for (int j = 0; j < 4; ++j) v[r][j] = src ? ((const f32x4*)src)[lane + 64 * j] : (f32x4){0.f, 0.f, 0.f, 0.f}; }
#pragma unroll
            for (int r = 0; r < 2; ++r) { float s = 0.f;
#pragma unroll
                for (int j = 0; j < 4; ++j) s += (v[r][j][0] * v[r][j][0] + v[r][j][1] * v[r][j][1]) + (v[r][j][2] * v[r][j][2] + v[r][j][3] * v[r][j][3]);
                ss[r] = wave_sum(s); }
#pragma unroll
            for (int r = 0; r < 2; ++r) { const int row = rows[r]; if (row < MP) {
#pragma unroll
                for (int j = 0; j < 4; ++j)
                    ((unsigned long long*)(HB + (size_t)row * DM))[lane + 64 * j] = (unsigned long long)pk2(v[r][j][0], v[r][j][1]) | ((unsigned long long)pk2(v[r][j][2], v[r][j][3]) << 32);
                if (lane < 16) stats[(size_t)row * 16 + lane] = (lane == 0) ? ss[r] : 0.f; } }
        }
    }
    grid.sync();
    const XcdBarrier xbar = xcd_barrier_post(ctl + CW_BAR, (volatile LAS unsigned*)(ldsp + RING_BYTES + 128));

    for (int l = 0; l < DEPTH; ++l) {
        const bf16* WL = Wb + (size_t)l * WL_SZ;
        for (int s = 0; s < 2; ++s) {
            if (s == 1) {
#ifndef NO_WIN
                { pg8::Gemm g{HB, WL + WL_IN, MP, NIN, DM}; pg8::StaticOrder S; S.init(MP, NIN, G, bx);
                  pg8::EpiWin E{Qb, Kb, Vb, CBb, Ub, stats, args.in[9] + l * 64, args.in[10] + l * 64, rope};
                  pg8::gemm_phase<pg8::EpiWin, pg8::StaticOrder, true, true>(ldsp, g, S, E); }
#endif

                xcd_barrier(xbar);
                {
                    int lane = lane0; asm volatile("" : "+v"(lane));
                    const float* cw = args.in[11] + (size_t)l * 3 * 512; const float* cbias = args.in[12] + (size_t)l * 512;
                    LAS volatile unsigned* qslot = (LAS volatile unsigned*)(ldsp + RING_BYTES);
                    constexpr int UPG_S = 4 * 32 + 1, UPG_P = 4 * 16 + 1, NU_S = 8 * 2 * UPG_S, NU_P = 4 * 2 * UPG_P, NU = NU_S + NU_P, NCH = MP / 64;
                    for (;;) {
                        if (tid == 0) qslot[0] = atomicAdd(ctl + l, 1u);
                        __syncthreads();
                        const int idx = __builtin_amdgcn_readfirstlane((int)qslot[0]);
                        if (idx >= NU + NCH) break;
                        if (idx < NU) {
                            int q, rem, nqb;
                            if (idx < NU_S) { q = 4 + idx / (2 * UPG_S); rem = idx % (2 * UPG_S); nqb = 32; } else { const int i2 = idx - NU_S; q = i2 / (2 * UPG_P); rem = i2 % (2 * UPG_P); nqb = 16; }
                            const int upg = 4 * nqb + 1, kvg = rem / upg, r2 = rem % upg;
                            const int is_meta = (r2 == 4 * nqb) ? 1 : 0, h = is_meta ? 4 * kvg : 4 * kvg + r2 / nqb, b = is_meta ? 0 : r2 % nqb;
                            const long sb = seq_base(q);
#ifndef NO_ATT
                            attn_body::attn_unit<8>(sb + 256L * b, is_meta, sb + 64L * q, nqb * 4, (long)(MB + 64 * q), h,
                                (const attn_body::bf16*)Qb, (const attn_body::bf16*)Kb, (const attn_body::bf16*)Vb, (attn_body::bf16*)Yb, (char*)lds);
#endif
                        } else {
                            f32x4 w0[2], w1[2], w2[2], bb[2];
#pragma unroll
                            for (int j = 0; j < 2; ++j) { w0[j] = *(const f32x4*)(cw + 8 * lane + 4 * j); w1[j] = *(const f32x4*)(cw + 512 + 8 * lane + 4 * j); w2[j] = *(const f32x4*)(cw + 1024 + 8 * lane + 4 * j); bb[j] = *(const f32x4*)(cbias + 8 * lane + 4 * j); }
                            const int rbase = (idx - NU) * 64 + wave * 8;
                            for (int rr = 0; rr < 8; ++rr) {
                                const int row = rbase + rr;
                                long prev = -1, next = -1; bool valid = true;
                                if (row < NREAL) { const int q = row < 16384 ? (row >> 12) : 4 + ((row - 16384) >> 13); const int nlen = row < 16384 ? 4096 : 8192; const int n = row & (nlen - 1);
                                    prev = (n == 0) ? (long)(MB + 64 * q + 15) : (long)row - 1; next = (n == nlen - 1) ? -1L : (long)row + 1; }
                                else { const int q = (row - MB) >> 6, i = (row - MB) & 63; valid = i < 16; prev = (i == 0) ? -1L : (long)row - 1; next = (i == 15) ? seq_base(q) : (long)row + 1; }
                                v4u* yo = (v4u*)(Yb + (size_t)row * 1024 + 512) + lane;
                                if (!valid) { *yo = (v4u){0u, 0u, 0u, 0u}; *((v4u*)(Yb + (size_t)row * 1024) + lane) = (v4u){0u, 0u, 0u, 0u}; continue; }
                                const v4u uc = *((const v4u*)(Ub + (size_t)row * 512) + lane);
                                const v4u up = prev >= 0 ? *((const v4u*)(Ub + (size_t)prev * 512) + lane) : (v4u){0u, 0u, 0u, 0u};
                                const v4u un = next >= 0 ? *((const v4u*)(Ub + (size_t)next * 512) + lane) : (v4u){0u, 0u, 0u, 0u};
                                const v4u cbv = *((const v4u*)(CBb + (size_t)row * 512) + lane);
                                float y[8]; float ss = 0.f;
#pragma unroll
                                for (int e = 0; e < 8; ++e) { const int wi = e >> 1; const bool hi_ = e & 1;
                                    const float a = hi_ ? bfhi(up[wi]) : bflo(up[wi]), b = hi_ ? bfhi(uc[wi]) : bflo(uc[wi]), c = hi_ ? bfhi(un[wi]) : bflo(un[wi]), d = hi_ ? bfhi(cbv[wi]) : bflo(cbv[wi]);
                                    const float t = a * w0[e >> 2][e & 3] + b * w1[e >> 2][e & 3] + c * w2[e >> 2][e & 3] + bb[e >> 2][e & 3];
                                    y[e] = d * t; ss += y[e] * y[e]; }
                                ss += __shfl_xor(ss, 1); ss += __shfl_xor(ss, 2); ss += __shfl_xor(ss, 4);
                                const float rn = rsqrtf(ss * (1.0f / 64.0f) + 1e-6f);
                                v4u o; o.x = pk2(y[0] * rn, y[1] * rn); o.y = pk2(y[2] * rn, y[3] * rn); o.z = pk2(y[4] * rn, y[5] * rn); o.w = pk2(y[6] * rn, y[7] * rn);
                                *yo = o;
                            }
                            __syncthreads();
                        }
                    }
                }
                xcd_barrier(xbar);
#ifndef NO_WOUT
                { const int Mr = (l == DEPTH - 1) ? NREAL : MP; pg8::Gemm g{Yb, WL + WL_OUT, Mr, DM, DM}; pg8::StaticOrder S; S.init(Mr, DM, G, bx);
                  pg8::EpiResid E{HB, stats, 1.0f};
                  pg8::gemm_phase<pg8::EpiResid, pg8::StaticOrder, true, true>(ldsp, g, S, E); }
#endif

                xcd_barrier(xbar);
            }
#ifndef NO_GU
            { const int Mr = (l == DEPTH - 1 && s == 1) ? NREAL : MP; pg8::Gemm g{HB, WL + (s ? WL_2GU : WL_1GU), Mr, 2 * DFF, DM}; pg8::StaticOrder S; S.init(Mr, 2 * DFF, G, bx);
              pg8::EpiGateUp E{ACT, stats, DFF};
              pg8::gemm_phase<pg8::EpiGateUp, pg8::StaticOrder, true, true>(ldsp, g, S, E); }
#endif

            xcd_barrier(xbar);
#ifndef NO_DOWN
            { const int Mr = (l == DEPTH - 1 && s == 1) ? NREAL : MP; pg8::Gemm g{ACT, WL + (s ? WL_2D : WL_1D), Mr, DM, DFF}; pg8::StaticOrder S; S.init(Mr, DM, G, bx);
              pg8::EpiResid E{HB, stats, 0.5f};
              pg8::gemm_phase<pg8::EpiResid, pg8::StaticOrder, true, true>(ldsp, g, S, E); }
#endif

            xcd_barrier(xbar);
        }
    }
    {
        int lane = lane0; asm volatile("" : "+v"(lane));
        const float* fn = args.in[20]; f32x4 gnv[4];
#pragma unroll
        for (int j = 0; j < 4; ++j) gnv[j] = ((const f32x4*)fn)[lane + 64 * j];
        for (int row0 = gw; row0 < NREAL; row0 += 2 * NGW) {
            unsigned long long w[2][4];
#pragma unroll
            for (int r = 0; r < 2; ++r) { const int row = row0 + r * NGW < NREAL ? row0 + r * NGW : row0;
#pragma unroll
                for (int j = 0; j < 4; ++j) w[r][j] = ((const unsigned long long*)(HB + (size_t)row * DM))[lane + 64 * j]; }
#pragma unroll
            for (int r = 0; r < 2; ++r) { const int row = row0 + r * NGW; f32x4 v[4]; float ss = 0.f;
#pragma unroll
                for (int j = 0; j < 4; ++j) { const unsigned lo = (unsigned)w[r][j], hi = (unsigned)(w[r][j] >> 32);
                    v[j][0] = bflo(lo); v[j][1] = bfhi(lo); v[j][2] = bflo(hi); v[j][3] = bfhi(hi); ss += (v[j][0] * v[j][0] + v[j][1] * v[j][1]) + (v[j][2] * v[j][2] + v[j][3] * v[j][3]); }
                const float rs = rsqrtf(wave_sum(ss) * (1.0f / 1024.0f) + 1e-6f);
                if (row < NREAL) {
#pragma unroll
                    for (int j = 0; j < 4; ++j) ((f32x4*)(args.out + (size_t)row * DM))[lane + 64 * j] = v[j] * rs * gnv[j]; } }
        }
    }
}

extern "C" void kernel_launch(void* const* d_in, const int* in_sizes, int n_in, void* d_out, int out_size, void* d_ws, size_t ws_size, hipStream_t stream) {
    static int grid = 0;
    if (grid == 0) {
        if (n_in != 21 || out_size != NREAL * DM || ws_size < WS_END || in_sizes[8] != DEPTH * DM * NIN) {
            fprintf(stderr, "kernel_launch: unexpected shapes: n_in %d out %d ws %zu (need %zu) w_in %d\n", n_in, out_size, ws_size, (size_t)WS_END, n_in > 8 ? in_sizes[8] : -1); grid = -1; return; }
        int dev = 0, cus = 0, per_cu = 0;
        (void)hipGetDevice(&dev); (void)hipDeviceGetAttribute(&cus, hipDeviceAttributeMultiprocessorCount, dev);
        if (hipFuncSetAttribute((const void*)hymba_fwd, hipFuncAttributeMaxDynamicSharedMemorySize, LDS_BYTES) != hipSuccess) { fprintf(stderr, "kernel_launch: hipFuncSetAttribute failed\n"); grid = -1; return; }
        (void)hipOccupancyMaxActiveBlocksPerMultiprocessor(&per_cu, (const void*)hymba_fwd, NWAVES * 64, LDS_BYTES);
        if (per_cu < 1) { fprintf(stderr, "kernel_launch: occupancy query says %d blocks per CU\n", per_cu); per_cu = 1; }
        (void)hipGetLastError();
        grid = cus;
    }
    if (grid < 0) return;
    Args a{};
    for (int i = 0; i < 21; ++i) a.in[i] = (const float*)d_in[i];
    a.out = (float*)d_out; a.ws = (unsigned char*)d_ws;
    void* kargs[] = {&a};
    hipError_t e = hipLaunchCooperativeKernel((const void*)hymba_fwd, dim3(grid), dim3(NWAVES * 64), kargs, LDS_BYTES, stream);
    if (e != hipSuccess) fprintf(stderr, "cooperative launch failed: %s (grid %d)\n", hipGetErrorString(e), grid);
}
```

```cpp
#include <hip/hip_runtime.h>
#include <hip/hip_cooperative_groups.h>
#include <hip/hip_bf16.h>
#include <cstdio>
#include <cstdint>
#include <cmath>
namespace cg = cooperative_groups;
namespace pg8 {
#define PG8_LAS __attribute__((address_space(3)))
typedef unsigned short bf16_t;
typedef short bf16x8 __attribute__((ext_vector_type(8)));
typedef float f32x4 __attribute__((ext_vector_type(4)));
typedef unsigned u32x4 __attribute__((ext_vector_type(4)));
constexpr int BM = 256, BK = 64, HALF = 128, HTB = HALF * BK * 2  , STAGE_BYTES = 8 * HTB, NXCD = 8, WGM = 8;

__host__ __device__ __forceinline__ int lds_byte(int r, int c) { const int st = (r >> 4) * 2 + (c >> 5), rr = r & 15, cc = c & 31, ob = rr * 64 + cc * 2; return st * 1024 + (ob ^ (((ob >> 9) & 1) << 5)); }
__host__ __device__ __forceinline__ void stage_rc(int b, int& R, int& C) { const int st = b / 1024, sb = b % 1024, swz = sb ^ (((sb >> 9) & 1) << 5); R = (st >> 1) * 16 + swz / 64; C = (st & 1) * 32 + (swz % 64) / 2; }
__host__ __device__ __forceinline__ int perm32(int rho) { const int n = rho >> 4, i = rho & 15; return 8 * (i >> 2) + 4 * n + (i & 3); }

struct Unit { int pm, pn; };
struct Gemm { const bf16_t* A; const bf16_t* Bt; int M, N, K; };

struct StaticOrder {
    int nM, nN, nwg, G, c;
    __host__ __device__ void init(int M, int N, int G_, int c_) { nM = M / BM; nN = N / BM; nwg = nM * nN; G = G_; c = c_; }
    __host__ __device__ bool next(int i, Unit& u) const {
        const long L = (long)i * G + c; if (L >= nwg) return false;
        int wgid = (int)L; { const int q = nwg / NXCD, r = nwg % NXCD, xcd = wgid % NXCD, off = wgid / NXCD; wgid = (xcd < r ? xcd * (q + 1) : r * (q + 1) + (xcd - r) * q) + off; }
        const int nig = WGM * nN, gid = wgid / nig, fm = gid * WGM, gsz = (nM - fm) < WGM ? (nM - fm) : WGM;
        u.pm = fm + ((wgid % nig) % gsz); u.pn = (wgid % nig) / gsz; return true;
    }
    __device__ __forceinline__ void a_ready(const Unit&) const {}
    __device__ __forceinline__ void done(const Unit&) const {}
};

__device__ __forceinline__ unsigned cvt_pk_bf16(float lo, float hi) { unsigned r; asm volatile("v_cvt_pk_bf16_f32 %0, %1, %2" : "=v"(r) : "v"(lo), "v"(hi)); return r; }
constexpr float RMS_EPS = 1e-6f;
__device__ __forceinline__ float row_rstd(const float* stats, int row, int fq) {
    const f32x4 a = *(const f32x4*)(stats + (size_t)row * 16 + 4 * fq);
    float t = (a[0] + a[1]) + (a[2] + a[3]);
    t += __shfl_xor(t, 16); t += __shfl_xor(t, 32);
    return rsqrtf(t * (1.0f / 1024.0f) + RMS_EPS);
}
#define EPI_RS8(rsv) float rsv[8]; _Pragma("unroll") for (int ai_ = 0; ai_ < 2; ++ai_) _Pragma("unroll") for (int m_ = 0; m_ < 4; ++m_) rsv[ai_ * 4 + m_] = row_rstd(stats, row0 + ai_ * HALF + m_ * 16, fq); asm volatile("" ::: "memory")
#define EPI_FENCE() asm volatile("" ::: "memory")
__device__ __forceinline__ float silu_f(float x) { return x * __builtin_amdgcn_rcpf(1.0f + __builtin_amdgcn_exp2f(-1.4426950408889634f * x)); }
__device__ __forceinline__ u32x4 pack8(const f32x4 a, const f32x4 b) { u32x4 w; w.x = cvt_pk_bf16(a[0], a[1]); w.y = cvt_pk_bf16(a[2], a[3]); w.z = cvt_pk_bf16(b[0], b[1]); w.w = cvt_pk_bf16(b[2], b[3]); return w; }

struct EpiGateUp {
    static constexpr bool PERM = true, AFTER_DRAIN = false;
    bf16_t* O; const float* stats; int ldo;
    __device__ __forceinline__ void operator()(const f32x4 (&acc)[2][2][4][2], const Unit& u, int wr, int wc, int fr_in, int fq_in) const {
        int fr = fr_in, fq = fq_in; asm volatile("" : "+v"(fr), "+v"(fq));
        const int row0 = u.pm * BM + wr * 64 + fr, col0 = u.pn * 128 + wc * 32 + 8 * fq;
        EPI_RS8(rsv);
#pragma unroll
        for (int ai = 0; ai < 2; ++ai)
#pragma unroll
            for (int m = 0; m < 4; ++m) { const int row = row0 + ai * HALF + m * 16; const float rs = rsv[ai * 4 + m], c1 = -1.4426950408889634f * rs, rs2 = rs * rs;
                float t[8], gu[8];
#pragma unroll
                for (int e = 0; e < 8; ++e) { const float g = acc[ai][0][m][e >> 2][e & 3]; t[e] = __builtin_amdgcn_exp2f(g * c1); gu[e] = g * acc[ai][1][m][e >> 2][e & 3]; }
#pragma unroll
                for (int e = 0; e < 8; ++e) t[e] = __builtin_amdgcn_rcpf(1.0f + t[e]);
                f32x4 o0, o1;
#pragma unroll
                for (int e = 0; e < 4; ++e) { o0[e] = gu[e] * (t[e] * rs2); o1[e] = gu[4 + e] * (t[4 + e] * rs2); }
                *(u32x4*)(O + (size_t)row * ldo + col0) = pack8(o0, o1); EPI_FENCE(); }
    }
};
struct EpiResid {
    static constexpr bool PERM = true, AFTER_DRAIN = false;
    bf16_t* HB; float* stats; float scale;
    __device__ __forceinline__ void operator()(const f32x4 (&acc)[2][2][4][2], const Unit& u, int wr, int wc, int fr_in, int fq_in) const {
        int fr = fr_in, fq = fq_in; asm volatile("" : "+v"(fr), "+v"(fq));
        const int row0 = u.pm * BM + wr * 64 + fr, col0 = u.pn * BM + wc * 32 + 8 * fq;
#pragma unroll
        for (int ai = 0; ai < 2; ++ai)
#pragma unroll
            for (int m = 0; m < 4; ++m) { const int row = row0 + ai * HALF + m * 16; float ss = 0.f;
#pragma unroll
                for (int bj = 0; bj < 2; ++bj) { u32x4* hp = (u32x4*)(HB + (size_t)row * 1024 + col0 + bj * HALF);
                    const u32x4 w = *hp; f32x4 h0, h1;
                    h0[0] = __uint_as_float(w.x << 16); h0[1] = __uint_as_float(w.x & 0xffff0000u); h0[2] = __uint_as_float(w.y << 16); h0[3] = __uint_as_float(w.y & 0xffff0000u);
                    h1[0] = __uint_as_float(w.z << 16); h1[1] = __uint_as_float(w.z & 0xffff0000u); h1[2] = __uint_as_float(w.w << 16); h1[3] = __uint_as_float(w.w & 0xffff0000u);
                    h0 = h0 + acc[ai][bj][m][0] * scale; h1 = h1 + acc[ai][bj][m][1] * scale;
                    *hp = pack8(h0, h1);
                    ss += ((h0[0] * h0[0] + h0[1] * h0[1]) + (h0[2] * h0[2] + h0[3] * h0[3])) + ((h1[0] * h1[0] + h1[1] * h1[1]) + (h1[2] * h1[2] + h1[3] * h1[3])); }
                ss += __shfl_xor(ss, 16); ss += __shfl_xor(ss, 32);
                if (fq == 0) stats[(size_t)row * 16 + u.pn * 4 + wc] = ss; EPI_FENCE(); }
    }
};
__device__ __forceinline__ int kv_row(int row) {
    if (row < 16384) return row + 64 * (row >> 12);
    if (row < 81920) return row + 64 * (4 + ((row - 16384) >> 13));
    const int q = (row - 81920) >> 6, i = (row - 81920) & 63;
    return (q < 4 ? 4096 * q + 4096 : 16384 + 8192 * (q - 4) + 8192) + 64 * q + i;
}
struct EpiWin {
    static constexpr bool PERM = true, AFTER_DRAIN = false;
    bf16_t *Q, *K, *V, *CB, *U; const float* stats; const float* qg; const float* kg; const float* rope;
    __device__ __forceinline__ void operator()(const f32x4 (&acc)[2][2][4][2], const Unit& u, int wr, int wc, int fr_in, int fq_in) const {
        int fr = fr_in, fq = fq_in; asm volatile("" : "+v"(fr), "+v"(fq));
        const int row0 = u.pm * BM + wr * 64 + fr, pn = u.pn;
        if (pn >= 5) {
            const int col0 = (pn - 5) * 128 + wc * 32 + 8 * fq;
#pragma unroll
            for (int ai = 0; ai < 2; ++ai)
#pragma unroll
                for (int m = 0; m < 4; ++m) { const int row = row0 + ai * HALF + m * 16; const float rs = row_rstd(stats, row, fq), rs2 = rs * rs;
                    const f32x4 o0 = acc[ai][0][m][0] * acc[ai][1][m][0] * rs2, o1 = acc[ai][0][m][1] * acc[ai][1][m][1] * rs2;
                    *(u32x4*)(U + (size_t)row * 512 + col0) = pack8(o0, o1); EPI_FENCE(); }
            return;
        }
        const int hd = 4 * pn + wc;
        const bool is_q = hd < 8, is_k = (hd >= 8 && hd < 10);
        bf16_t* dst; int ldd, cb;
        if (is_q) { dst = Q; ldd = 512; cb = hd * 64; } else if (is_k) { dst = K; ldd = 128; cb = (hd - 8) * 64; }
        else if (hd < 12) { dst = V; ldd = 128; cb = (hd - 10) * 64; } else { dst = CB; ldd = 512; cb = (hd - 12) * 64; }
        cb += 8 * fq;
        if (is_q || is_k) {
            const float* gp = (is_q ? qg : kg) + 8 * fq;
            const float osc = is_q ? (0.125f * 1.4426950408889634f) : 1.0f;
#pragma unroll
            for (int ai = 0; ai < 2; ++ai)
#pragma unroll
                for (int m = 0; m < 4; ++m) { const int row = row0 + ai * HALF + m * 16; const float rs = row_rstd(stats, row, fq);
                    f32x4 v00 = acc[ai][0][m][0] * rs, v01 = acc[ai][0][m][1] * rs, v10 = acc[ai][1][m][0] * rs, v11 = acc[ai][1][m][1] * rs;
                    float ss = ((v00[0] * v00[0] + v00[1] * v00[1]) + (v00[2] * v00[2] + v00[3] * v00[3])) + ((v01[0] * v01[0] + v01[1] * v01[1]) + (v01[2] * v01[2] + v01[3] * v01[3]))
                             + ((v10[0] * v10[0] + v10[1] * v10[1]) + (v10[2] * v10[2] + v10[3] * v10[3])) + ((v11[0] * v11[0] + v11[1] * v11[1]) + (v11[2] * v11[2] + v11[3] * v11[3]));
                    ss += __shfl_xor(ss, 16); ss += __shfl_xor(ss, 32);
                    const float rn = rsqrtf(ss * (1.0f / 64.0f) + RMS_EPS);
                    v00 = v00 * *(const f32x4*)gp * rn; v01 = v01 * *(const f32x4*)(gp + 4) * rn; v10 = v10 * *(const f32x4*)(gp + 32) * rn; v11 = v11 * *(const f32x4*)(gp + 36) * rn;
                    int rp = 0, cp = 0;
                    if (row < 81920) { const int nn = row & (row < 16384 ? 4095 : 8191); rp = nn >> 6; cp = nn & 63; }
                    const float* tr = rope + (size_t)rp * 32 + 8 * fq; const float* tc = rope + (size_t)cp * 32 + 8 * fq;
                    const f32x4 r0 = *(const f32x4*)tr, r1 = *(const f32x4*)(tr + 4), c0 = *(const f32x4*)tc, c1 = *(const f32x4*)(tc + 4);
                    f32x4 o00, o01, o10, o11;
                    o00[0] = v00[0] * r0[0] - v00[1] * r0[1]; o00[1] = v00[0] * r0[1] + v00[1] * r0[0]; o00[2] = v00[2] * r0[2] - v00[3] * r0[3]; o00[3] = v00[2] * r0[3] + v00[3] * r0[2];
                    o01[0] = v01[0] * r1[0] - v01[1] * r1[1]; o01[1] = v01[0] * r1[1] + v01[1] * r1[0]; o01[2] = v01[2] * r1[2] - v01[3] * r1[3]; o01[3] = v01[2] * r1[3] + v01[3] * r1[2];
                    o10[0] = v10[0] * c0[0] - v10[1] * c0[1]; o10[1] = v10[0] * c0[1] + v10[1] * c0[0]; o10[2] = v10[2] * c0[2] - v10[3] * c0[3]; o10[3] = v10[2] * c0[3] + v10[3] * c0[2];
                    o11[0] = v11[0] * c1[0] - v11[1] * c1[1]; o11[1] = v11[0] * c1[1] + v11[1] * c1[0]; o11[2] = v11[2] * c1[2] - v11[3] * c1[3]; o11[3] = v11[2] * c1[3] + v11[3] * c1[2];
                    bf16_t* dp = dst + (size_t)(is_k ? kv_row(row) : row) * ldd + cb;
                    *(u32x4*)dp = pack8(o00 * osc, o01 * osc); *(u32x4*)(dp + 32) = pack8(o10 * osc, o11 * osc); EPI_FENCE(); }
        } else {
#pragma unroll
            for (int ai = 0; ai < 2; ++ai)
#pragma unroll
                for (int m = 0; m < 4; ++m) { const int row = row0 + ai * HALF + m * 16; const float rs = row_rstd(stats, row, fq);
                    bf16_t* dp = dst + (size_t)(hd < 12 ? kv_row(row) : row) * ldd + cb;
                    *(u32x4*)dp = pack8(acc[ai][0][m][0] * rs, acc[ai][0][m][1] * rs); *(u32x4*)(dp + 32) = pack8(acc[ai][1][m][0] * rs, acc[ai][1][m][1] * rs); EPI_FENCE(); }
        }
    }
};

template <class Epi, class Sched, bool ALIGN_EPI = false, bool SP2 = false>
__device__ __forceinline__ void gemm_phase(PG8_LAS unsigned char* lds, const Gemm g, const Sched& S, const Epi& E) {
    int tid_ = threadIdx.x; asm volatile("" : "+v"(tid_));
    const int tid = tid_, wid = __builtin_amdgcn_readfirstlane(tid >> 6), lane = tid & 63, wr = wid >> 2, wc = wid & 3, fr = lane & 15, fq = lane >> 4;
    const int K = g.K, nt = K / BK;
    unsigned voffA[2], voffB[2];
#pragma unroll
    for (int i = 0; i < 2; ++i) { int R, C; stage_rc(tid * 16 + i * 8192, R, C); const int Rb = Epi::PERM ? ((R & ~31) + perm32(R & 31)) : R;
        voffA[i] = (unsigned)(R * K + C) * 2u; voffB[i] = (unsigned)(Rb * K + C) * 2u; }
    const size_t kstep = (size_t)(BK * 2);
    const size_t hstep = (size_t)HALF * K * 2;
    const size_t tstep = 2 * hstep;
    const unsigned ldsw = (unsigned)wid * 1024u;
    const int aoff = lds_byte(wr * 64 + fr, fq * 8), boff = lds_byte(wc * 32 + fr, fq * 8);
#define PG8_SA(b, h) (((b) * 2 + (h)) * HTB)
#define PG8_SB(b, h) ((4 + (b) * 2 + (h)) * HTB)
#define PG8_STAGE(bufoff, gbase, voff) do { _Pragma("unroll") for (int _i = 0; _i < 2; ++_i) \
        __builtin_amdgcn_global_load_lds((const unsigned*)((const char*)(gbase) + (voff)[_i]), (PG8_LAS unsigned*)(lds + (bufoff) + ldsw + _i * 8192), 16, 0, 0); } while (0)
#define PG8_LDA(dst, b, h) do { _Pragma("unroll") for (int m = 0; m < 4; ++m) _Pragma("unroll") for (int k = 0; k < 2; ++k) dst[m][k] = *(const PG8_LAS bf16x8*)(lds + PG8_SA(b, h) + aoff + m * 2048 + k * 1024); } while (0)
#define PG8_LDB(dst, b, h) do { _Pragma("unroll") for (int n = 0; n < 2; ++n) _Pragma("unroll") for (int k = 0; k < 2; ++k) dst[n][k] = *(const PG8_LAS bf16x8*)(lds + PG8_SB(b, h) + boff + n * 2048 + k * 1024); } while (0)
#define PG8_MMA(ai, bj, At, Bt) do { __builtin_amdgcn_s_setprio(1); _Pragma("unroll") for (int m = 0; m < 4; ++m) _Pragma("unroll") for (int n = 0; n < 2; ++n) _Pragma("unroll") for (int k = 0; k < 2; ++k) \
        acc[ai][bj][m][n] = __builtin_amdgcn_mfma_f32_16x16x32_bf16(Bt[n][k], At[m][k], acc[ai][bj][m][n], 0, 0, 0); __builtin_amdgcn_s_setprio(0); } while (0)
#define PG8_WAIT_V(n) asm volatile("s_waitcnt vmcnt(" #n ")" ::: "memory")
#define PG8_WAIT_L(n) asm volatile("s_waitcnt lgkmcnt(" #n ")" ::: "memory")
#define PG8_BAR __builtin_amdgcn_s_barrier()
#define PG8_SCHED __builtin_amdgcn_sched_barrier(0)
    Unit cur, nxt; int ui = 0;
    if (!S.next(0, cur)) return;
    f32x4 acc[2][2][4][2];
#pragma unroll
    for (int a = 0; a < 2; ++a)
#pragma unroll
        for (int b = 0; b < 2; ++b)
#pragma unroll
            for (int m = 0; m < 4; ++m)
#pragma unroll
                for (int n = 0; n < 2; ++n) acc[a][b][m][n] = (f32x4){0.f, 0.f, 0.f, 0.f};
    bf16x8 At[4][2], B0[2][2], B1[2][2];
    const char* cA = (const char*)g.A + (size_t)cur.pm * tstep; const char* cB = (const char*)g.Bt + (size_t)cur.pn * tstep;
    S.a_ready(cur);
    if constexpr (SP2) {
        PG8_STAGE(PG8_SB(0, 0), cB, voffB); PG8_STAGE(PG8_SB(0, 1), cB + hstep, voffB); PG8_STAGE(PG8_SA(0, 0), cA, voffA); PG8_STAGE(PG8_SA(0, 1), cA + hstep, voffA);
        if (wr == 1) PG8_BAR;
        PG8_WAIT_V(2); PG8_BAR;
        PG8_STAGE(PG8_SB(1, 0), cB + kstep, voffB); PG8_STAGE(PG8_SA(1, 0), cA + kstep, voffA); PG8_STAGE(PG8_SB(1, 1), cB + hstep + kstep, voffB);
        PG8_WAIT_V(6); PG8_BAR;
    } else {
        PG8_STAGE(PG8_SB(0, 0), cB, voffB); PG8_STAGE(PG8_SA(0, 0), cA, voffA); PG8_STAGE(PG8_SB(0, 1), cB + hstep, voffB); PG8_STAGE(PG8_SA(0, 1), cA + hstep, voffA);
        if (wr == 1) PG8_BAR;
        PG8_WAIT_V(4); PG8_BAR;
        PG8_STAGE(PG8_SB(1, 0), cB + kstep, voffB); PG8_STAGE(PG8_SA(1, 0), cA + kstep, voffA); PG8_STAGE(PG8_SB(1, 1), cB + hstep + kstep, voffB);
        PG8_WAIT_V(6); PG8_BAR;
    }
    for (;;) {
        const bool has_next = S.next(ui + 1, nxt);
        const char* nA = has_next ? (const char*)g.A + (size_t)nxt.pm * tstep : cA; const char* nB = has_next ? (const char*)g.Bt + (size_t)nxt.pn * tstep : cB;
        for (int t = 0; t < nt; t += 2) {
            const bool last = (t == nt - 2);
            const char* a1 = cA + (size_t)(t + 1) * kstep;
            const char* a2 = last ? nA : cA + (size_t)(t + 2) * kstep; const char* b2 = last ? nB : cB + (size_t)(t + 2) * kstep;
            const char* a3 = a2 + kstep; const char* b3 = b2 + kstep;
            if (last && has_next) S.a_ready(nxt);
            if constexpr (SP2) {
            PG8_LDB(B0, 0, 0); PG8_LDB(B1, 0, 1); PG8_SCHED; PG8_LDA(At, 0, 0); PG8_STAGE(PG8_SA(1, 1), a1 + hstep, voffA);
            PG8_WAIT_V(8); PG8_WAIT_L(0); PG8_BAR; PG8_MMA(0, 0, At, B0); PG8_MMA(0, 1, At, B1); PG8_BAR; PG8_SCHED;
            PG8_LDA(At, 0, 1); PG8_STAGE(PG8_SB(0, 0), b2, voffB); PG8_STAGE(PG8_SB(0, 1), b2 + hstep, voffB); PG8_STAGE(PG8_SA(0, 0), a2, voffA);
            PG8_WAIT_V(8); PG8_WAIT_L(0); PG8_BAR; PG8_MMA(1, 0, At, B0); PG8_MMA(1, 1, At, B1); PG8_BAR; PG8_SCHED;
            PG8_LDB(B0, 1, 0); PG8_LDB(B1, 1, 1); PG8_SCHED; PG8_LDA(At, 1, 0); PG8_STAGE(PG8_SA(0, 1), a2 + hstep, voffA);
            PG8_WAIT_V(8); PG8_WAIT_L(0); PG8_BAR; PG8_MMA(0, 0, At, B0); PG8_MMA(0, 1, At, B1); PG8_BAR; PG8_SCHED;
            PG8_LDA(At, 1, 1); PG8_STAGE(PG8_SB(1, 0), b3, voffB); PG8_STAGE(PG8_SB(1, 1), b3 + hstep, voffB); PG8_STAGE(PG8_SA(1, 0), a3, voffA);
            PG8_WAIT_V(8); PG8_WAIT_L(0); PG8_BAR; PG8_MMA(1, 0, At, B0); PG8_MMA(1, 1, At, B1); PG8_BAR; PG8_SCHED;
            } else {
            PG8_LDB(B0, 0, 0); PG8_SCHED; PG8_LDA(At, 0, 0); PG8_STAGE(PG8_SA(1, 1), a1 + hstep, voffA);
            PG8_WAIT_L(8); PG8_BAR; PG8_WAIT_L(0); PG8_MMA(0, 0, At, B0); PG8_BAR; PG8_SCHED;
            PG8_LDB(B1, 0, 1); PG8_STAGE(PG8_SB(0, 0), b2, voffB);
            PG8_BAR; PG8_WAIT_L(0); PG8_MMA(0, 1, At, B1); PG8_BAR;
            PG8_LDA(At, 0, 1); PG8_STAGE(PG8_SA(0, 0), a2, voffA);
            PG8_BAR; PG8_WAIT_L(0); PG8_MMA(1, 0, At, B0); PG8_BAR; PG8_SCHED;
            PG8_STAGE(PG8_SB(0, 1), b2 + hstep, voffB);
            PG8_WAIT_V(6); PG8_BAR; PG8_MMA(1, 1, At, B1); PG8_BAR;
            PG8_LDB(B0, 1, 0); PG8_SCHED; PG8_LDA(At, 1, 0); PG8_STAGE(PG8_SA(0, 1), a2 + hstep, voffA);
            PG8_WAIT_L(8); PG8_BAR; PG8_WAIT_L(0); PG8_MMA(0, 0, At, B0); PG8_BAR; PG8_SCHED;
            PG8_LDB(B1, 1, 1); PG8_STAGE(PG8_SB(1, 0), b3, voffB);
            PG8_BAR; PG8_WAIT_L(0); PG8_MMA(0, 1, At, B1); PG8_BAR;
            PG8_LDA(At, 1, 1); PG8_STAGE(PG8_SA(1, 0), a3, voffA);
            PG8_BAR; PG8_WAIT_L(0); PG8_MMA(1, 0, At, B0); PG8_BAR; PG8_SCHED;
            PG8_STAGE(PG8_SB(1, 1), b3 + hstep, voffB);
            PG8_WAIT_V(6); PG8_BAR; PG8_MMA(1, 1, At, B1); PG8_BAR;
            }
        }
        if constexpr (ALIGN_EPI) { if (wr == 0) PG8_BAR; }
        if constexpr (!Epi::AFTER_DRAIN) { E(acc, cur, wr, wc, fr, fq); S.done(cur); }
        if (!has_next) break;
#pragma unroll
        for (int a = 0; a < 2; ++a)
#pragma unroll
            for (int b = 0; b < 2; ++b)
#pragma unroll
                for (int m = 0; m < 4; ++m)
#pragma unroll
                    for (int n = 0; n < 2; ++n) acc[a][b][m][n] = (f32x4){0.f, 0.f, 0.f, 0.f};
        cur = nxt; cA = nA; cB = nB; ++ui;
        if constexpr (ALIGN_EPI) { if (wr == 1) PG8_BAR; }
    }
    PG8_WAIT_V(0);
    if constexpr (!ALIGN_EPI) { if (wr == 0) PG8_BAR; }
    PG8_BAR;
    if constexpr (Epi::AFTER_DRAIN) { E.fused(acc, cur, wr, wc, fr, fq, lds, wid, lane); S.done(cur); }
#undef PG8_SA
#undef PG8_SB
#undef PG8_STAGE
#undef PG8_LDA
#undef PG8_LDB
#undef PG8_MMA
#undef PG8_WAIT_V
#undef PG8_WAIT_L
#undef PG8_BAR
#undef PG8_SCHED
}
}

namespace attn_body {
using bf16=__hip_bfloat16;
using bf16x8=__attribute__((ext_vector_type(8)))short;
using s16x4=__attribute__((ext_vector_type(4)))short;
using f32x16=__attribute__((ext_vector_type(16)))float;
using u32x4=__attribute__((ext_vector_type(4)))unsigned;
constexpr int D=64,QP=512,KP=128,OP=1024;
typedef float f32x4 __attribute__((ext_vector_type(4)));
constexpr int NW=8,QBLK=32,QB=QBLK*NW,KVBLK=64;
__device__ __forceinline__ int crow(int r,int hi){return (r&3)+8*(r>>2)+4*hi;}
#define SBAR() __builtin_amdgcn_sched_barrier(0)
#define ATTN_STORE16(p,v) (*(u32x4*)(p)=(v))
__device__ __forceinline__ void mmask(f32x16&p0,f32x16&p1,bool any,bool all){
  const float NEG=-INFINITY;
  #pragma unroll
  for(int r=0;r<16;++r){p1[r]=any?NEG:p1[r]; p0[r]=((r>=8)?any:all)?NEG:p0[r];}
}
constexpr int NSLOT=3, SLOTB=8192;
constexpr int LDS_K=0, LDS_V=NSLOT*SLOTB, LDS_WS=2*NSLOT*SLOTB, LDS_OST=LDS_WS+NW*64*4, LDS_BYTES=LDS_OST+NW*4096;
constexpr float C2=0.125f*1.4426950408889634f;
__device__ __forceinline__ void glds16(const void*gsrc,unsigned lds_dst){unsigned keep;
  asm volatile("s_mov_b32 %0, m0\n\ts_mov_b32 m0, %2\n\ts_nop 0\n\tglobal_load_lds_dwordx4 %1, off\n\ts_mov_b32 m0, %0":"=&s"(keep):"v"(gsrc),"s"(lds_dst):"memory");}
__device__ __forceinline__ float max3f(float a,float b,float c){float r;asm("v_max3_f32 %0, %1, %2, %3":"=v"(r):"v"(a),"v"(b),"v"(c));return r;}
__device__ __forceinline__ float max2f(float a,float b){float r;asm("v_max_f32_e32 %0, %1, %2":"=v"(r):"v"(a),"v"(b));return r;}
__device__ __forceinline__ float fadd_s(float a,float b){float r;asm("v_add_f32_e32 %0, %1, %2":"=v"(r):"v"(a),"v"(b));return r;}
__device__ __forceinline__ float fsub_s(float a,float b){float r;asm("v_sub_f32_e32 %0, %1, %2":"=v"(r):"v"(a),"v"(b));return r;}
typedef float f32x2_t __attribute__((ext_vector_type(2))); typedef __bf16 bf16x2_t __attribute__((ext_vector_type(2)));
__device__ __forceinline__ unsigned cvtpk_s(float lo,float hi){f32x2_t v={lo,hi};bf16x2_t b=__builtin_convertvector(v,bf16x2_t);return __builtin_bit_cast(unsigned,b);}
#define WAIT_BAR(N) asm volatile("s_waitcnt vmcnt(" #N ") lgkmcnt(0)\n\ts_barrier":::"memory")

__device__ __forceinline__ void qkt(f32x16&p0,f32x16&p1,const char*Kslot,const bf16x8*qr,const f32x16&negm,int r32,int hi){
  const char*kb=Kslot+hi*1024+r32*16;
  #pragma unroll
  for(int d0=0;d0<4;++d0){
    const bf16x8 b0=*reinterpret_cast<const bf16x8*>(kb+d0*2048);
    const bf16x8 b1=*reinterpret_cast<const bf16x8*>(kb+d0*2048+512);
    if(d0==0){p0=__builtin_amdgcn_mfma_f32_32x32x16_bf16(b0,qr[0],negm,0,0,0);p1=__builtin_amdgcn_mfma_f32_32x32x16_bf16(b1,qr[0],negm,0,0,0);}
    else{p0=__builtin_amdgcn_mfma_f32_32x32x16_bf16(b0,qr[d0],p0,0,0,0);p1=__builtin_amdgcn_mfma_f32_32x32x16_bf16(b1,qr[d0],p1,0,0,0);}}
}
typedef __attribute__((address_space(3))) const char* lds_cptr;
typedef short v4i16_t __attribute__((ext_vector_type(4)));
__device__ __forceinline__ void kload8(bf16x8*kf,lds_cptr kp){
  kf[0]=*(const __attribute__((address_space(3))) bf16x8*)(kp);      kf[1]=*(const __attribute__((address_space(3))) bf16x8*)(kp+512);
  kf[2]=*(const __attribute__((address_space(3))) bf16x8*)(kp+2048); kf[3]=*(const __attribute__((address_space(3))) bf16x8*)(kp+2560);
  kf[4]=*(const __attribute__((address_space(3))) bf16x8*)(kp+4096); kf[5]=*(const __attribute__((address_space(3))) bf16x8*)(kp+4608);
  kf[6]=*(const __attribute__((address_space(3))) bf16x8*)(kp+6144); kf[7]=*(const __attribute__((address_space(3))) bf16x8*)(kp+6656);
}
__device__ __forceinline__ void kload2(bf16x8*kf,lds_cptr kp,int j){ kf[2*j]=*(const __attribute__((address_space(3))) bf16x8*)(kp+j*2048); kf[2*j+1]=*(const __attribute__((address_space(3))) bf16x8*)(kp+j*2048+512); }
__device__ __forceinline__ s16x4 vtr(lds_cptr p){ return __builtin_bit_cast(s16x4,__builtin_amdgcn_ds_read_tr16_b64_v4i16((__attribute__((address_space(3))) v4i16_t*)p)); }
__device__ __forceinline__ float rowmax(const f32x16&p0,const f32x16&p1){
  float a=max3f(p0[0],p0[1],p1[0]),b=max3f(p0[2],p0[3],p1[1]);a=max3f(a,p1[2],p1[3]);
  #pragma unroll
  for(int r=4;r<16;r+=4){a=max3f(a,p0[r],p0[r+1]);b=max3f(b,p0[r+2],p0[r+3]);a=max3f(a,p1[r],p1[r+1]);b=max3f(b,p1[r+2],p1[r+3]);}
  const float m=max2f(a,b);
  auto rr=__builtin_amdgcn_permlane32_swap(__float_as_uint(m),__float_as_uint(m),false,false);
  return max2f(__uint_as_float(rr[0]),__uint_as_float(rr[1]));
}
__device__ __forceinline__ void pv(f32x16*o,int vb,bf16x8 pa0,bf16x8 pa1,bf16x8 pa2,bf16x8 pa3){
  #pragma unroll
  for(int d0=0;d0<2;++d0){s16x4 lo[4],hi[4];
    #pragma unroll
    for(int ks=0;ks<4;++ks){
      asm volatile("ds_read_b64_tr_b16 %0,%1 offset:%c2":"=&v"(lo[ks]):"v"(vb),"i"(d0*4096+ks*1024):"memory");
      asm volatile("ds_read_b64_tr_b16 %0,%1 offset:%c2":"=&v"(hi[ks]):"v"(vb),"i"(d0*4096+ks*1024+512):"memory");}
    asm volatile("s_waitcnt lgkmcnt(0)":::"memory");SBAR();
    #define PK(k) (bf16x8){lo[k][0],lo[k][1],lo[k][2],lo[k][3],hi[k][0],hi[k][1],hi[k][2],hi[k][3]}
    o[d0]=__builtin_amdgcn_mfma_f32_32x32x16_bf16(pa0,PK(0),o[d0],0,0,0);
    o[d0]=__builtin_amdgcn_mfma_f32_32x32x16_bf16(pa1,PK(1),o[d0],0,0,0);
    o[d0]=__builtin_amdgcn_mfma_f32_32x32x16_bf16(pa2,PK(2),o[d0],0,0,0);
    o[d0]=__builtin_amdgcn_mfma_f32_32x32x16_bf16(pa3,PK(3),o[d0],0,0,0);
    #undef PK
  }
}

template<int THRL> __device__ __forceinline__ void attn_unit(long qrow0,int is_meta,long kvbase,int NR,long metarow,int h,const bf16*Q,const bf16*__restrict__ K,const bf16*__restrict__ V,bf16*O,char*shm){
  int tid_=threadIdx.x; asm volatile("":"+v"(tid_)); const int tid=tid_,lane=tid&63,r32=lane&31,hi=lane>>5; const int wid=__builtin_amdgcn_readfirstlane(tid>>6);
  const long qrow_l=is_meta?(metarow+(long)(r32&15)):(qrow0+wid*QBLK+r32);
  const int h_l=is_meta?(h+2*(wid&1)+(r32>>4)):h;
  const bf16*Qw=Q+qrow_l*QP+h_l*D;
  const bf16*Kh=K+(h>>2)*D,*Vh=V+(h>>2)*D;
  const unsigned lds0=(unsigned)(uintptr_t)shm;
  float*wsf=(float*)(shm+LDS_WS)+wid*64;
  const bf16*ksrc=Kh+(long)lane*KP+wid*8;
  const bf16*vsrc=Vh+(long)(16*(wid&3)+(lane>>2))*KP+(wid>>2)*32+(lane&3)*8;
  #define TROW(t) (kvbase+(long)(t)*KVBLK)
  const unsigned kdst=lds0+LDS_K+wid*1024, vdst=lds0+LDS_V+wid*1024;
  #define DMA_K(t,slot) glds16(ksrc+TROW(t)*KP,(unsigned)__builtin_amdgcn_readfirstlane(kdst+(slot)))
  #define DMA_V(t,slot) glds16(vsrc+TROW(t)*KP,(unsigned)__builtin_amdgcn_readfirstlane(vdst+(slot)))
  const int vb0=(int)(lds0+LDS_V)+((lane>>4)&1)*32+(lane&3)*8+(4*hi+((lane&15)>>2))*64;
  const char*Kbase=shm+LDS_K; bf16x8 kf[8];
  const lds_cptr shm3=(lds_cptr)shm; const lds_cptr kp0=shm3+LDS_K+hi*1024+r32*16; const lds_cptr vp0=shm3+LDS_V+((lane>>4)&1)*32+(lane&3)*8+(4*hi+((lane&15)>>2))*64;
  const int NT=NR+2;
  DMA_K(0,0);DMA_V(0,0);DMA_K(1,SLOTB);
  bf16x8 qr[4];
  #pragma unroll
  for(int d0=0;d0<4;++d0)qr[d0]=*reinterpret_cast<const bf16x8*>(&Qw[d0*16+hi*8]);
  float mhat=0.f,l_reg=0.f;f32x16 o[2];o[0]=f32x16{};o[1]=f32x16{};f32x16 negm=f32x16{};asm volatile("":"+v"(negm));
  #define CMASK(P0,P1,t) do{ mmask(P0,P1,(t)>=NT-2,(t)==NT-1); }while(0)
  bool resc=false;
  #define START(P0,P1) do{ const float rm=rowmax(P0,P1); resc=false; \
    { const float dl=rm; mhat=fadd_s(mhat,dl); \
      _Pragma("unroll") for(int r=0;r<16;++r){P0[r]=fsub_s(P0[r],dl);P1[r]=fsub_s(P1[r],dl);} \
      _Pragma("unroll") for(int r=0;r<16;++r)negm[r]=-mhat; asm volatile("":"+v"(negm)); } \
    _Pragma("unroll") for(int r=0;r<16;++r)P0[r]=__builtin_amdgcn_exp2f(P0[r]); }while(0)
  #define RESC() do{ if(resc){ asm volatile("s_waitcnt lgkmcnt(0)":::"memory"); \
      _Pragma("unroll") for(int d_=0;d_<2;++d_) _Pragma("unroll") for(int r=0;r<16;++r)o[d_][r]*=wsf[crow(r,hi)]; } }while(0)
  f32x16 pA0,pA1,pB0,pB1;
  int sl_prev=0,sl_cur=0,sl_next=SLOTB;
  #define ROT() do{sl_prev=sl_cur;sl_cur=sl_next;sl_next=(sl_next==(NSLOT-1)*SLOTB)?0:sl_next+SLOTB;}while(0)
  DMA_K(2,2*SLOTB);
  WAIT_BAR(3);
  qkt(pA0,pA1,Kbase,qr,negm,r32,hi);asm volatile("s_nop 15\n\ts_nop 7":"+v"(pA0),"+v"(pA1));
  START(pA0,pA1);
  _Pragma("unroll") for(int r=0;r<16;++r)pA1[r]=__builtin_amdgcn_exp2f(pA1[r]);
  WAIT_BAR(0);
  DMA_K(3,0);DMA_V(1,SLOTB);
  ROT();
  kload8(kf,kp0+sl_cur);
  WAIT_BAR(2);
  s16x4 vlo[8],vhi[8]; u32x4 pw0,pw1,pw2,pw3;
  #define PKW(P,B) cvtpk_s(P[B],P[B+1])
  #define PAF(k) __builtin_bit_cast(bf16x8,pw##k)
  #define VFR(i) (bf16x8){vlo[i][0],vlo[i][1],vlo[i][2],vlo[i][3],vhi[i][0],vhi[i][1],vhi[i][2],vhi[i][3]}
  #define PIN(x) asm volatile("":"+v"(x))
  #define MX3(a,b,c) __builtin_fmaxf(__builtin_fmaxf((a),(b)),(c))
  #define GAPA(MF,A0,A1,A2,A3,W0,W1,PW) do{ MF; sacc+=A0; sacc+=A1; sacc+=A2; sacc+=A3; PIN(sacc); W0; W1; PIN(PW); SBAR(); }while(0)
  #define EX(v) __builtin_amdgcn_exp2f(v)
  #define GAPB(MF,X,B) do{ MF; X[B]=EX(X[B]); X[B+1]=EX(X[B+1]); X[B+2]=EX(X[B+2]); X[B+3]=EX(X[B+3]); PIN(X); SBAR(); }while(0)
  #define VRD(i) do{ vlo[i]=vtr(vp_+(((i)>>2)*4096+((i)&3)*1024)); vhi[i]=vtr(vp_+(((i)>>2)*4096+((i)&3)*1024+512)); }while(0)
  #define KRD(G,j) do{ if(G){ kload2(kf,kp0+sl_next,j); SBAR(); } }while(0)
  #define STEP(C0,C1,P0,P1,t,GK,GV,GL) do{ SBAR(); \
    const lds_cptr vp_=vp0+sl_prev; \
    VRD(0); SBAR(); float sacc=(P0[0]+P0[1]); \
    GAPA(C0=__builtin_amdgcn_mfma_f32_32x32x16_bf16(kf[0],qr[0],negm,0,0,0), P0[2],P0[3],P0[4],P0[5],     pw0[0]=PKW(P0,0), pw0[1]=PKW(P0,2), pw0); \
    VRD(4); SBAR(); GAPA(C1=__builtin_amdgcn_mfma_f32_32x32x16_bf16(kf[1],qr[0],negm,0,0,0), P0[6],P0[7],P0[8],P0[9],     pw0[2]=PKW(P0,4), pw0[3]=PKW(P0,6), pw0); \
    VRD(1); SBAR(); GAPA(C0=__builtin_amdgcn_mfma_f32_32x32x16_bf16(kf[2],qr[1],C0,0,0,0),   P0[10],P0[11],P0[12],P0[13], pw1[0]=PKW(P0,8), pw1[1]=PKW(P0,10), pw1); \
    VRD(5); SBAR(); GAPA(C1=__builtin_amdgcn_mfma_f32_32x32x16_bf16(kf[3],qr[1],C1,0,0,0),   P0[14],P0[15],P1[0],P1[1],   pw1[2]=PKW(P0,12),pw1[3]=PKW(P0,14), pw1); \
    VRD(2); SBAR(); GAPA(C0=__builtin_amdgcn_mfma_f32_32x32x16_bf16(kf[4],qr[2],C0,0,0,0),   P1[2],P1[3],P1[4],P1[5],     pw2[0]=PKW(P1,0), pw2[1]=PKW(P1,2), pw2); \
    VRD(6); SBAR(); GAPA(C1=__builtin_amdgcn_mfma_f32_32x32x16_bf16(kf[5],qr[2],C1,0,0,0),   P1[6],P1[7],P1[8],P1[9],     pw2[2]=PKW(P1,4), pw2[3]=PKW(P1,6), pw2); \
    VRD(3); SBAR(); GAPA(C0=__builtin_amdgcn_mfma_f32_32x32x16_bf16(kf[6],qr[3],C0,0,0,0),   P1[10],P1[11],P1[12],P1[13], pw3[0]=PKW(P1,8), pw3[1]=PKW(P1,10), pw3); \
    VRD(7); SBAR(); GAPA(C1=__builtin_amdgcn_mfma_f32_32x32x16_bf16(kf[7],qr[3],C1,0,0,0),   P1[14],P1[15],0.f,0.f,       pw3[2]=PKW(P1,12),pw3[3]=PKW(P1,14), pw3); \
    l_reg+=sacc; \
    if(GK){DMA_K((t)+3,sl_cur);} if(GV){DMA_V((t)+1,sl_next);} \
    CMASK(C0,C1,t); \
    { float a=MX3(C0[0],C0[1],C1[0]),b=MX3(C0[2],C0[3],C1[1]); a=MX3(a,C1[2],C1[3]); \
      _Pragma("unroll") for(int r=4;r<16;r+=4){a=MX3(a,C0[r],C0[r+1]);b=MX3(b,C0[r+2],C0[r+3]);a=MX3(a,C1[r],C1[r+1]);b=MX3(b,C1[r+2],C1[r+3]);} \
      float rm=__builtin_fmaxf(a,b); { auto rr=__builtin_amdgcn_permlane32_swap(__float_as_uint(rm),__float_as_uint(rm),false,false); rm=__builtin_fmaxf(__uint_as_float(rr[0]),__uint_as_float(rr[1])); } \
      resc=false; \
      if(__builtin_expect(__any(rm>(float)THRL),0)){ const float dl=__builtin_fmaxf(rm,0.f); mhat+=dl; \
        _Pragma("unroll") for(int r=0;r<16;++r){C0[r]-=dl;C1[r]-=dl;} \
        _Pragma("unroll") for(int r=0;r<16;++r)negm[r]=-mhat; asm volatile("":"+v"(negm)); \
        const float f=__builtin_amdgcn_exp2f(-dl); l_reg*=f; if(hi==0)wsf[r32]=f; resc=true; } } \
    SBAR(); \
    GAPB(o[0]=__builtin_amdgcn_mfma_f32_32x32x16_bf16(PAF(0),VFR(0),o[0],0,0,0), C0,0); \
    GAPB(o[1]=__builtin_amdgcn_mfma_f32_32x32x16_bf16(PAF(0),VFR(4),o[1],0,0,0), C0,4); \
    KRD(GL,0); GAPB(o[0]=__builtin_amdgcn_mfma_f32_32x32x16_bf16(PAF(1),VFR(1),o[0],0,0,0), C0,8); \
    KRD(GL,1); GAPB(o[1]=__builtin_amdgcn_mfma_f32_32x32x16_bf16(PAF(1),VFR(5),o[1],0,0,0), C0,12); \
    KRD(GL,2); GAPB(o[0]=__builtin_amdgcn_mfma_f32_32x32x16_bf16(PAF(2),VFR(2),o[0],0,0,0), C1,0); \
    KRD(GL,3); GAPB(o[1]=__builtin_amdgcn_mfma_f32_32x32x16_bf16(PAF(2),VFR(6),o[1],0,0,0), C1,4); \
    GAPB(o[0]=__builtin_amdgcn_mfma_f32_32x32x16_bf16(PAF(3),VFR(3),o[0],0,0,0), C1,8); \
    GAPB(o[1]=__builtin_amdgcn_mfma_f32_32x32x16_bf16(PAF(3),VFR(7),o[1],0,0,0), C1,12); \
    }while(0)
  int t=1;
  #undef CMASK
  #define CMASK(P0,P1,t) do{}while(0)
  for(;t+5<NT;t+=2){
    STEP(pB0,pB1,pA0,pA1,t,true,true,true);     WAIT_BAR(2); RESC(); ROT();
    STEP(pA0,pA1,pB0,pB1,t+1,true,true,true);   WAIT_BAR(2); RESC(); ROT();
  }
  #undef CMASK
  #define CMASK(P0,P1,t) do{ mmask(P0,P1,(t)>=NT-2,(t)==NT-1); }while(0)
  #define ENDW(tt) do{ if((tt)+3<NT){WAIT_BAR(2);} else if((tt)+2<NT){WAIT_BAR(1);} else {WAIT_BAR(0);} }while(0)
  for(;t+1<NT;t+=2){
    STEP(pB0,pB1,pA0,pA1,t,(t+3<NT),(t+1<NT),(t+1<NT));       ENDW(t);   RESC(); ROT();
    STEP(pA0,pA1,pB0,pB1,t+1,(t+4<NT),(t+2<NT),(t+2<NT));     ENDW(t+1); RESC(); ROT();
  }
  STEP(pB0,pB1,pA0,pA1,NT-1,false,false,false); RESC();
  { float sacc=pB0[0]+pB0[1]; _Pragma("unroll") for(int r=2;r<16;++r)sacc+=pB0[r]; _Pragma("unroll") for(int r=0;r<16;++r)sacc+=pB1[r]; l_reg+=sacc;
    pw0=(u32x4){PKW(pB0,0),PKW(pB0,2),PKW(pB0,4),PKW(pB0,6)};pw1=(u32x4){PKW(pB0,8),PKW(pB0,10),PKW(pB0,12),PKW(pB0,14)};pw2=(u32x4){PKW(pB1,0),PKW(pB1,2),PKW(pB1,4),PKW(pB1,6)};pw3=(u32x4){PKW(pB1,8),PKW(pB1,10),PKW(pB1,12),PKW(pB1,14)};
    SBAR(); pv(o,vb0+sl_cur,PAF(0),PAF(1),PAF(2),PAF(3)); }
  #undef PKW
  #undef PAF
  #undef VFR
  #undef PIN
  #undef MX3
  #undef GAPA
  #undef GAPB
  #undef EX
  #undef VRD
  #undef KRD
  #undef STEP
  #undef ENDW
  {auto rr=__builtin_amdgcn_permlane32_swap(__float_as_uint(l_reg),__float_as_uint(l_reg),false,false);l_reg=__uint_as_float(rr[0])+__uint_as_float(rr[1]);}
  if(hi==0)wsf[32+r32]=l_reg;asm volatile("s_waitcnt lgkmcnt(0)":::"memory");
  float rli[16];
  #pragma unroll
  for(int r=0;r<16;++r)rli[r]=__builtin_amdgcn_rcpf(wsf[32+crow(r,hi)]);
  { bf16*stg=(bf16*)(shm+LDS_OST)+wid*2048;
    #pragma unroll
    for(int r=0;r<16;++r){const int orow=crow(r,hi);
      #pragma unroll
      for(int d0=0;d0<2;++d0)stg[orow*64+d0*32+r32]=__float2bfloat16(o[d0][r]*rli[r]);}
    asm volatile("s_waitcnt lgkmcnt(0)":::"memory");
    #pragma unroll
    for(int i=0;i<4;++i){const int row=i*8+(lane>>3),ch=lane&7; const u32x4 w=*(const u32x4*)(stg+row*64+ch*8);
      float x[8];
      #pragma unroll
      for(int e=0;e<4;++e){x[2*e]=__uint_as_float(w[e]<<16); x[2*e+1]=__uint_as_float(w[e]&0xffff0000u);}
      float ss=((x[0]*x[0]+x[1]*x[1])+(x[2]*x[2]+x[3]*x[3]))+((x[4]*x[4]+x[5]*x[5])+(x[6]*x[6]+x[7]*x[7]));
      ss+=__shfl_xor(ss,1); ss+=__shfl_xor(ss,2); ss+=__shfl_xor(ss,4);
      const float rn=rsqrtf(ss*(1.0f/64.0f)+1e-6f);
      u32x4 v; v.x=cvtpk_s(x[0]*rn,x[1]*rn); v.y=cvtpk_s(x[2]*rn,x[3]*rn); v.z=cvtpk_s(x[4]*rn,x[5]*rn); v.w=cvtpk_s(x[6]*rn,x[7]*rn);
      const long orow_g=is_meta?(metarow+(row&15)):(qrow0+wid*QBLK+row);
      const int h_o=is_meta?(h+2*wid+(row>>4)):h;
      const bool ok=(!is_meta)||(wid<2);
      if(ok) ATTN_STORE16(O+orow_g*OP+h_o*D+ch*8,v);} }
  asm volatile("s_waitcnt lgkmcnt(0)\n\ts_barrier":::"memory");
  #undef DMA_K
  #undef TROW
  #undef DMA_V
  #undef CMASK
  #undef START
  #undef RESC
  #undef ROT
}
constexpr int ATTN_LDS_BYTES=LDS_BYTES;
#undef SBAR
#undef WAIT_BAR
}

constexpr int NWAVES = 8;
constexpr int DM = 1024, DFF = 2816, NIN = 2304, DEPTH = 4;
constexpr int NREAL = 81920, MB = 81920, MP = 82688;
constexpr int NSEQ = 12;
constexpr size_t MiB = 1u << 20;
constexpr size_t WS_CTL = 0, WS_ROPE = 65536, WS_STATS = 131072, WS_W = 6 * MiB, WS_H = 165 * MiB, WS_BIG = 327 * MiB;
constexpr size_t WS_END = WS_BIG + (size_t)MP * 2816 * 2;
constexpr size_t W_GU = (size_t)2 * DFF * DM, W_D = (size_t)DM * DFF, W_IN = (size_t)NIN * DM, W_OUT = (size_t)DM * DM;
constexpr size_t WL_1GU = 0, WL_1D = WL_1GU + W_GU, WL_IN = WL_1D + W_D, WL_OUT = WL_IN + W_IN, WL_2GU = WL_OUT + W_OUT, WL_2D = WL_2GU + W_GU, WL_SZ = WL_2D + W_D;
static_assert(WS_STATS + (size_t)MP * 16 * 4 <= WS_W && WS_W + WL_SZ * 2 * DEPTH <= WS_H && WS_H + (size_t)MP * DM * 2 <= WS_BIG, "ws map");
constexpr int CTL_WORDS = 16384, CW_BAR = 4096;
constexpr int RING_BYTES = 131072, LDS_BYTES = 147456;
static_assert(attn_body::ATTN_LDS_BYTES <= RING_BYTES, "attention LDS");

#define LAS __attribute__((address_space(3)))
typedef unsigned short bf16;
typedef unsigned v4u __attribute__((ext_vector_type(4)));
typedef float f32x4 __attribute__((ext_vector_type(4)));
__device__ __forceinline__ unsigned f2bf(float f) { unsigned u = __builtin_bit_cast(unsigned, f); return (u + 0x7fffu + ((u >> 16) & 1u)) >> 16; }
__device__ __forceinline__ unsigned pk2(float lo, float hi) { return f2bf(lo) | (f2bf(hi) << 16); }
__device__ __forceinline__ float bflo(unsigned w) { return __builtin_bit_cast(float, w << 16); }
__device__ __forceinline__ float bfhi(unsigned w) { return __builtin_bit_cast(float, w & 0xffff0000u); }
__device__ __forceinline__ float wave_sum(float v) {
#pragma unroll
    for (int o = 1; o < 64; o <<= 1) v += __shfl_xor(v, o);
    return v;
}
__device__ __forceinline__ void tr_item(const float* W, int K, int N, const float* gain, bf16* WT, int drow0, LAS float* scr, int k0, int n0, int lane) {
#pragma unroll 16
    for (int i = 0; i < 32; ++i) { const int kk = 2 * i + (lane >> 5); const float g = gain ? gain[k0 + kk] : 1.0f; scr[kk * 33 + (lane & 31)] = g * W[(size_t)(k0 + kk) * N + n0 + (lane & 31)]; }
    asm volatile("s_waitcnt lgkmcnt(0)" ::: "memory");
    const int c = lane & 7;
#pragma unroll
    for (int j = 0; j < 4; ++j) { const int n = (lane >> 3) + 8 * j; const LAS float* s = scr + (8 * c) * 33 + n;
        v4u o; o.x = pk2(s[0 * 33], s[1 * 33]); o.y = pk2(s[2 * 33], s[3 * 33]); o.z = pk2(s[4 * 33], s[5 * 33]); o.w = pk2(s[6 * 33], s[7 * 33]);
        *(v4u*)(WT + (size_t)(drow0 + n) * K + k0 + 8 * c) = o; }
    asm volatile("s_waitcnt lgkmcnt(0)" ::: "memory");
}
__device__ __forceinline__ int win_drow(int n0) {
    if (n0 < 1280) { const int hd = n0 >> 6, bj = (n0 >> 5) & 1; return 256 * (hd >> 2) + 128 * bj + 32 * (hd & 3); }
    if (n0 < 1792) { const int t = (n0 - 1280) >> 7, w = (n0 - 1280) & 127; return 1280 + 256 * t + w; }
    { const int t = (n0 - 1792) >> 7, w = (n0 - 1792) & 127; return 1280 + 256 * t + 128 + w; }
}
__device__ __forceinline__ long seq_base(int q) { return q < 4 ? 4096L * q : 16384L + 8192L * (q - 4); }

#define GAS __attribute__((address_space(1)))
#define XB_TMO      128
#define XB_XCNT(j)  (256  + 64 * (j))
#define XB_XSUB(j)  (1280 + 64 * (j))
#define XB_XGEN(j)  (2304 + 64 * (j))
#define XB_TOP      3328
#define XB_TOPGEN   3392
#define XCD_BAR_WORDS 3456
#define XB_SPIN_CAP (1u << 18)

__device__ __forceinline__ unsigned xb_ld(unsigned* p)              { return __hip_atomic_load(p, __ATOMIC_RELAXED, __HIP_MEMORY_SCOPE_AGENT); }
__device__ __forceinline__ unsigned xb_add(unsigned* p, unsigned v) { return __hip_atomic_fetch_add(p, v, __ATOMIC_RELAXED, __HIP_MEMORY_SCOPE_AGENT); }
__device__ __forceinline__ unsigned xb_xcc_id() { return (unsigned)__builtin_amdgcn_s_getreg((3 << 11) | 20) & 0xFu; }
#define XB_SPIN(cond, bar) do { unsigned _sp = 0; while (cond) { __builtin_amdgcn_s_sleep(1); \
    if ((++_sp & 255u) == 0u) { if (xb_ld(&(bar)[XB_TMO])) break; if (_sp > XB_SPIN_CAP) { atomicAdd(&(bar)[XB_TMO], 1u); break; } } } } while (0)

struct XcdBarrier {
    unsigned* bar; unsigned x;
    volatile LAS unsigned* st;
};

__device__ __forceinline__ XcdBarrier xcd_barrier_post(unsigned* bar, volatile LAS unsigned* st) {
    XcdBarrier b; b.bar = bar; b.x = xb_xcc_id(); b.st = st;
    if (threadIdx.x == 0) (void)xb_add(&bar[XB_XCNT(b.x)], 1u);
    return b;
}
__device__ __forceinline__ void xcd_barrier_complete(unsigned* bar, unsigned x, unsigned& nloc, unsigned& nx) {
    const unsigned G = gridDim.x * gridDim.y * gridDim.z;
    unsigned sum, cnt, mine, sp = 0u;
    for (;;) {
        sum = 0u; cnt = 0u; mine = 0u;
#pragma unroll
        for (unsigned j = 0; j < 16; ++j) { const unsigned c = xb_ld(&bar[XB_XCNT(j)]); sum += c; cnt += (c > 0u) ? 1u : 0u; mine = (j == x) ? c : mine; }
        if (sum == G) break;
        __builtin_amdgcn_s_sleep(1);
        if ((++sp & 255u) == 0u) { if (xb_ld(&bar[XB_TMO])) break; if (sp > XB_SPIN_CAP) { atomicAdd(&bar[XB_TMO], 1u); break; } }
    }
    nloc = mine > 0u ? mine : 1u; nx = cnt > 0u ? cnt : 1u;
}

__device__ __forceinline__ void xcd_barrier(const XcdBarrier& b) {
    asm volatile("s_waitcnt vmcnt(0)" ::: "memory");
    __syncthreads();
    if (threadIdx.x == 0) {
        unsigned* bar = b.bar;
        __builtin_amdgcn_s_waitcnt(0);
        unsigned nloc = b.st[0], nx = b.st[1];
        if (nloc == 0u) { xcd_barrier_complete(bar, b.x, nloc, nx); b.st[0] = nloc; b.st[1] = nx; }
        const unsigned old = xb_add(&bar[XB_XSUB(b.x)], 1u);
        const unsigned gen = old / nloc;
        if (old + 1u == (gen + 1u) * nloc) {
            __builtin_amdgcn_fence(__ATOMIC_RELEASE, "agent");
            asm volatile("s_waitcnt vmcnt(0)" ::: "memory");
            const unsigned og = xb_add(&bar[XB_TOP], 1u);
            const unsigned tg = og / nx;
            if (og + 1u == (tg + 1u) * nx) xb_add(&bar[XB_TOPGEN], 1u);
            else XB_SPIN(xb_ld(&bar[XB_TOPGEN]) == tg, bar);
            __builtin_amdgcn_fence(__ATOMIC_ACQUIRE, "agent");
            xb_add(&bar[XB_XGEN(b.x)], 1u);
            asm volatile("s_waitcnt vmcnt(0)" ::: "memory");
        } else {
            XB_SPIN(xb_ld(&bar[XB_XGEN(b.x)]) == gen, bar);
            __builtin_amdgcn_fence(__ATOMIC_ACQUIRE, "agent");
            asm volatile("s_waitcnt vmcnt(0)" ::: "memory");
        }
    }
    __syncthreads();
}

static_assert(CW_BAR + XCD_BAR_WORDS <= CTL_WORDS && CTL_WORDS * 4 <= (int)WS_ROPE, "ctl map");

struct Args { const float* in[21]; float* out; unsigned char* ws; };

#define CONVERT_LAYER(LC, W0, NW) do { const int lc__ = (LC), w0__ = (W0), nw__ = (NW); { const int l = lc__; LAS float* scr = (LAS float*)(ldsp + wave * 16384); \
        constexpr int I_GU = 16 * 88, I_D = 44 * 32, I_IN = 16 * 72, I_OUT = 16 * 32, I_L = 4 * I_GU + 2 * I_D + I_IN + I_OUT; \
        for (int it = w0__; it < I_L; it += nw__) { \
            int r = it; bf16* WL = Wb + (size_t)l * WL_SZ; \
            if (r < 4 * I_GU) { const int which = r / I_GU; r %= I_GU; const int kb = r / 88, nb = r % 88, n0 = 32 * nb; \
                const float* W = args.in[(which < 2 ? 4 : 17) + (which & 1)] + (size_t)l * DM * DFF; const float* gn = args.in[which < 2 ? 3 : 16] + l * DM; \
                tr_item(W, DM, DFF, gn, WL + (which < 2 ? WL_1GU : WL_2GU), 256 * (n0 >> 7) + (n0 & 127) + ((which & 1) ? 128 : 0), scr, 64 * kb, n0, lane); continue; } \
            r -= 4 * I_GU; \
            if (r < 2 * I_D) { const int which = r / I_D; r %= I_D; const int kb = r / 32, nb = r % 32; \
                tr_item(args.in[which ? 19 : 6] + (size_t)l * DFF * DM, DFF, DM, nullptr, WL + (which ? WL_2D : WL_1D), 32 * nb, scr, 64 * kb, 32 * nb, lane); continue; } \
            r -= 2 * I_D; \
            if (r < I_IN) { const int kb = r / 72, nb = r % 72; \
                tr_item(args.in[8] + (size_t)l * DM * NIN, DM, NIN, args.in[7] + l * DM, WL + WL_IN, win_drow(32 * nb), scr, 64 * kb, 32 * nb, lane); continue; } \
            r -= I_IN; \
            { const int kb = r / 32, nb = r % 32; const int k0 = 64 * kb; \
              const float* gn = (k0 < 512) ? (args.in[13] + l * 512 + 0) : (args.in[14] + l * 512 - 512); \
              tr_item(args.in[15] + (size_t)l * DM * DM, DM, DM, gn, WL + WL_OUT, 32 * nb, scr, k0, 32 * nb, lane); } \
        } } } while (0)
__global__ void __launch_bounds__(NWAVES * 64, 2) hymba_fwd(Args args) {
    extern __shared__ __attribute__((aligned(16))) unsigned char lds[];
    cg::grid_group grid = cg::this_grid();
    const int tid = threadIdx.x, lane0 = tid & 63, wave = __builtin_amdgcn_readfirstlane(tid >> 6);
    const int G = gridDim.x, bx = blockIdx.x;
    const int gw = bx * NWAVES + wave, NGW = G * NWAVES;
    unsigned char* ws = args.ws;
    unsigned* ctl = (unsigned*)(ws + WS_CTL);
    float* rope = (float*)(ws + WS_ROPE);
    float* stats = (float*)(ws + WS_STATS);
    bf16* Wb = (bf16*)(ws + WS_W);
    bf16* HB = (bf16*)(ws + WS_H);
    bf16* BIG = (bf16*)(ws + WS_BIG);
    bf16* ACT = BIG;
    bf16* Qb = BIG; bf16* Kb = BIG + (size_t)MP * 512; bf16* Vb = BIG + (size_t)MP * 640; bf16* CBb = BIG + (size_t)MP * 768; bf16* Ub = BIG + (size_t)MP * 1280; bf16* Yb = BIG + (size_t)MP * 1792;
    LAS unsigned char* ldsp = (LAS unsigned char*)lds;
    const float* x_prompt = args.in[0]; const float* x_sample = args.in[1]; const float* meta = args.in[2];

    {
        const int lane = lane0;
        for (int i = bx * (NWAVES * 64) + tid; i < CTL_WORDS; i += G * NWAVES * 64) ctl[i] = 0u;
        if (tid < 2) ((LAS unsigned*)(ldsp + RING_BYTES + 128))[tid] = 0u;
        { const int gt = bx * (NWAVES * 64) + tid;
          if (gt < 2048) { const int pos = gt >> 4, i = gt & 15; const double fr = exp2(-(double)i * (13.287712379549449 / 16.0)); double s, c; sincos((double)pos * fr, &s, &c); rope[2 * gt] = (float)c; rope[2 * gt + 1] = (float)s; } }
        CONVERT_LAYER(0, gw, NGW);
        for (int row0 = gw; row0 < MP; row0 += 2 * NGW) {
            f32x4 v[2][4]; float ss[2]; const int rows[2] = {row0, row0 + NGW};
#pragma unroll
            for (int r = 0; r < 2; ++r) { const int row = rows[r]; const float* src = nullptr;
                if (row < 16384) src = x_prompt + (size_t)row * DM; else if (row < NREAL) src = x_sample + (size_t)(row - 16384) * DM;
                else if (row < MP) { const int i = (row - MB) & 63; if (i < 16) src = meta + (size_t)i * DM; }
#pragma unroll
                for (int j = 0; j < 4; ++j) v[r][j] = src ? ((const f32x4*)src)[lane + 64 * j] : (f32x4){0.f, 0.f, 0.f, 0.f}; }
#pragma unroll
            for (int r = 0; r < 2; ++r) { float s = 0.f;
#pragma unroll
                for (int j = 0; j < 4; ++j) s += (v[r][j][0] * v[r][j][0] + v[r][j][1] * v[r][j][1]) + (v[r][j][2] * v[r][j][2] + v[r][j][3] * v[r][j][3]);
                ss[r] = wave_sum(s); }
#pragma unroll
            for (int r = 0; r < 2; ++r) { const int row = rows[r]; if (row < MP) {
#pragma unroll
                for (int j = 0; j < 4; ++j)
                    ((unsigned long long*)(HB + (size_t)row * DM))[lane + 64 * j] = (unsigned long long)pk2(v[r][j][0], v[r][j][1]) | ((unsigned long long)pk2(v[r][j][2], v[r][j][3]) << 32);
                if (lane < 16) stats[(size_t)row * 16 + lane] = (lane == 0) ? ss[r] : 0.f; } }
        }
    }
    grid.sync();
    const XcdBarrier xbar = xcd_barrier_post(ctl + CW_BAR, (volatile LAS unsigned*)(ldsp + RING_BYTES + 128));

    for (int l = 0; l < DEPTH; ++l) {
        const bf16* WL = Wb + (size_t)l * WL_SZ;
        for (int s = 0; s < 2; ++s) {
            if (s == 1) {
#ifndef NO_WIN
                { pg8::Gemm g{HB, WL + WL_IN, MP, NIN, DM}; pg8::StaticOrder S; S.init(MP, NIN, G, bx);
                  pg8::EpiWin E{Qb, Kb, Vb, CBb, Ub, stats, args.in[9] + l * 64, args.in[10] + l * 64, rope};
                  pg8::gemm_phase<pg8::EpiWin, pg8::StaticOrder, true, true>(ldsp, g, S, E); }
#endif

                xcd_barrier(xbar);
                {
                    int lane = lane0; asm volatile("" : "+v"(lane));
                    const float* cw = args.in[11] + (size_t)l * 3 * 512; const float* cbias = args.in[12] + (size_t)l * 512;
                    LAS volatile unsigned* qslot = (LAS volatile unsigned*)(ldsp + RING_BYTES);
                    constexpr int UPG_S = 4 * 32 + 1, UPG_P = 4 * 16 + 1, NU_S = 8 * 2 * UPG_S, NU_P = 4 * 2 * UPG_P, NU = NU_S + NU_P, NCH = MP / 64;
                    for (;;) {
                        if (tid == 0) qslot[0] = atomicAdd(ctl + l, 1u);
                        __syncthreads();
                        const int idx = __builtin_amdgcn_readfirstlane((int)qslot[0]);
                        if (idx >= NU + NCH) break;
                        if (idx < NU) {
                            int q, rem, nqb;
                            if (idx < NU_S) { q = 4 + idx / (2 * UPG_S); rem = idx % (2 * UPG_S); nqb = 32; } else { const int i2 = idx - NU_S; q = i2 / (2 * UPG_P); rem = i2 % (2 * UPG_P); nqb = 16; }
                            const int upg = 4 * nqb + 1, kvg = rem / upg, r2 = rem % upg;
                            const int is_meta = (r2 == 4 * nqb) ? 1 : 0, h = is_meta ? 4 * kvg : 4 * kvg + r2 / nqb, b = is_meta ? 0 : r2 % nqb;
                            const long sb = seq_base(q);
#ifndef NO_ATT
                            attn_body::attn_unit<8>(sb + 256L * b, is_meta, sb + 64L * q, nqb * 4, (long)(MB + 64 * q), h,
                                (const attn_body::bf16*)Qb, (const attn_body::bf16*)Kb, (const attn_body::bf16*)Vb, (attn_body::bf16*)Yb, (char*)lds);
#endif
                        } else {
                            f32x4 w0[2], w1[2], w2[2], bb[2];
#pragma unroll
                            for (int j = 0; j < 2; ++j) { w0[j] = *(const f32x4*)(cw + 8 * lane + 4 * j); w1[j] = *(const f32x4*)(cw + 512 + 8 * lane + 4 * j); w2[j] = *(const f32x4*)(cw + 1024 + 8 * lane + 4 * j); bb[j] = *(const f32x4*)(cbias + 8 * lane + 4 * j); }
                            const int rbase = (idx - NU) * 64 + wave * 8;
                            for (int rr = 0; rr < 8; ++rr) {
                                const int row = rbase + rr;
                                long prev = -1, next = -1; bool valid = true;
                                if (row < NREAL) { const int q = row < 16384 ? (row >> 12) : 4 + ((row - 16384) >> 13); const int nlen = row < 16384 ? 4096 : 8192; const int n = row & (nlen - 1);
                                    prev = (n == 0) ? (long)(MB + 64 * q + 15) : (long)row - 1; next = (n == nlen - 1) ? -1L : (long)row + 1; }
                                else { const int q = (row - MB) >> 6, i = (row - MB) & 63; valid = i < 16; prev = (i == 0) ? -1L : (long)row - 1; next = (i == 15) ? seq_base(q) : (long)row + 1; }
                                v4u* yo = (v4u*)(Yb + (size_t)row * 1024 + 512) + lane;
                                if (!valid) { *yo = (v4u){0u, 0u, 0u, 0u}; *((v4u*)(Yb + (size_t)row * 1024) + lane) = (v4u){0u, 0u, 0u, 0u}; continue; }
                                const v4u uc = *((const v4u*)(Ub + (size_t)row * 512) + lane);
                                const v4u up = prev >= 0 ? *((const v4u*)(Ub + (size_t)prev * 512) + lane) : (v4u){0u, 0u, 0u, 0u};
                                const v4u un = next >= 0 ? *((const v4u*)(Ub + (size_t)next * 512) + lane) : (v4u){0u, 0u, 0u, 0u};
                                const v4u cbv = *((const v4u*)(CBb + (size_t)row * 512) + lane);
                                float y[8]; float ss = 0.f;
#pragma unroll
                                for (int e = 0; e < 8; ++e) { const int wi = e >> 1; const bool hi_ = e & 1;
                                    const float a = hi_ ? bfhi(up[wi]) : bflo(up[wi]), b = hi_ ? bfhi(uc[wi]) : bflo(uc[wi]), c = hi_ ? bfhi(un[wi]) : bflo(un[wi]), d = hi_ ? bfhi(cbv[wi]) : bflo(cbv[wi]);
                                    const float t = a * w0[e >> 2][e & 3] + b * w1[e >> 2][e & 3] + c * w2[e >> 2][e & 3] + bb[e >> 2][e & 3];
                                    y[e] = d * t; ss += y[e] * y[e]; }
                                ss += __shfl_xor(ss, 1); ss += __shfl_xor(ss, 2); ss += __shfl_xor(ss, 4);
                                const float rn = rsqrtf(ss * (1.0f / 64.0f) + 1e-6f);
                                v4u o; o.x = pk2(y[0] * rn, y[1] * rn); o.y = pk2(y[2] * rn, y[3] * rn); o.z = pk2(y[4] * rn, y[5] * rn); o.w = pk2(y[6] * rn, y[7] * rn);
                                *yo = o;
                            }
                            __syncthreads();
                        }
                    }
                }
                xcd_barrier(xbar);
#ifndef NO_WOUT
                { const int Mr = (l == DEPTH - 1) ? NREAL : MP; pg8::Gemm g{Yb, WL + WL_OUT, Mr, DM, DM}; pg8::StaticOrder S; S.init(Mr, DM, G, bx);
                  pg8::EpiResid E{HB, stats, 1.0f};
                  pg8::gemm_phase<pg8::EpiResid, pg8::StaticOrder, true, true>(ldsp, g, S, E); }
#endif

                xcd_barrier(xbar);
            }
#ifndef NO_GU
            { const int Mr = (l == DEPTH - 1 && s == 1) ? NREAL : MP; pg8::Gemm g{HB, WL + (s ? WL_2GU : WL_1GU), Mr, 2 * DFF, DM}; pg8::StaticOrder S; S.init(Mr, 2 * DFF, G, bx);
              pg8::EpiGateUp E{ACT, stats, DFF};
              pg8::gemm_phase<pg8::EpiGateUp, pg8::StaticOrder, true, true>(ldsp, g, S, E); }
#endif

            xcd_barrier(xbar);
#ifndef NO_DOWN
            { const int Mr = (l == DEPTH - 1 && s == 1) ? NREAL : MP; pg8::Gemm g{ACT, WL + (s ? WL_2D : WL_1D), Mr, DM, DFF}; pg8::StaticOrder S; S.init(Mr, DM, G, bx);
              pg8::EpiResid E{HB, stats, 0.5f};
              pg8::gemm_phase<pg8::EpiResid, pg8::StaticOrder, true, true>(ldsp, g, S, E);
              if (s == 0 && l + 1 < DEPTH) {
                  const int extra = S.nwg % G, first = extra ? extra : 0;
                  if (bx >= first) { int lane = lane0; asm volatile("" : "+v"(lane)); CONVERT_LAYER(l + 1, (bx - first) * NWAVES + wave, (G - first) * NWAVES); } } }
#endif

            xcd_barrier(xbar);
        }
    }
    {
        int lane = lane0; asm volatile("" : "+v"(lane));
        const float* fn = args.in[20]; f32x4 gnv[4];
#pragma unroll
        for (int j = 0; j < 4; ++j) gnv[j] = ((const f32x4*)fn)[lane + 64 * j];
        for (int row0 = gw; row0 < NREAL; row0 += 2 * NGW) {
            unsigned long long w[2][4];
#pragma unroll
            for (int r = 0; r < 2; ++r) { const int row = row0 + r * NGW < NREAL ? row0 + r * NGW : row0;
#pragma unroll
                for (int j = 0; j < 4; ++j) w[r][j] = ((const unsigned long long*)(HB + (size_t)row * DM))[lane + 64 * j]; }
#pragma unroll
            for (int r = 0; r < 2; ++r) { const int row = row0 + r * NGW; f32x4 v[4]; float ss = 0.f;
#pragma unroll
                for (int j = 0; j < 4; ++j) { const unsigned lo = (unsigned)w[r][j], hi = (unsigned)(w[r][j] >> 32);
                    v[j][0] = bflo(lo); v[j][1] = bfhi(lo); v[j][2] = bflo(hi); v[j][3] = bfhi(hi); ss += (v[j][0] * v[j][0] + v[j][1] * v[j][1]) + (v[j][2] * v[j][2] + v[j][3] * v[j][3]); }
                const float rs = rsqrtf(wave_sum(ss) * (1.0f / 1024.0f) + 1e-6f);
                if (row < NREAL) {
#pragma unroll
                    for (int j = 0; j < 4; ++j) ((f32x4*)(args.out + (size_t)row * DM))[lane + 64 * j] = v[j] * rs * gnv[j]; } }
        }
    }
}

extern "C" void kernel_launch(void* const* d_in, const int* in_sizes, int n_in, void* d_out, int out_size, void* d_ws, size_t ws_size, hipStream_t stream) {
    static int grid = 0;
    if (grid == 0) {
        if (n_in != 21 || out_size != NREAL * DM || ws_size < WS_END || in_sizes[8] != DEPTH * DM * NIN) {
            fprintf(stderr, "kernel_launch: unexpected shapes: n_in %d out %d ws %zu (need %zu) w_in %d\n", n_in, out_size, ws_size, (size_t)WS_END, n_in > 8 ? in_sizes[8] : -1); grid = -1; return; }
        int dev = 0, cus = 0, per_cu = 0;
        (void)hipGetDevice(&dev); (void)hipDeviceGetAttribute(&cus, hipDeviceAttributeMultiprocessorCount, dev);
        if (hipFuncSetAttribute((const void*)hymba_fwd, hipFuncAttributeMaxDynamicSharedMemorySize, LDS_BYTES) != hipSuccess) { fprintf(stderr, "kernel_launch: hipFuncSetAttribute failed\n"); grid = -1; return; }
        (void)hipOccupancyMaxActiveBlocksPerMultiprocessor(&per_cu, (const void*)hymba_fwd, NWAVES * 64, LDS_BYTES);
        if (per_cu < 1) { fprintf(stderr, "kernel_launch: occupancy query says %d blocks per CU\n", per_cu); per_cu = 1; }
        (void)hipGetLastError();
        grid = cus;
    }
    if (grid < 0) return;
    Args a{};
    for (int i = 0; i < 21; ++i) a.in[i] = (const float*)d_in[i];
    a.out = (float*)d_out; a.ws = (unsigned char*)d_ws;
    void* kargs[] = {&a};
    hipError_t e = hipLaunchCooperativeKernel((const void*)hymba_fwd, dim3(grid), dim3(NWAVES * 64), kargs, LDS_BYTES, stream);
    if (e != hipSuccess) fprintf(stderr, "cooperative launch failed: %s (grid %d)\n", hipGetErrorString(e), grid);
}
```

```cpp
#include <hip/hip_runtime.h>
#include <hip/hip_cooperative_groups.h>
#include <hip/hip_bf16.h>
#include <cstdio>
#include <cstdint>
#include <cmath>
namespace cg = cooperative_groups;
namespace pg8 {
#define PG8_LAS __attribute__((address_space(3)))
typedef unsigned short bf16_t;
typedef short bf16x8 __attribute__((ext_vector_type(8)));
typedef float f32x4 __attribute__((ext_vector_type(4)));
typedef unsigned u32x4 __attribute__((ext_vector_type(4)));
constexpr int BM = 256, BK = 64, HALF = 128, HTB = HALF * BK * 2  , STAGE_BYTES = 8 * HTB, NXCD = 8, WGM = 8;

__host__ __device__ __forceinline__ int lds_byte(int r, int c) { const int st = (r >> 4) * 2 + (c >> 5), rr = r & 15, cc = c & 31, ob = rr * 64 + cc * 2; return st * 1024 + (ob ^ (((ob >> 9) & 1) << 5)); }
__host__ __device__ __forceinline__ void stage_rc(int b, int& R, int& C) { const int st = b / 1024, sb = b % 1024, swz = sb ^ (((sb >> 9) & 1) << 5); R = (st >> 1) * 16 + swz / 64; C = (st & 1) * 32 + (swz % 64) / 2; }
__host__ __device__ __forceinline__ int perm32(int rho) { const int n = rho >> 4, i = rho & 15; return 8 * (i >> 2) + 4 * n + (i & 3); }

struct Unit { int pm, pn; };
struct Gemm { const bf16_t* A; const bf16_t* Bt; int M, N, K; };

struct StaticOrder {
    int nM, nN, nwg, G, c;
    __host__ __device__ void init(int M, int N, int G_, int c_) { nM = M / BM; nN = N / BM; nwg = nM * nN; G = G_; c = c_; }
    __host__ __device__ bool next(int i, Unit& u) const {
        const long L = (long)i * G + c; if (L >= nwg) return false;
        int wgid = (int)L; { const int q = nwg / NXCD, r = nwg % NXCD, xcd = wgid % NXCD, off = wgid / NXCD; wgid = (xcd < r ? xcd * (q + 1) : r * (q + 1) + (xcd - r) * q) + off; }
        const int nig = WGM * nN, gid = wgid / nig, fm = gid * WGM, gsz = (nM - fm) < WGM ? (nM - fm) : WGM;
        u.pm = fm + ((wgid % nig) % gsz); u.pn = (wgid % nig) / gsz; return true;
    }
    __device__ __forceinline__ void a_ready(const Unit&) const {}
    __device__ __forceinline__ void done(const Unit&) const {}
};

__device__ __forceinline__ unsigned cvt_pk_bf16(float lo, float hi) { unsigned r; asm volatile("v_cvt_pk_bf16_f32 %0, %1, %2" : "=v"(r) : "v"(lo), "v"(hi)); return r; }
constexpr float RMS_EPS = 1e-6f;
typedef float f32x2 __attribute__((ext_vector_type(2)));
__device__ __forceinline__ float row_rstd(const float* stats, int row, int fq) {
    const f32x4 a = *(const f32x4*)(stats + (size_t)row * 16 + 4 * fq);
    float t = (a[0] + a[1]) + (a[2] + a[3]);
    t += __shfl_xor(t, 16); t += __shfl_xor(t, 32);
    return rsqrtf(t * (1.0f / 1024.0f) + RMS_EPS);
}
#define EPI_RS8(rsv) float rsv[8]; _Pragma("unroll") for (int ai_ = 0; ai_ < 2; ++ai_) _Pragma("unroll") for (int m_ = 0; m_ < 4; ++m_) rsv[ai_ * 4 + m_] = row_rstd(stats, row0 + ai_ * HALF + m_ * 16, fq); asm volatile("" ::: "memory")
#define EPI_FENCE() asm volatile("" ::: "memory")
__device__ __forceinline__ float silu_f(float x) { return x * __builtin_amdgcn_rcpf(1.0f + __builtin_amdgcn_exp2f(-1.4426950408889634f * x)); }
__device__ __forceinline__ u32x4 pack8(const f32x4 a, const f32x4 b) { u32x4 w; w.x = cvt_pk_bf16(a[0], a[1]); w.y = cvt_pk_bf16(a[2], a[3]); w.z = cvt_pk_bf16(b[0], b[1]); w.w = cvt_pk_bf16(b[2], b[3]); return w; }

struct EpiGateUp {
    static constexpr bool PERM = true, AFTER_DRAIN = false;
    bf16_t* O; const float* stats; int ldo;
    __device__ __forceinline__ void operator()(const f32x4 (&acc)[2][2][4][2], const Unit& u, int wr, int wc, int fr_in, int fq_in) const {
        int fr = fr_in, fq = fq_in; asm volatile("" : "+v"(fr), "+v"(fq));
        const int row0 = u.pm * BM + wr * 64 + fr, col0 = u.pn * 128 + wc * 32 + 8 * fq;
        EPI_RS8(rsv);
#pragma unroll
        for (int ai = 0; ai < 2; ++ai)
#pragma unroll
            for (int m = 0; m < 4; ++m) { const int row = row0 + ai * HALF + m * 16; const float rs = rsv[ai * 4 + m], c1 = -1.4426950408889634f * rs, rs2 = rs * rs;
                f32x2 t[4], gu[4];
#pragma unroll
                for (int p = 0; p < 4; ++p) { const f32x4 gq = acc[ai][0][m][p >> 1], uq = acc[ai][1][m][p >> 1];
                    const f32x2 g = (p & 1) ? (f32x2){gq[2], gq[3]} : (f32x2){gq[0], gq[1]}, uu = (p & 1) ? (f32x2){uq[2], uq[3]} : (f32x2){uq[0], uq[1]};
                    const f32x2 a = g * c1; t[p].x = __builtin_amdgcn_exp2f(a.x); t[p].y = __builtin_amdgcn_exp2f(a.y); gu[p] = g * uu; }
#pragma unroll
                for (int p = 0; p < 4; ++p) { const f32x2 d = t[p] + 1.0f; t[p].x = __builtin_amdgcn_rcpf(d.x); t[p].y = __builtin_amdgcn_rcpf(d.y); }
                f32x4 o0, o1;
#pragma unroll
                for (int p = 0; p < 4; ++p) { const f32x2 o = gu[p] * (t[p] * rs2); if (p < 2) { o0[2 * p] = o.x; o0[2 * p + 1] = o.y; } else { o1[2 * p - 4] = o.x; o1[2 * p - 3] = o.y; } }
                *(u32x4*)(O + (size_t)row * ldo + col0) = pack8(o0, o1); EPI_FENCE(); }
    }
};
struct EpiResid {
    static constexpr bool PERM = true, AFTER_DRAIN = false;
    bf16_t* HB; float* stats; float scale;
    __device__ __forceinline__ void operator()(const f32x4 (&acc)[2][2][4][2], const Unit& u, int wr, int wc, int fr_in, int fq_in) const {
        int fr = fr_in, fq = fq_in; asm volatile("" : "+v"(fr), "+v"(fq));
        const int row0 = u.pm * BM + wr * 64 + fr, col0 = u.pn * BM + wc * 32 + 8 * fq;
#pragma unroll
        for (int ai = 0; ai < 2; ++ai)
#pragma unroll
            for (int m = 0; m < 4; ++m) { const int row = row0 + ai * HALF + m * 16; float ss = 0.f;
#pragma unroll
                for (int bj = 0; bj < 2; ++bj) { u32x4* hp = (u32x4*)(HB + (size_t)row * 1024 + col0 + bj * HALF);
                    const u32x4 w = *hp; f32x4 h0, h1;
                    h0[0] = __uint_as_float(w.x << 16); h0[1] = __uint_as_float(w.x & 0xffff0000u); h0[2] = __uint_as_float(w.y << 16); h0[3] = __uint_as_float(w.y & 0xffff0000u);
                    h1[0] = __uint_as_float(w.z << 16); h1[1] = __uint_as_float(w.z & 0xffff0000u); h1[2] = __uint_as_float(w.w << 16); h1[3] = __uint_as_float(w.w & 0xffff0000u);
                    h0 = h0 + acc[ai][bj][m][0] * scale; h1 = h1 + acc[ai][bj][m][1] * scale;
                    *hp = pack8(h0, h1);
                    ss += ((h0[0] * h0[0] + h0[1] * h0[1]) + (h0[2] * h0[2] + h0[3] * h0[3])) + ((h1[0] * h1[0] + h1[1] * h1[1]) + (h1[2] * h1[2] + h1[3] * h1[3])); }
                ss += __shfl_xor(ss, 16); ss += __shfl_xor(ss, 32);
                if (fq == 0) stats[(size_t)row * 16 + u.pn * 4 + wc] = ss; EPI_FENCE(); }
    }
};
__device__ __forceinline__ int kv_row(int row) {
    if (row < 16384) return row + 64 * (row >> 12);
    if (row < 81920) return row + 64 * (4 + ((row - 16384) >> 13));
    const int q = (row - 81920) >> 6, i = (row - 81920) & 63;
    return (q < 4 ? 4096 * q + 4096 : 16384 + 8192 * (q - 4) + 8192) + 64 * q + i;
}
struct EpiWin {
    static constexpr bool PERM = true, AFTER_DRAIN = false;
    bf16_t *Q, *K, *V, *CB, *U; const float* stats; const float* qg; const float* kg; const float* rope;
    __device__ __forceinline__ void operator()(const f32x4 (&acc)[2][2][4][2], const Unit& u, int wr, int wc, int fr_in, int fq_in) const {
        int fr = fr_in, fq = fq_in; asm volatile("" : "+v"(fr), "+v"(fq));
        const int row0 = u.pm * BM + wr * 64 + fr, pn = u.pn;
        if (pn >= 5) {
            const int col0 = (pn - 5) * 128 + wc * 32 + 8 * fq;
#pragma unroll
            for (int ai = 0; ai < 2; ++ai)
#pragma unroll
                for (int m = 0; m < 4; ++m) { const int row = row0 + ai * HALF + m * 16; const float rs = row_rstd(stats, row, fq), rs2 = rs * rs;
                    const f32x4 o0 = acc[ai][0][m][0] * acc[ai][1][m][0] * rs2, o1 = acc[ai][0][m][1] * acc[ai][1][m][1] * rs2;
                    *(u32x4*)(U + (size_t)row * 512 + col0) = pack8(o0, o1); EPI_FENCE(); }
            return;
        }
        const int hd = 4 * pn + wc;
        const bool is_q = hd < 8, is_k = (hd >= 8 && hd < 10);
        bf16_t* dst; int ldd, cb;
        if (is_q) { dst = Q; ldd = 512; cb = hd * 64; } else if (is_k) { dst = K; ldd = 128; cb = (hd - 8) * 64; }
        else if (hd < 12) { dst = V; ldd = 128; cb = (hd - 10) * 64; } else { dst = CB; ldd = 512; cb = (hd - 12) * 64; }
        cb += 8 * fq;
        if (is_q || is_k) {
            const float* gp = (is_q ? qg : kg) + 8 * fq;
            const float osc = is_q ? (0.125f * 1.4426950408889634f) : 1.0f;
#pragma unroll
            for (int ai = 0; ai < 2; ++ai)
#pragma unroll
                for (int m = 0; m < 4; ++m) { const int row = row0 + ai * HALF + m * 16; const float rs = row_rstd(stats, row, fq);
                    f32x4 v00 = acc[ai][0][m][0] * rs, v01 = acc[ai][0][m][1] * rs, v10 = acc[ai][1][m][0] * rs, v11 = acc[ai][1][m][1] * rs;
                    float ss = ((v00[0] * v00[0] + v00[1] * v00[1]) + (v00[2] * v00[2] + v00[3] * v00[3])) + ((v01[0] * v01[0] + v01[1] * v01[1]) + (v01[2] * v01[2] + v01[3] * v01[3]))
                             + ((v10[0] * v10[0] + v10[1] * v10[1]) + (v10[2] * v10[2] + v10[3] * v10[3])) + ((v11[0] * v11[0] + v11[1] * v11[1]) + (v11[2] * v11[2] + v11[3] * v11[3]));
                    ss += __shfl_xor(ss, 16); ss += __shfl_xor(ss, 32);
                    const float rn = rsqrtf(ss * (1.0f / 64.0f) + RMS_EPS);
                    v00 = v00 * *(const f32x4*)gp * rn; v01 = v01 * *(const f32x4*)(gp + 4) * rn; v10 = v10 * *(const f32x4*)(gp + 32) * rn; v11 = v11 * *(const f32x4*)(gp + 36) * rn;
                    int rp = 0, cp = 0;
                    if (row < 81920) { const int nn = row & (row < 16384 ? 4095 : 8191); rp = nn >> 6; cp = nn & 63; }
                    const float* tr = rope + (size_t)rp * 32 + 8 * fq; const float* tc = rope + (size_t)cp * 32 + 8 * fq;
                    const f32x4 r0 = *(const f32x4*)tr, r1 = *(const f32x4*)(tr + 4), c0 = *(const f32x4*)tc, c1 = *(const f32x4*)(tc + 4);
                    f32x4 o00, o01, o10, o11;
                    o00[0] = v00[0] * r0[0] - v00[1] * r0[1]; o00[1] = v00[0] * r0[1] + v00[1] * r0[0]; o00[2] = v00[2] * r0[2] - v00[3] * r0[3]; o00[3] = v00[2] * r0[3] + v00[3] * r0[2];
                    o01[0] = v01[0] * r1[0] - v01[1] * r1[1]; o01[1] = v01[0] * r1[1] + v01[1] * r1[0]; o01[2] = v01[2] * r1[2] - v01[3] * r1[3]; o01[3] = v01[2] * r1[3] + v01[3] * r1[2];
                    o10[0] = v10[0] * c0[0] - v10[1] * c0[1]; o10[1] = v10[0] * c0[1] + v10[1] * c0[0]; o10[2] = v10[2] * c0[2] - v10[3] * c0[3]; o10[3] = v10[2] * c0[3] + v10[3] * c0[2];
                    o11[0] = v11[0] * c1[0] - v11[1] * c1[1]; o11[1] = v11[0] * c1[1] + v11[1] * c1[0]; o11[2] = v11[2] * c1[2] - v11[3] * c1[3]; o11[3] = v11[2] * c1[3] + v11[3] * c1[2];
                    bf16_t* dp = dst + (size_t)(is_k ? kv_row(row) : row) * ldd + cb;
                    *(u32x4*)dp = pack8(o00 * osc, o01 * osc); *(u32x4*)(dp + 32) = pack8(o10 * osc, o11 * osc); EPI_FENCE(); }
        } else {
#pragma unroll
            for (int ai = 0; ai < 2; ++ai)
#pragma unroll
                for (int m = 0; m < 4; ++m) { const int row = row0 + ai * HALF + m * 16; const float rs = row_rstd(stats, row, fq);
                    bf16_t* dp = dst + (size_t)(hd < 12 ? kv_row(row) : row) * ldd + cb;
                    *(u32x4*)dp = pack8(acc[ai][0][m][0] * rs, acc[ai][0][m][1] * rs); *(u32x4*)(dp + 32) = pack8(acc[ai][1][m][0] * rs, acc[ai][1][m][1] * rs); EPI_FENCE(); }
        }
    }
};

template <class Epi, class Sched, bool ALIGN_EPI = false, bool SP2 = false>
__device__ __forceinline__ void gemm_phase(PG8_LAS unsigned char* lds, const Gemm g, const Sched& S, const Epi& E) {
    int tid_ = threadIdx.x; asm volatile("" : "+v"(tid_));
    const int tid = tid_, wid = __builtin_amdgcn_readfirstlane(tid >> 6), lane = tid & 63, wr = wid >> 2, wc = wid & 3, fr = lane & 15, fq = lane >> 4;
    const int K = g.K, nt = K / BK;
    unsigned voffA[2], voffB[2];
#pragma unroll
    for (int i = 0; i < 2; ++i) { int R, C; stage_rc(tid * 16 + i * 8192, R, C); const int Rb = Epi::PERM ? ((R & ~31) + perm32(R & 31)) : R;
        voffA[i] = (unsigned)(R * K + C) * 2u; voffB[i] = (unsigned)(Rb * K + C) * 2u; }
    const size_t kstep = (size_t)(BK * 2);
    const size_t hstep = (size_t)HALF * K * 2;
    const size_t tstep = 2 * hstep;
    const unsigned ldsw = (unsigned)wid * 1024u;
    const int aoff = lds_byte(wr * 64 + fr, fq * 8), boff = lds_byte(wc * 32 + fr, fq * 8);
#define PG8_SA(b, h) (((b) * 2 + (h)) * HTB)
#define PG8_SB(b, h) ((4 + (b) * 2 + (h)) * HTB)
#define PG8_STAGE(bufoff, gbase, voff) do { _Pragma("unroll") for (int _i = 0; _i < 2; ++_i) \
        __builtin_amdgcn_global_load_lds((const unsigned*)((const char*)(gbase) + (voff)[_i]), (PG8_LAS unsigned*)(lds + (bufoff) + ldsw + _i * 8192), 16, 0, 0); } while (0)
#define PG8_LDA(dst, b, h) do { _Pragma("unroll") for (int m = 0; m < 4; ++m) _Pragma("unroll") for (int k = 0; k < 2; ++k) dst[m][k] = *(const PG8_LAS bf16x8*)(lds + PG8_SA(b, h) + aoff + m * 2048 + k * 1024); } while (0)
#define PG8_LDB(dst, b, h) do { _Pragma("unroll") for (int n = 0; n < 2; ++n) _Pragma("unroll") for (int k = 0; k < 2; ++k) dst[n][k] = *(const PG8_LAS bf16x8*)(lds + PG8_SB(b, h) + boff + n * 2048 + k * 1024); } while (0)
#define PG8_MMA(ai, bj, At, Bt) do { __builtin_amdgcn_s_setprio(1); _Pragma("unroll") for (int m = 0; m < 4; ++m) _Pragma("unroll") for (int n = 0; n < 2; ++n) _Pragma("unroll") for (int k = 0; k < 2; ++k) \
        acc[ai][bj][m][n] = __builtin_amdgcn_mfma_f32_16x16x32_bf16(Bt[n][k], At[m][k], acc[ai][bj][m][n], 0, 0, 0); __builtin_amdgcn_s_setprio(0); } while (0)
#define PG8_WAIT_V(n) asm volatile("s_waitcnt vmcnt(" #n ")" ::: "memory")
#define PG8_WAIT_L(n) asm volatile("s_waitcnt lgkmcnt(" #n ")" ::: "memory")
#define PG8_BAR __builtin_amdgcn_s_barrier()
#define PG8_SCHED __builtin_amdgcn_sched_barrier(0)
    Unit cur, nxt; int ui = 0;
    if (!S.next(0, cur)) return;
    f32x4 acc[2][2][4][2];
#pragma unroll
    for (int a = 0; a < 2; ++a)
#pragma unroll
        for (int b = 0; b < 2; ++b)
#pragma unroll
            for (int m = 0; m < 4; ++m)
#pragma unroll
                for (int n = 0; n < 2; ++n) acc[a][b][m][n] = (f32x4){0.f, 0.f, 0.f, 0.f};
    bf16x8 At[4][2], B0[2][2], B1[2][2];
    const char* cA = (const char*)g.A + (size_t)cur.pm * tstep; const char* cB = (const char*)g.Bt + (size_t)cur.pn * tstep;
    S.a_ready(cur);
    if constexpr (SP2) {
        PG8_STAGE(PG8_SB(0, 0), cB, voffB); PG8_STAGE(PG8_SB(0, 1), cB + hstep, voffB); PG8_STAGE(PG8_SA(0, 0), cA, voffA); PG8_STAGE(PG8_SA(0, 1), cA + hstep, voffA);
        if (wr == 1) PG8_BAR;
        PG8_WAIT_V(2); PG8_BAR;
        PG8_STAGE(PG8_SB(1, 0), cB + kstep, voffB); PG8_STAGE(PG8_SA(1, 0), cA + kstep, voffA); PG8_STAGE(PG8_SB(1, 1), cB + hstep + kstep, voffB);
        PG8_WAIT_V(6); PG8_BAR;
    } else {
        PG8_STAGE(PG8_SB(0, 0), cB, voffB); PG8_STAGE(PG8_SA(0, 0), cA, voffA); PG8_STAGE(PG8_SB(0, 1), cB + hstep, voffB); PG8_STAGE(PG8_SA(0, 1), cA + hstep, voffA);
        if (wr == 1) PG8_BAR;
        PG8_WAIT_V(4); PG8_BAR;
        PG8_STAGE(PG8_SB(1, 0), cB + kstep, voffB); PG8_STAGE(PG8_SA(1, 0), cA + kstep, voffA); PG8_STAGE(PG8_SB(1, 1), cB + hstep + kstep, voffB);
        PG8_WAIT_V(6); PG8_BAR;
    }
    for (;;) {
        const bool has_next = S.next(ui + 1, nxt);
        const char* nA = has_next ? (const char*)g.A + (size_t)nxt.pm * tstep : cA; const char* nB = has_next ? (const char*)g.Bt + (size_t)nxt.pn * tstep : cB;
        for (int t = 0; t < nt; t += 2) {
            const bool last = (t == nt - 2);
            const char* a1 = cA + (size_t)(t + 1) * kstep;
            const char* a2 = last ? nA : cA + (size_t)(t + 2) * kstep; const char* b2 = last ? nB : cB + (size_t)(t + 2) * kstep;
            const char* a3 = a2 + kstep; const char* b3 = b2 + kstep;
            if (last && has_next) S.a_ready(nxt);
            if constexpr (SP2) {
            PG8_LDB(B0, 0, 0); PG8_LDB(B1, 0, 1); PG8_SCHED; PG8_LDA(At, 0, 0); PG8_STAGE(PG8_SA(1, 1), a1 + hstep, voffA);
            PG8_WAIT_V(8); PG8_WAIT_L(0); PG8_BAR; PG8_MMA(0, 0, At, B0); PG8_MMA(0, 1, At, B1); PG8_BAR; PG8_SCHED;
            PG8_LDA(At, 0, 1); PG8_STAGE(PG8_SB(0, 0), b2, voffB); PG8_STAGE(PG8_SB(0, 1), b2 + hstep, voffB); PG8_STAGE(PG8_SA(0, 0), a2, voffA);
            PG8_WAIT_V(8); PG8_WAIT_L(0); PG8_BAR; PG8_MMA(1, 0, At, B0); PG8_MMA(1, 1, At, B1); PG8_BAR; PG8_SCHED;
            PG8_LDB(B0, 1, 0); PG8_LDB(B1, 1, 1); PG8_SCHED; PG8_LDA(At, 1, 0); PG8_STAGE(PG8_SA(0, 1), a2 + hstep, voffA);
            PG8_WAIT_V(8); PG8_WAIT_L(0); PG8_BAR; PG8_MMA(0, 0, At, B0); PG8_MMA(0, 1, At, B1); PG8_BAR; PG8_SCHED;
            PG8_LDA(At, 1, 1); PG8_STAGE(PG8_SB(1, 0), b3, voffB); PG8_STAGE(PG8_SB(1, 1), b3 + hstep, voffB); PG8_STAGE(PG8_SA(1, 0), a3, voffA);
            PG8_WAIT_V(8); PG8_WAIT_L(0); PG8_BAR; PG8_MMA(1, 0, At, B0); PG8_MMA(1, 1, At, B1); PG8_BAR; PG8_SCHED;
            } else {
            PG8_LDB(B0, 0, 0); PG8_SCHED; PG8_LDA(At, 0, 0); PG8_STAGE(PG8_SA(1, 1), a1 + hstep, voffA);
            PG8_WAIT_L(8); PG8_BAR; PG8_WAIT_L(0); PG8_MMA(0, 0, At, B0); PG8_BAR; PG8_SCHED;
            PG8_LDB(B1, 0, 1); PG8_STAGE(PG8_SB(0, 0), b2, voffB);
            PG8_BAR; PG8_WAIT_L(0); PG8_MMA(0, 1, At, B1); PG8_BAR;
            PG8_LDA(At, 0, 1); PG8_STAGE(PG8_SA(0, 0), a2, voffA);
            PG8_BAR; PG8_WAIT_L(0); PG8_MMA(1, 0, At, B0); PG8_BAR; PG8_SCHED;
            PG8_STAGE(PG8_SB(0, 1), b2 + hstep, voffB);
            PG8_WAIT_V(6); PG8_BAR; PG8_MMA(1, 1, At, B1); PG8_BAR;
            PG8_LDB(B0, 1, 0); PG8_SCHED; PG8_LDA(At, 1, 0); PG8_STAGE(PG8_SA(0, 1), a2 + hstep, voffA);
            PG8_WAIT_L(8); PG8_BAR; PG8_WAIT_L(0); PG8_MMA(0, 0, At, B0); PG8_BAR; PG8_SCHED;
            PG8_LDB(B1, 1, 1); PG8_STAGE(PG8_SB(1, 0), b3, voffB);
            PG8_BAR; PG8_WAIT_L(0); PG8_MMA(0, 1, At, B1); PG8_BAR;
            PG8_LDA(At, 1, 1); PG8_STAGE(PG8_SA(1, 0), a3, voffA);
            PG8_BAR; PG8_WAIT_L(0); PG8_MMA(1, 0, At, B0); PG8_BAR; PG8_SCHED;
            PG8_STAGE(PG8_SB(1, 1), b3 + hstep, voffB);
            PG8_WAIT_V(6); PG8_BAR; PG8_MMA(1, 1, At, B1); PG8_BAR;
            }
        }
        if constexpr (ALIGN_EPI) { if (wr == 0) PG8_BAR; }
        if constexpr (!Epi::AFTER_DRAIN) { E(acc, cur, wr, wc, fr, fq); S.done(cur); }
        if (!has_next) break;
#pragma unroll
        for (int a = 0; a < 2; ++a)
#pragma unroll
            for (int b = 0; b < 2; ++b)
#pragma unroll
                for (int m = 0; m < 4; ++m)
#pragma unroll
                    for (int n = 0; n < 2; ++n) acc[a][b][m][n] = (f32x4){0.f, 0.f, 0.f, 0.f};
        cur = nxt; cA = nA; cB = nB; ++ui;
        if constexpr (ALIGN_EPI) { if (wr == 1) PG8_BAR; }
    }
    PG8_WAIT_V(0);
    if constexpr (!ALIGN_EPI) { if (wr == 0) PG8_BAR; }
    PG8_BAR;
    if constexpr (Epi::AFTER_DRAIN) { E.fused(acc, cur, wr, wc, fr, fq, lds, wid, lane); S.done(cur); }
#undef PG8_SA
#undef PG8_SB
#undef PG8_STAGE
#undef PG8_LDA
#undef PG8_LDB
#undef PG8_MMA
#undef PG8_WAIT_V
#undef PG8_WAIT_L
#undef PG8_BAR
#undef PG8_SCHED
}
}

namespace attn_body {
using bf16=__hip_bfloat16;
using bf16x8=__attribute__((ext_vector_type(8)))short;
using s16x4=__attribute__((ext_vector_type(4)))short;
using f32x16=__attribute__((ext_vector_type(16)))float;
using u32x4=__attribute__((ext_vector_type(4)))unsigned;
constexpr int D=64,QP=512,KP=128,OP=1024;
typedef float f32x4 __attribute__((ext_vector_type(4)));
constexpr int NW=8,QBLK=32,QB=QBLK*NW,KVBLK=64;
__device__ __forceinline__ int crow(int r,int hi){return (r&3)+8*(r>>2)+4*hi;}
#define SBAR() __builtin_amdgcn_sched_barrier(0)
#define ATTN_STORE16(p,v) (*(u32x4*)(p)=(v))
__device__ __forceinline__ void mmask(f32x16&p0,f32x16&p1,bool any,bool all){
  const float NEG=-INFINITY;
  #pragma unroll
  for(int r=0;r<16;++r){p1[r]=any?NEG:p1[r]; p0[r]=((r>=8)?any:all)?NEG:p0[r];}
}
constexpr int NSLOT=3, SLOTB=8192;
constexpr int LDS_K=0, LDS_V=NSLOT*SLOTB, LDS_WS=2*NSLOT*SLOTB, LDS_OST=LDS_WS+NW*64*4, LDS_BYTES=LDS_OST+NW*4096;
constexpr float C2=0.125f*1.4426950408889634f;
__device__ __forceinline__ void glds16(const void*gsrc,unsigned lds_dst){unsigned keep;
  asm volatile("s_mov_b32 %0, m0\n\ts_mov_b32 m0, %2\n\ts_nop 0\n\tglobal_load_lds_dwordx4 %1, off\n\ts_mov_b32 m0, %0":"=&s"(keep):"v"(gsrc),"s"(lds_dst):"memory");}
__device__ __forceinline__ float max3f(float a,float b,float c){float r;asm("v_max3_f32 %0, %1, %2, %3":"=v"(r):"v"(a),"v"(b),"v"(c));return r;}
__device__ __forceinline__ float max2f(float a,float b){float r;asm("v_max_f32_e32 %0, %1, %2":"=v"(r):"v"(a),"v"(b));return r;}
__device__ __forceinline__ float fadd_s(float a,float b){float r;asm("v_add_f32_e32 %0, %1, %2":"=v"(r):"v"(a),"v"(b));return r;}
__device__ __forceinline__ float fsub_s(float a,float b){float r;asm("v_sub_f32_e32 %0, %1, %2":"=v"(r):"v"(a),"v"(b));return r;}
typedef float f32x2_t __attribute__((ext_vector_type(2))); typedef __bf16 bf16x2_t __attribute__((ext_vector_type(2)));
__device__ __forceinline__ unsigned cvtpk_s(float lo,float hi){f32x2_t v={lo,hi};bf16x2_t b=__builtin_convertvector(v,bf16x2_t);return __builtin_bit_cast(unsigned,b);}
#define WAIT_BAR(N) asm volatile("s_waitcnt vmcnt(" #N ") lgkmcnt(0)\n\ts_barrier":::"memory")

__device__ __forceinline__ void qkt(f32x16&p0,f32x16&p1,const char*Kslot,const bf16x8*qr,const f32x16&negm,int r32,int hi){
  const char*kb=Kslot+hi*1024+r32*16;
  #pragma unroll
  for(int d0=0;d0<4;++d0){
    const bf16x8 b0=*reinterpret_cast<const bf16x8*>(kb+d0*2048);
    const bf16x8 b1=*reinterpret_cast<const bf16x8*>(kb+d0*2048+512);
    if(d0==0){p0=__builtin_amdgcn_mfma_f32_32x32x16_bf16(b0,qr[0],negm,0,0,0);p1=__builtin_amdgcn_mfma_f32_32x32x16_bf16(b1,qr[0],negm,0,0,0);}
    else{p0=__builtin_amdgcn_mfma_f32_32x32x16_bf16(b0,qr[d0],p0,0,0,0);p1=__builtin_amdgcn_mfma_f32_32x32x16_bf16(b1,qr[d0],p1,0,0,0);}}
}
typedef __attribute__((address_space(3))) const char* lds_cptr;
typedef short v4i16_t __attribute__((ext_vector_type(4)));
__device__ __forceinline__ void kload8(bf16x8*kf,lds_cptr kp){
  kf[0]=*(const __attribute__((address_space(3))) bf16x8*)(kp);      kf[1]=*(const __attribute__((address_space(3))) bf16x8*)(kp+512);
  kf[2]=*(const __attribute__((address_space(3))) bf16x8*)(kp+2048); kf[3]=*(const __attribute__((address_space(3))) bf16x8*)(kp+2560);
  kf[4]=*(const __attribute__((address_space(3))) bf16x8*)(kp+4096); kf[5]=*(const __attribute__((address_space(3))) bf16x8*)(kp+4608);
  kf[6]=*(const __attribute__((address_space(3))) bf16x8*)(kp+6144); kf[7]=*(const __attribute__((address_space(3))) bf16x8*)(kp+6656);
}
__device__ __forceinline__ void kload2(bf16x8*kf,lds_cptr kp,int j){ kf[2*j]=*(const __attribute__((address_space(3))) bf16x8*)(kp+j*2048); kf[2*j+1]=*(const __attribute__((address_space(3))) bf16x8*)(kp+j*2048+512); }
__device__ __forceinline__ s16x4 vtr(lds_cptr p){ return __builtin_bit_cast(s16x4,__builtin_amdgcn_ds_read_tr16_b64_v4i16((__attribute__((address_space(3))) v4i16_t*)p)); }
__device__ __forceinline__ float rowmax(const f32x16&p0,const f32x16&p1){
  float a=max3f(p0[0],p0[1],p1[0]),b=max3f(p0[2],p0[3],p1[1]);a=max3f(a,p1[2],p1[3]);
  #pragma unroll
  for(int r=4;r<16;r+=4){a=max3f(a,p0[r],p0[r+1]);b=max3f(b,p0[r+2],p0[r+3]);a=max3f(a,p1[r],p1[r+1]);b=max3f(b,p1[r+2],p1[r+3]);}
  const float m=max2f(a,b);
  auto rr=__builtin_amdgcn_permlane32_swap(__float_as_uint(m),__float_as_uint(m),false,false);
  return max2f(__uint_as_float(rr[0]),__uint_as_float(rr[1]));
}
__device__ __forceinline__ void pv(f32x16*o,int vb,bf16x8 pa0,bf16x8 pa1,bf16x8 pa2,bf16x8 pa3){
  #pragma unroll
  for(int d0=0;d0<2;++d0){s16x4 lo[4],hi[4];
    #pragma unroll
    for(int ks=0;ks<4;++ks){
      asm volatile("ds_read_b64_tr_b16 %0,%1 offset:%c2":"=&v"(lo[ks]):"v"(vb),"i"(d0*4096+ks*1024):"memory");
      asm volatile("ds_read_b64_tr_b16 %0,%1 offset:%c2":"=&v"(hi[ks]):"v"(vb),"i"(d0*4096+ks*1024+512):"memory");}
    asm volatile("s_waitcnt lgkmcnt(0)":::"memory");SBAR();
    #define PK(k) (bf16x8){lo[k][0],lo[k][1],lo[k][2],lo[k][3],hi[k][0],hi[k][1],hi[k][2],hi[k][3]}
    o[d0]=__builtin_amdgcn_mfma_f32_32x32x16_bf16(pa0,PK(0),o[d0],0,0,0);
    o[d0]=__builtin_amdgcn_mfma_f32_32x32x16_bf16(pa1,PK(1),o[d0],0,0,0);
    o[d0]=__builtin_amdgcn_mfma_f32_32x32x16_bf16(pa2,PK(2),o[d0],0,0,0);
    o[d0]=__builtin_amdgcn_mfma_f32_32x32x16_bf16(pa3,PK(3),o[d0],0,0,0);
    #undef PK
  }
}

template<int THRL> __device__ __forceinline__ void attn_unit(long qrow0,int is_meta,long kvbase,int NR,long metarow,int h,const bf16*Q,const bf16*__restrict__ K,const bf16*__restrict__ V,bf16*O,char*shm){
  int tid_=threadIdx.x; asm volatile("":"+v"(tid_)); const int tid=tid_,lane=tid&63,r32=lane&31,hi=lane>>5; const int wid=__builtin_amdgcn_readfirstlane(tid>>6);
  const long qrow_l=is_meta?(metarow+(long)(r32&15)):(qrow0+wid*QBLK+r32);
  const int h_l=is_meta?(h+2*(wid&1)+(r32>>4)):h;
  const bf16*Qw=Q+qrow_l*QP+h_l*D;
  const bf16*Kh=K+(h>>2)*D,*Vh=V+(h>>2)*D;
  const unsigned lds0=(unsigned)(uintptr_t)shm;
  float*wsf=(float*)(shm+LDS_WS)+wid*64;
  const bf16*ksrc=Kh+(long)lane*KP+wid*8;
  const bf16*vsrc=Vh+(long)(16*(wid&3)+(lane>>2))*KP+(wid>>2)*32+(lane&3)*8;
  #define TROW(t) (kvbase+(long)(t)*KVBLK)
  const unsigned kdst=lds0+LDS_K+wid*1024, vdst=lds0+LDS_V+wid*1024;
  #define DMA_K(t,slot) glds16(ksrc+TROW(t)*KP,(unsigned)__builtin_amdgcn_readfirstlane(kdst+(slot)))
  #define DMA_V(t,slot) glds16(vsrc+TROW(t)*KP,(unsigned)__builtin_amdgcn_readfirstlane(vdst+(slot)))
  const int vb0=(int)(lds0+LDS_V)+((lane>>4)&1)*32+(lane&3)*8+(4*hi+((lane&15)>>2))*64;
  const char*Kbase=shm+LDS_K; bf16x8 kf[8];
  const lds_cptr shm3=(lds_cptr)shm; const lds_cptr kp0=shm3+LDS_K+hi*1024+r32*16; const lds_cptr vp0=shm3+LDS_V+((lane>>4)&1)*32+(lane&3)*8+(4*hi+((lane&15)>>2))*64;
  const int NT=NR+2;
  DMA_K(0,0);DMA_V(0,0);DMA_K(1,SLOTB);
  bf16x8 qr[4];
  #pragma unroll
  for(int d0=0;d0<4;++d0)qr[d0]=*reinterpret_cast<const bf16x8*>(&Qw[d0*16+hi*8]);
  float mhat=0.f,l_reg=0.f;f32x16 o[2];o[0]=f32x16{};o[1]=f32x16{};f32x16 negm=f32x16{};asm volatile("":"+v"(negm));
  #define CMASK(P0,P1,t) do{ mmask(P0,P1,(t)>=NT-2,(t)==NT-1); }while(0)
  bool resc=false;
  #define START(P0,P1) do{ const float rm=rowmax(P0,P1); resc=false; \
    { const float dl=rm; mhat=fadd_s(mhat,dl); \
      _Pragma("unroll") for(int r=0;r<16;++r){P0[r]=fsub_s(P0[r],dl);P1[r]=fsub_s(P1[r],dl);} \
      _Pragma("unroll") for(int r=0;r<16;++r)negm[r]=-mhat; asm volatile("":"+v"(negm)); } \
    _Pragma("unroll") for(int r=0;r<16;++r)P0[r]=__builtin_amdgcn_exp2f(P0[r]); }while(0)
  #define RESC() do{ if(resc){ asm volatile("s_waitcnt lgkmcnt(0)":::"memory"); \
      _Pragma("unroll") for(int d_=0;d_<2;++d_) _Pragma("unroll") for(int r=0;r<16;++r)o[d_][r]*=wsf[crow(r,hi)]; } }while(0)
  f32x16 pA0,pA1,pB0,pB1;
  int sl_prev=0,sl_cur=0,sl_next=SLOTB;
  #define ROT() do{sl_prev=sl_cur;sl_cur=sl_next;sl_next=(sl_next==(NSLOT-1)*SLOTB)?0:sl_next+SLOTB;}while(0)
  DMA_K(2,2*SLOTB);
  WAIT_BAR(3);
  qkt(pA0,pA1,Kbase,qr,negm,r32,hi);asm volatile("s_nop 15\n\ts_nop 7":"+v"(pA0),"+v"(pA1));
  START(pA0,pA1);
  _Pragma("unroll") for(int r=0;r<16;++r)pA1[r]=__builtin_amdgcn_exp2f(pA1[r]);
  WAIT_BAR(0);
  DMA_K(3,0);DMA_V(1,SLOTB);
  ROT();
  kload8(kf,kp0+sl_cur);
  WAIT_BAR(2);
  s16x4 vlo[8],vhi[8]; u32x4 pw0,pw1,pw2,pw3;
  #define PKW(P,B) cvtpk_s(P[B],P[B+1])
  #define PAF(k) __builtin_bit_cast(bf16x8,pw##k)
  #define VFR(i) (bf16x8){vlo[i][0],vlo[i][1],vlo[i][2],vlo[i][3],vhi[i][0],vhi[i][1],vhi[i][2],vhi[i][3]}
  #define PIN(x) asm volatile("":"+v"(x))
  #define MX3(a,b,c) __builtin_fmaxf(__builtin_fmaxf((a),(b)),(c))
  #define GAPA(MF,A0,A1,A2,A3,W0,W1,PW) do{ MF; sacc+=A0; sacc+=A1; sacc+=A2; sacc+=A3; PIN(sacc); W0; W1; PIN(PW); SBAR(); }while(0)
  #define EX(v) __builtin_amdgcn_exp2f(v)
  #define GAPB(MF,X,B) do{ MF; X[B]=EX(X[B]); X[B+1]=EX(X[B+1]); X[B+2]=EX(X[B+2]); X[B+3]=EX(X[B+3]); PIN(X); SBAR(); }while(0)
  #define VRD(i) do{ vlo[i]=vtr(vp_+(((i)>>2)*4096+((i)&3)*1024)); vhi[i]=vtr(vp_+(((i)>>2)*4096+((i)&3)*1024+512)); }while(0)
  #define KRD(G,j) do{ if(G){ kload2(kf,kp0+sl_next,j); SBAR(); } }while(0)
  #define STEP(C0,C1,P0,P1,t,GK,GV,GL) do{ SBAR(); \
    const lds_cptr vp_=vp0+sl_prev; \
    VRD(0); SBAR(); float sacc=(P0[0]+P0[1]); \
    GAPA(C0=__builtin_amdgcn_mfma_f32_32x32x16_bf16(kf[0],qr[0],negm,0,0,0), P0[2],P0[3],P0[4],P0[5],     pw0[0]=PKW(P0,0), pw0[1]=PKW(P0,2), pw0); \
    VRD(4); SBAR(); GAPA(C1=__builtin_amdgcn_mfma_f32_32x32x16_bf16(kf[1],qr[0],negm,0,0,0), P0[6],P0[7],P0[8],P0[9],     pw0[2]=PKW(P0,4), pw0[3]=PKW(P0,6), pw0); \
    VRD(1); SBAR(); GAPA(C0=__builtin_amdgcn_mfma_f32_32x32x16_bf16(kf[2],qr[1],C0,0,0,0),   P0[10],P0[11],P0[12],P0[13], pw1[0]=PKW(P0,8), pw1[1]=PKW(P0,10), pw1); \
    VRD(5); SBAR(); GAPA(C1=__builtin_amdgcn_mfma_f32_32x32x16_bf16(kf[3],qr[1],C1,0,0,0),   P0[14],P0[15],P1[0],P1[1],   pw1[2]=PKW(P0,12),pw1[3]=PKW(P0,14), pw1); \
    VRD(2); SBAR(); GAPA(C0=__builtin_amdgcn_mfma_f32_32x32x16_bf16(kf[4],qr[2],C0,0,0,0),   P1[2],P1[3],P1[4],P1[5],     pw2[0]=PKW(P1,0), pw2[1]=PKW(P1,2), pw2); \
    VRD(6); SBAR(); GAPA(C1=__builtin_amdgcn_mfma_f32_32x32x16_bf16(kf[5],qr[2],C1,0,0,0),   P1[6],P1[7],P1[8],P1[9],     pw2[2]=PKW(P1,4), pw2[3]=PKW(P1,6), pw2); \
    VRD(3); SBAR(); GAPA(C0=__builtin_amdgcn_mfma_f32_32x32x16_bf16(kf[6],qr[3],C0,0,0,0),   P1[10],P1[11],P1[12],P1[13], pw3[0]=PKW(P1,8), pw3[1]=PKW(P1,10), pw3); \
    VRD(7); SBAR(); GAPA(C1=__builtin_amdgcn_mfma_f32_32x32x16_bf16(kf[7],qr[3],C1,0,0,0),   P1[14],P1[15],0.f,0.f,       pw3[2]=PKW(P1,12),pw3[3]=PKW(P1,14), pw3); \
    l_reg+=sacc; \
    if(GK){DMA_K((t)+3,sl_cur);} if(GV){DMA_V((t)+1,sl_next);} \
    CMASK(C0,C1,t); \
    { float a=MX3(C0[0],C0[1],C1[0]),b=MX3(C0[2],C0[3],C1[1]); a=MX3(a,C1[2],C1[3]); \
      _Pragma("unroll") for(int r=4;r<16;r+=4){a=MX3(a,C0[r],C0[r+1]);b=MX3(b,C0[r+2],C0[r+3]);a=MX3(a,C1[r],C1[r+1]);b=MX3(b,C1[r+2],C1[r+3]);} \
      float rm=__builtin_fmaxf(a,b); { auto rr=__builtin_amdgcn_permlane32_swap(__float_as_uint(rm),__float_as_uint(rm),false,false); rm=__builtin_fmaxf(__uint_as_float(rr[0]),__uint_as_float(rr[1])); } \
      resc=false; \
      if(__builtin_expect(__any(rm>(float)THRL),0)){ const float dl=__builtin_fmaxf(rm,0.f); mhat+=dl; \
        _Pragma("unroll") for(int r=0;r<16;++r){C0[r]-=dl;C1[r]-=dl;} \
        _Pragma("unroll") for(int r=0;r<16;++r)negm[r]=-mhat; asm volatile("":"+v"(negm)); \
        const float f=__builtin_amdgcn_exp2f(-dl); l_reg*=f; if(hi==0)wsf[r32]=f; resc=true; } } \
    SBAR(); \
    GAPB(o[0]=__builtin_amdgcn_mfma_f32_32x32x16_bf16(PAF(0),VFR(0),o[0],0,0,0), C0,0); \
    GAPB(o[1]=__builtin_amdgcn_mfma_f32_32x32x16_bf16(PAF(0),VFR(4),o[1],0,0,0), C0,4); \
    KRD(GL,0); GAPB(o[0]=__builtin_amdgcn_mfma_f32_32x32x16_bf16(PAF(1),VFR(1),o[0],0,0,0), C0,8); \
    KRD(GL,1); GAPB(o[1]=__builtin_amdgcn_mfma_f32_32x32x16_bf16(PAF(1),VFR(5),o[1],0,0,0), C0,12); \
    KRD(GL,2); GAPB(o[0]=__builtin_amdgcn_mfma_f32_32x32x16_bf16(PAF(2),VFR(2),o[0],0,0,0), C1,0); \
    KRD(GL,3); GAPB(o[1]=__builtin_amdgcn_mfma_f32_32x32x16_bf16(PAF(2),VFR(6),o[1],0,0,0), C1,4); \
    GAPB(o[0]=__builtin_amdgcn_mfma_f32_32x32x16_bf16(PAF(3),VFR(3),o[0],0,0,0), C1,8); \
    GAPB(o[1]=__builtin_amdgcn_mfma_f32_32x32x16_bf16(PAF(3),VFR(7),o[1],0,0,0), C1,12); \
    }while(0)
  int t=1;
  #undef CMASK
  #define CMASK(P0,P1,t) do{}while(0)
  for(;t+5<NT;t+=2){
    STEP(pB0,pB1,pA0,pA1,t,true,true,true);     WAIT_BAR(2); RESC(); ROT();
    STEP(pA0,pA1,pB0,pB1,t+1,true,true,true);   WAIT_BAR(2); RESC(); ROT();
  }
  #undef CMASK
  #define CMASK(P0,P1,t) do{ mmask(P0,P1,(t)>=NT-2,(t)==NT-1); }while(0)
  #define ENDW(tt) do{ if((tt)+3<NT){WAIT_BAR(2);} else if((tt)+2<NT){WAIT_BAR(1);} else {WAIT_BAR(0);} }while(0)
  for(;t+1<NT;t+=2){
    STEP(pB0,pB1,pA0,pA1,t,(t+3<NT),(t+1<NT),(t+1<NT));       ENDW(t);   RESC(); ROT();
    STEP(pA0,pA1,pB0,pB1,t+1,(t+4<NT),(t+2<NT),(t+2<NT));     ENDW(t+1); RESC(); ROT();
  }
  STEP(pB0,pB1,pA0,pA1,NT-1,false,false,false); RESC();
  { float sacc=pB0[0]+pB0[1]; _Pragma("unroll") for(int r=2;r<16;++r)sacc+=pB0[r]; _Pragma("unroll") for(int r=0;r<16;++r)sacc+=pB1[r]; l_reg+=sacc;
    pw0=(u32x4){PKW(pB0,0),PKW(pB0,2),PKW(pB0,4),PKW(pB0,6)};pw1=(u32x4){PKW(pB0,8),PKW(pB0,10),PKW(pB0,12),PKW(pB0,14)};pw2=(u32x4){PKW(pB1,0),PKW(pB1,2),PKW(pB1,4),PKW(pB1,6)};pw3=(u32x4){PKW(pB1,8),PKW(pB1,10),PKW(pB1,12),PKW(pB1,14)};
    SBAR(); pv(o,vb0+sl_cur,PAF(0),PAF(1),PAF(2),PAF(3)); }
  #undef PKW
  #undef PAF
  #undef VFR
  #undef PIN
  #undef MX3
  #undef GAPA
  #undef GAPB
  #undef EX
  #undef VRD
  #undef KRD
  #undef STEP
  #undef ENDW
  {auto rr=__builtin_amdgcn_permlane32_swap(__float_as_uint(l_reg),__float_as_uint(l_reg),false,false);l_reg=__uint_as_float(rr[0])+__uint_as_float(rr[1]);}
  if(hi==0)wsf[32+r32]=l_reg;asm volatile("s_waitcnt lgkmcnt(0)":::"memory");
  float rli[16];
  #pragma unroll
  for(int r=0;r<16;++r)rli[r]=__builtin_amdgcn_rcpf(wsf[32+crow(r,hi)]);
  { bf16*stg=(bf16*)(shm+LDS_OST)+wid*2048;
    #pragma unroll
    for(int r=0;r<16;++r){const int orow=crow(r,hi);
      #pragma unroll
      for(int d0=0;d0<2;++d0)stg[orow*64+d0*32+r32]=__float2bfloat16(o[d0][r]*rli[r]);}
    asm volatile("s_waitcnt lgkmcnt(0)":::"memory");
    #pragma unroll
    for(int i=0;i<4;++i){const int row=i*8+(lane>>3),ch=lane&7; const u32x4 w=*(const u32x4*)(stg+row*64+ch*8);
      float x[8];
      #pragma unroll
      for(int e=0;e<4;++e){x[2*e]=__uint_as_float(w[e]<<16); x[2*e+1]=__uint_as_float(w[e]&0xffff0000u);}
      float ss=((x[0]*x[0]+x[1]*x[1])+(x[2]*x[2]+x[3]*x[3]))+((x[4]*x[4]+x[5]*x[5])+(x[6]*x[6]+x[7]*x[7]));
      ss+=__shfl_xor(ss,1); ss+=__shfl_xor(ss,2); ss+=__shfl_xor(ss,4);
      const float rn=rsqrtf(ss*(1.0f/64.0f)+1e-6f);
      u32x4 v; v.x=cvtpk_s(x[0]*rn,x[1]*rn); v.y=cvtpk_s(x[2]*rn,x[3]*rn); v.z=cvtpk_s(x[4]*rn,x[5]*rn); v.w=cvtpk_s(x[6]*rn,x[7]*rn);
      const long orow_g=is_meta?(metarow+(row&15)):(qrow0+wid*QBLK+row);
      const int h_o=is_meta?(h+2*wid+(row>>4)):h;
      const bool ok=(!is_meta)||(wid<2);
      if(ok) ATTN_STORE16(O+orow_g*OP+h_o*D+ch*8,v);} }
  asm volatile("s_waitcnt lgkmcnt(0)\n\ts_barrier":::"memory");
  #undef DMA_K
  #undef TROW
  #undef DMA_V
  #undef CMASK
  #undef START
  #undef RESC
  #undef ROT
}
constexpr int ATTN_LDS_BYTES=LDS_BYTES;
#undef SBAR
#undef WAIT_BAR
}

constexpr int NWAVES = 8;
constexpr int DM = 1024, DFF = 2816, NIN = 2304, DEPTH = 4;
constexpr int NREAL = 81920, MB = 81920, MP = 82688;
constexpr int NSEQ = 12;
constexpr size_t MiB = 1u << 20;
constexpr size_t WS_CTL = 0, WS_ROPE = 65536, WS_STATS = 131072, WS_W = 6 * MiB, WS_H = 165 * MiB, WS_BIG = 327 * MiB;
constexpr size_t WS_END = WS_BIG + (size_t)MP * 2816 * 2;
constexpr size_t W_GU = (size_t)2 * DFF * DM, W_D = (size_t)DM * DFF, W_IN = (size_t)NIN * DM, W_OUT = (size_t)DM * DM;
constexpr size_t WL_1GU = 0, WL_1D = WL_1GU + W_GU, WL_IN = WL_1D + W_D, WL_OUT = WL_IN + W_IN, WL_2GU = WL_OUT + W_OUT, WL_2D = WL_2GU + W_GU, WL_SZ = WL_2D + W_D;
static_assert(WS_STATS + (size_t)MP * 16 * 4 <= WS_W && WS_W + WL_SZ * 2 * DEPTH <= WS_H && WS_H + (size_t)MP * DM * 2 <= WS_BIG, "ws map");
constexpr int CTL_WORDS = 16384, CW_BAR = 4096;
constexpr int RING_BYTES = 131072, LDS_BYTES = 147456;
static_assert(attn_body::ATTN_LDS_BYTES <= RING_BYTES, "attention LDS");

#define LAS __attribute__((address_space(3)))
typedef unsigned short bf16;
typedef unsigned v4u __attribute__((ext_vector_type(4)));
typedef float f32x4 __attribute__((ext_vector_type(4)));
__device__ __forceinline__ unsigned f2bf(float f) { unsigned u = __builtin_bit_cast(unsigned, f); return (u + 0x7fffu + ((u >> 16) & 1u)) >> 16; }
__device__ __forceinline__ unsigned pk2(float lo, float hi) { return f2bf(lo) | (f2bf(hi) << 16); }
__device__ __forceinline__ float bflo(unsigned w) { return __builtin_bit_cast(float, w << 16); }
__device__ __forceinline__ float bfhi(unsigned w) { return __builtin_bit_cast(float, w & 0xffff0000u); }
__device__ __forceinline__ float wave_sum(float v) {
#pragma unroll
    for (int o = 1; o < 64; o <<= 1) v += __shfl_xor(v, o);
    return v;
}
__device__ __forceinline__ void tr_item(const float* W, int K, int N, const float* gain, bf16* WT, int drow0, LAS float* scr, int k0, int n0, int lane) {
#pragma unroll 16
    for (int i = 0; i < 32; ++i) { const int kk = 2 * i + (lane >> 5); const float g = gain ? gain[k0 + kk] : 1.0f; scr[kk * 33 + (lane & 31)] = g * W[(size_t)(k0 + kk) * N + n0 + (lane & 31)]; }
    asm volatile("s_waitcnt lgkmcnt(0)" ::: "memory");
    const int c = lane & 7;
#pragma unroll
    for (int j = 0; j < 4; ++j) { const int n = (lane >> 3) + 8 * j; const LAS float* s = scr + (8 * c) * 33 + n;
        v4u o; o.x = pk2(s[0 * 33], s[1 * 33]); o.y = pk2(s[2 * 33], s[3 * 33]); o.z = pk2(s[4 * 33], s[5 * 33]); o.w = pk2(s[6 * 33], s[7 * 33]);
        *(v4u*)(WT + (size_t)(drow0 + n) * K + k0 + 8 * c) = o; }
    asm volatile("s_waitcnt lgkmcnt(0)" ::: "memory");
}
__device__ __forceinline__ int win_drow(int n0) {
    if (n0 < 1280) { const int hd = n0 >> 6, bj = (n0 >> 5) & 1; return 256 * (hd >> 2) + 128 * bj + 32 * (hd & 3); }
    if (n0 < 1792) { const int t = (n0 - 1280) >> 7, w = (n0 - 1280) & 127; return 1280 + 256 * t + w; }
    { const int t = (n0 - 1792) >> 7, w = (n0 - 1792) & 127; return 1280 + 256 * t + 128 + w; }
}
__device__ __forceinline__ long seq_base(int q) { return q < 4 ? 4096L * q : 16384L + 8192L * (q - 4); }

#define GAS __attribute__((address_space(1)))
#define XB_TMO      128
#define XB_XCNT(j)  (256  + 64 * (j))
#define XB_XSUB(j)  (1280 + 64 * (j))
#define XB_XGEN(j)  (2304 + 64 * (j))
#define XB_TOP      3328
#define XB_TOPGEN   3392
#define XCD_BAR_WORDS 3456
#define XB_SPIN_CAP (1u << 18)

__device__ __forceinline__ unsigned xb_ld(unsigned* p)              { return __hip_atomic_load(p, __ATOMIC_RELAXED, __HIP_MEMORY_SCOPE_AGENT); }
__device__ __forceinline__ unsigned xb_add(unsigned* p, unsigned v) { return __hip_atomic_fetch_add(p, v, __ATOMIC_RELAXED, __HIP_MEMORY_SCOPE_AGENT); }
__device__ __forceinline__ unsigned xb_xcc_id() { return (unsigned)__builtin_amdgcn_s_getreg((3 << 11) | 20) & 0xFu; }
#define XB_SPIN(cond, bar) do { unsigned _sp = 0; while (cond) { __builtin_amdgcn_s_sleep(1); \
    if ((++_sp & 255u) == 0u) { if (xb_ld(&(bar)[XB_TMO])) break; if (_sp > XB_SPIN_CAP) { atomicAdd(&(bar)[XB_TMO], 1u); break; } } } } while (0)

struct XcdBarrier {
    unsigned* bar; unsigned x;
    volatile LAS unsigned* st;
};

__device__ __forceinline__ XcdBarrier xcd_barrier_post(unsigned* bar, volatile LAS unsigned* st) {
    XcdBarrier b; b.bar = bar; b.x = xb_xcc_id(); b.st = st;
    if (threadIdx.x == 0) (void)xb_add(&bar[XB_XCNT(b.x)], 1u);
    return b;
}
__device__ __forceinline__ void xcd_barrier_complete(unsigned* bar, unsigned x, unsigned& nloc, unsigned& nx) {
    const unsigned G = gridDim.x * gridDim.y * gridDim.z;
    unsigned sum, cnt, mine, sp = 0u;
    for (;;) {
        sum = 0u; cnt = 0u; mine = 0u;
#pragma unroll
        for (unsigned j = 0; j < 16; ++j) { const unsigned c = xb_ld(&bar[XB_XCNT(j)]); sum += c; cnt += (c > 0u) ? 1u : 0u; mine = (j == x) ? c : mine; }
        if (sum == G) break;
        __builtin_amdgcn_s_sleep(1);
        if ((++sp & 255u) == 0u) { if (xb_ld(&bar[XB_TMO])) break; if (sp > XB_SPIN_CAP) { atomicAdd(&bar[XB_TMO], 1u); break; } }
    }
    nloc = mine > 0u ? mine : 1u; nx = cnt > 0u ? cnt : 1u;
}

__device__ __forceinline__ void xcd_barrier(const XcdBarrier& b) {
    asm volatile("s_waitcnt vmcnt(0)" ::: "memory");
    __syncthreads();
    if (threadIdx.x == 0) {
        unsigned* bar = b.bar;
        __builtin_amdgcn_s_waitcnt(0);
        unsigned nloc = b.st[0], nx = b.st[1];
        if (nloc == 0u) { xcd_barrier_complete(bar, b.x, nloc, nx); b.st[0] = nloc; b.st[1] = nx; }
        const unsigned old = xb_add(&bar[XB_XSUB(b.x)], 1u);
        const unsigned gen = old / nloc;
        if (old + 1u == (gen + 1u) * nloc) {
            __builtin_amdgcn_fence(__ATOMIC_RELEASE, "agent");
            asm volatile("s_waitcnt vmcnt(0)" ::: "memory");
            const unsigned og = xb_add(&bar[XB_TOP], 1u);
            const unsigned tg = og / nx;
            if (og + 1u == (tg + 1u) * nx) xb_add(&bar[XB_TOPGEN], 1u);
            else XB_SPIN(xb_ld(&bar[XB_TOPGEN]) == tg, bar);
            __builtin_amdgcn_fence(__ATOMIC_ACQUIRE, "agent");
            xb_add(&bar[XB_XGEN(b.x)], 1u);
            asm volatile("s_waitcnt vmcnt(0)" ::: "memory");
        } else {
            XB_SPIN(xb_ld(&bar[XB_XGEN(b.x)]) == gen, bar);
            __builtin_amdgcn_fence(__ATOMIC_ACQUIRE, "agent");
            asm volatile("s_waitcnt vmcnt(0)" ::: "memory");
        }
    }
    __syncthreads();
}

static_assert(CW_BAR + XCD_BAR_WORDS <= CTL_WORDS && CTL_WORDS * 4 <= (int)WS_ROPE, "ctl map");

struct Args { const float* in[21]; float* out; unsigned char* ws; };

#define CONVERT_LAYER(LC, W0, NW) do { const int lc__ = (LC), w0__ = (W0), nw__ = (NW); { const int l = lc__; LAS float* scr = (LAS float*)(ldsp + wave * 16384); \
        constexpr int I_GU = 16 * 88, I_D = 44 * 32, I_IN = 16 * 72, I_OUT = 16 * 32, I_L = 4 * I_GU + 2 * I_D + I_IN + I_OUT; \
        for (int it = w0__; it < I_L; it += nw__) { \
            int r = it; bf16* WL = Wb + (size_t)l * WL_SZ; \
            if (r < 4 * I_GU) { const int which = r / I_GU; r %= I_GU; const int kb = r / 88, nb = r % 88, n0 = 32 * nb; \
                const float* W = args.in[(which < 2 ? 4 : 17) + (which & 1)] + (size_t)l * DM * DFF; const float* gn = args.in[which < 2 ? 3 : 16] + l * DM; \
                tr_item(W, DM, DFF, gn, WL + (which < 2 ? WL_1GU : WL_2GU), 256 * (n0 >> 7) + (n0 & 127) + ((which & 1) ? 128 : 0), scr, 64 * kb, n0, lane); continue; } \
            r -= 4 * I_GU; \
            if (r < 2 * I_D) { const int which = r / I_D; r %= I_D; const int kb = r / 32, nb = r % 32; \
                tr_item(args.in[which ? 19 : 6] + (size_t)l * DFF * DM, DFF, DM, nullptr, WL + (which ? WL_2D : WL_1D), 32 * nb, scr, 64 * kb, 32 * nb, lane); continue; } \
            r -= 2 * I_D; \
            if (r < I_IN) { const int kb = r / 72, nb = r % 72; \
                tr_item(args.in[8] + (size_t)l * DM * NIN, DM, NIN, args.in[7] + l * DM, WL + WL_IN, win_drow(32 * nb), scr, 64 * kb, 32 * nb, lane); continue; } \
            r -= I_IN; \
            { const int kb = r / 32, nb = r % 32; const int k0 = 64 * kb; \
              const float* gn = (k0 < 512) ? (args.in[13] + l * 512 + 0) : (args.in[14] + l * 512 - 512); \
              tr_item(args.in[15] + (size_t)l * DM * DM, DM, DM, gn, WL + WL_OUT, 32 * nb, scr, k0, 32 * nb, lane); } \
        } } } while (0)
__global__ void __launch_bounds__(NWAVES * 64, 2) hymba_fwd(Args args) {
    extern __shared__ __attribute__((aligned(16))) unsigned char lds[];
    cg::grid_group grid = cg::this_grid();
    const int tid = threadIdx.x, lane0 = tid & 63, wave = __builtin_amdgcn_readfirstlane(tid >> 6);
    const int G = gridDim.x, bx = blockIdx.x;
    const int gw = bx * NWAVES + wave, NGW = G * NWAVES;
    unsigned char* ws = args.ws;
    unsigned* ctl = (unsigned*)(ws + WS_CTL);
    float* rope = (float*)(ws + WS_ROPE);
    float* stats = (float*)(ws + WS_STATS);
    bf16* Wb = (bf16*)(ws + WS_W);
    bf16* HB = (bf16*)(ws + WS_H);
    bf16* BIG = (bf16*)(ws + WS_BIG);
    bf16* ACT = BIG;
    bf16* Qb = BIG; bf16* Kb = BIG + (size_t)MP * 512; bf16* Vb = BIG + (size_t)MP * 640; bf16* CBb = BIG + (size_t)MP * 768; bf16* Ub = BIG + (size_t)MP * 1280; bf16* Yb = BIG + (size_t)MP * 1792;
    LAS unsigned char* ldsp = (LAS unsigned char*)lds;
    const float* x_prompt = args.in[0]; const float* x_sample = args.in[1]; const float* meta = args.in[2];

    {
        const int lane = lane0;
        for (int i = bx * (NWAVES * 64) + tid; i < CTL_WORDS; i += G * NWAVES * 64) ctl[i] = 0u;
        if (tid < 2) ((LAS unsigned*)(ldsp + RING_BYTES + 128))[tid] = 0u;
        { const int gt = bx * (NWAVES * 64) + tid;
          if (gt < 2048) { const int pos = gt >> 4, i = gt & 15; const double fr = exp2(-(double)i * (13.287712379549449 / 16.0)); double s, c; sincos((double)pos * fr, &s, &c); rope[2 * gt] = (float)c; rope[2 * gt + 1] = (float)s; } }
        CONVERT_LAYER(0, gw, NGW);
        for (int row0 = gw; row0 < MP; row0 += 2 * NGW) {
            f32x4 v[2][4]; float ss[2]; const int rows[2] = {row0, row0 + NGW};
#pragma unroll
            for (int r = 0; r < 2; ++r) { const int row = rows[r]; const float* src = nullptr;
                if (row < 16384) src = x_prompt + (size_t)row * DM; else if (row < NREAL) src = x_sample + (size_t)(row - 16384) * DM;
                else if (row < MP) { const int i = (row - MB) & 63; if (i < 16) src = meta + (size_t)i * DM; }
#pragma unroll
                for (int j = 0; j < 4; ++j) v[r][j] = src ? ((const f32x4*)src)[lane + 64 * j] : (f32x4){0.f, 0.f, 0.f, 0.f}; }
#pragma unroll
            for (int r = 0; r < 2; ++r) { float s = 0.f;
#pragma unroll
                for (int j = 0; j < 4; ++j) s += (v[r][j][0] * v[r][j][0] + v[r][j][1] * v[r][j][1]) + (v[r][j][2] * v[r][j][2] + v[r][j][3] * v[r][j][3]);
                ss[r] = wave_sum(s); }
#pragma unroll
            for (int r = 0; r < 2; ++r) { const int row = rows[r]; if (row < MP) {
#pragma unroll
                for (int j = 0; j < 4; ++j)
                    ((unsigned long long*)(HB + (size_t)row * DM))[lane + 64 * j] = (unsigned long long)pk2(v[r][j][0], v[r][j][1]) | ((unsigned long long)pk2(v[r][j][2], v[r][j][3]) << 32);
                if (lane < 16) stats[(size_t)row * 16 + lane] = (lane == 0) ? ss[r] : 0.f; } }
        }
    }
    grid.sync();
    const XcdBarrier xbar = xcd_barrier_post(ctl + CW_BAR, (volatile LAS unsigned*)(ldsp + RING_BYTES + 128));

    for (int l = 0; l < DEPTH; ++l) {
        const bf16* WL = Wb + (size_t)l * WL_SZ;
        for (int s = 0; s < 2; ++s) {
            if (s == 1) {
#ifndef NO_WIN
                { pg8::Gemm g{HB, WL + WL_IN, MP, NIN, DM}; pg8::StaticOrder S; S.init(MP, NIN, G, bx);
                  pg8::EpiWin E{Qb, Kb, Vb, CBb, Ub, stats, args.in[9] + l * 64, args.in[10] + l * 64, rope};
                  pg8::gemm_phase<pg8::EpiWin, pg8::StaticOrder, true, true>(ldsp, g, S, E); }
#endif

                xcd_barrier(xbar);
                {
                    int lane = lane0; asm volatile("" : "+v"(lane));
                    const float* cw = args.in[11] + (size_t)l * 3 * 512; const float* cbias = args.in[12] + (size_t)l * 512;
                    LAS volatile unsigned* qslot = (LAS volatile unsigned*)(ldsp + RING_BYTES);
                    constexpr int UPG_S = 4 * 32 + 1, UPG_P = 4 * 16 + 1, NU_S = 8 * 2 * UPG_S, NU_P = 4 * 2 * UPG_P, NU = NU_S + NU_P, NCH = MP / 64;
                    for (;;) {
                        if (tid == 0) qslot[0] = atomicAdd(ctl + l, 1u);
                        __syncthreads();
                        const int idx = __builtin_amdgcn_readfirstlane((int)qslot[0]);
                        if (idx >= NU + NCH) break;
                        if (idx < NU) {
                            int q, rem, nqb;
                            if (idx < NU_S) { q = 4 + idx / (2 * UPG_S); rem = idx % (2 * UPG_S); nqb = 32; } else { const int i2 = idx - NU_S; q = i2 / (2 * UPG_P); rem = i2 % (2 * UPG_P); nqb = 16; }
                            const int upg = 4 * nqb + 1, kvg = rem / upg, r2 = rem % upg;
                            const int is_meta = (r2 == 4 * nqb) ? 1 : 0, h = is_meta ? 4 * kvg : 4 * kvg + r2 / nqb, b = is_meta ? 0 : r2 % nqb;
                            const long sb = seq_base(q);
#ifndef NO_ATT
                            attn_body::attn_unit<8>(sb + 256L * b, is_meta, sb + 64L * q, nqb * 4, (long)(MB + 64 * q), h,
                                (const attn_body::bf16*)Qb, (const attn_body::bf16*)Kb, (const attn_body::bf16*)Vb, (attn_body::bf16*)Yb, (char*)lds);
#endif
                        } else {
                            f32x4 w0[2], w1[2], w2[2], bb[2];
#pragma unroll
                            for (int j = 0; j < 2; ++j) { w0[j] = *(const f32x4*)(cw + 8 * lane + 4 * j); w1[j] = *(const f32x4*)(cw + 512 + 8 * lane + 4 * j); w2[j] = *(const f32x4*)(cw + 1024 + 8 * lane + 4 * j); bb[j] = *(const f32x4*)(cbias + 8 * lane + 4 * j); }
                            const int rbase = (idx - NU) * 64 + wave * 8;
                            for (int rr = 0; rr < 8; ++rr) {
                                const int row = rbase + rr;
                                long prev = -1, next = -1; bool valid = true;
                                if (row < NREAL) { const int q = row < 16384 ? (row >> 12) : 4 + ((row - 16384) >> 13); const int nlen = row < 16384 ? 4096 : 8192; const int n = row & (nlen - 1);
                                    prev = (n == 0) ? (long)(MB + 64 * q + 15) : (long)row - 1; next = (n == nlen - 1) ? -1L : (long)row + 1; }
                                else { const int q = (row - MB) >> 6, i = (row - MB) & 63; valid = i < 16; prev = (i == 0) ? -1L : (long)row - 1; next = (i == 15) ? seq_base(q) : (long)row + 1; }
                                v4u* yo = (v4u*)(Yb + (size_t)row * 1024 + 512) + lane;
                                if (!valid) { *yo = (v4u){0u, 0u, 0u, 0u}; *((v4u*)(Yb + (size_t)row * 1024) + lane) = (v4u){0u, 0u, 0u, 0u}; continue; }
                                const v4u uc = *((const v4u*)(Ub + (size_t)row * 512) + lane);
                                const v4u up = prev >= 0 ? *((const v4u*)(Ub + (size_t)prev * 512) + lane) : (v4u){0u, 0u, 0u, 0u};
                                const v4u un = next >= 0 ? *((const v4u*)(Ub + (size_t)next * 512) + lane) : (v4u){0u, 0u, 0u, 0u};
                                const v4u cbv = *((const v4u*)(CBb + (size_t)row * 512) + lane);
                                float y[8]; float ss = 0.f;
#pragma unroll
                                for (int e = 0; e < 8; ++e) { const int wi = e >> 1; const bool hi_ = e & 1;
                                    const float a = hi_ ? bfhi(up[wi]) : bflo(up[wi]), b = hi_ ? bfhi(uc[wi]) : bflo(uc[wi]), c = hi_ ? bfhi(un[wi]) : bflo(un[wi]), d = hi_ ? bfhi(cbv[wi]) : bflo(cbv[wi]);
                                    const float t = a * w0[e >> 2][e & 3] + b * w1[e >> 2][e & 3] + c * w2[e >> 2][e & 3] + bb[e >> 2][e & 3];
                                    y[e] = d * t; ss += y[e] * y[e]; }
                                ss += __shfl_xor(ss, 1); ss += __shfl_xor(ss, 2); ss += __shfl_xor(ss, 4);
                                const float rn = rsqrtf(ss * (1.0f / 64.0f) + 1e-6f);
                                v4u o; o.x = pk2(y[0] * rn, y[1] * rn); o.y = pk2(y[2] * rn, y[3] * rn); o.z = pk2(y[4] * rn, y[5] * rn); o.w = pk2(y[6] * rn, y[7] * rn);
                                *yo = o;
                            }
                            __syncthreads();
                        }
                    }
                }
                xcd_barrier(xbar);
#ifndef NO_WOUT
                { const int Mr = (l == DEPTH - 1) ? NREAL : MP; pg8::Gemm g{Yb, WL + WL_OUT, Mr, DM, DM}; pg8::StaticOrder S; S.init(Mr, DM, G, bx);
                  pg8::EpiResid E{HB, stats, 1.0f};
                  pg8::gemm_phase<pg8::EpiResid, pg8::StaticOrder, true, true>(ldsp, g, S, E); }
#endif

                xcd_barrier(xbar);
            }
#ifndef NO_GU
            { const int Mr = (l == DEPTH - 1 && s == 1) ? NREAL : MP; pg8::Gemm g{HB, WL + (s ? WL_2GU : WL_1GU), Mr, 2 * DFF, DM}; pg8::StaticOrder S; S.init(Mr, 2 * DFF, G, bx);
              pg8::EpiGateUp E{ACT, stats, DFF};
              pg8::gemm_phase<pg8::EpiGateUp, pg8::StaticOrder, true, true>(ldsp, g, S, E); }
#endif

            xcd_barrier(xbar);
#ifndef NO_DOWN
            { const int Mr = (l == DEPTH - 1 && s == 1) ? NREAL : MP; pg8::Gemm g{ACT, WL + (s ? WL_2D : WL_1D), Mr, DM, DFF}; pg8::StaticOrder S; S.init(Mr, DM, G, bx);
              pg8::EpiResid E{HB, stats, 0.5f};
              pg8::gemm_phase<pg8::EpiResid, pg8::StaticOrder, true, true>(ldsp, g, S, E);
              if (s == 0 && l + 1 < DEPTH) {
                  const int extra = S.nwg % G, first = extra ? extra : 0;
                  if (bx >= first) { int lane = lane0; asm volatile("" : "+v"(lane)); CONVERT_LAYER(l + 1, (bx - first) * NWAVES + wave, (G - first) * NWAVES); } } }
#endif

            xcd_barrier(xbar);
        }
    }
    {
        int lane = lane0; asm volatile("" : "+v"(lane));
        const float* fn = args.in[20]; f32x4 gnv[4];
#pragma unroll
        for (int j = 0; j < 4; ++j) gnv[j] = ((const f32x4*)fn)[lane + 64 * j];
        for (int row0 = gw; row0 < NREAL; row0 += 2 * NGW) {
            unsigned long long w[2][4];
#pragma unroll
            for (int r = 0; r < 2; ++r) { const int row = row0 + r * NGW < NREAL ? row0 + r * NGW : row0;
#pragma unroll
                for (int j = 0; j < 4; ++j) w[r][j] = ((const unsigned long long*)(HB + (size_t)row * DM))[lane + 64 * j]; }
#pragma unroll
            for (int r = 0; r < 2; ++r) { const int row = row0 + r * NGW; f32x4 v[4]; float ss = 0.f;
#pragma unroll
                for (int j = 0; j < 4; ++j) { const unsigned lo = (unsigned)w[r][j], hi = (unsigned)(w[r][j] >> 32);
                    v[j][0] = bflo(lo); v[j][1] = bfhi(lo); v[j][2] = bflo(hi); v[j][3] = bfhi(hi); ss += (v[j][0] * v[j][0] + v[j][1] * v[j][1]) + (v[j][2] * v[j][2] + v[j][3] * v[j][3]); }
                const float rs = rsqrtf(wave_sum(ss) * (1.0f / 1024.0f) + 1e-6f);
                if (row < NREAL) {
#pragma unroll
                    for (int j = 0; j < 4; ++j) ((f32x4*)(args.out + (size_t)row * DM))[lane + 64 * j] = v[j] * rs * gnv[j]; } }
        }
    }
}

extern "C" void kernel_launch(void* const* d_in, const int* in_sizes, int n_in, void* d_out, int out_size, void* d_ws, size_t ws_size, hipStream_t stream) {
    static int grid = 0;
    if (grid == 0) {
        if (n_in != 21 || out_size != NREAL * DM || ws_size < WS_END || in_sizes[8] != DEPTH * DM * NIN) {
            fprintf(stderr, "kernel_launch: unexpected shapes: n_in %d out %d ws %zu (need %zu) w_in %d\n", n_in, out_size, ws_size, (size_t)WS_END, n_in > 8 ? in_sizes[8] : -1); grid = -1; return; }
        int dev = 0, cus = 0, per_cu = 0;
        (void)hipGetDevice(&dev); (void)hipDeviceGetAttribute(&cus, hipDeviceAttributeMultiprocessorCount, dev);
        if (hipFuncSetAttribute((const void*)hymba_fwd, hipFuncAttributeMaxDynamicSharedMemorySize, LDS_BYTES) != hipSuccess) { fprintf(stderr, "kernel_launch: hipFuncSetAttribute failed\n"); grid = -1; return; }
        (void)hipOccupancyMaxActiveBlocksPerMultiprocessor(&per_cu, (const void*)hymba_fwd, NWAVES * 64, LDS_BYTES);
        if (per_cu < 1) { fprintf(stderr, "kernel_launch: occupancy query says %d blocks per CU\n", per_cu); per_cu = 1; }
        (void)hipGetLastError();
        grid = cus;
    }
    if (grid < 0) return;
    Args a{};
    for (int i = 0; i < 21; ++i) a.in[i] = (const float*)d_in[i];
    a.out = (float*)d_out; a.ws = (unsigned char*)d_ws;
    void* kargs[] = {&a};
    hipError_t e = hipLaunchCooperativeKernel((const void*)hymba_fwd, dim3(grid), dim3(NWAVES * 64), kargs, LDS_BYTES, stream);
    if (e != hipSuccess) fprintf(stderr, "cooperative launch failed: %s (grid %d)\n", hipGetErrorString(e), grid);
}
```

```cpp
#include <hip/hip_runtime.h>
#include <hip/hip_cooperative_groups.h>
#include <hip/hip_bf16.h>
#include <cstdio>
#include <cstdint>
#include <cmath>
namespace cg = cooperative_groups;
namespace pg8 {
#define PG8_LAS __attribute__((address_space(3)))
typedef unsigned short bf16_t;
typedef short bf16x8 __attribute__((ext_vector_type(8)));
typedef float f32x4 __attribute__((ext_vector_type(4)));
typedef unsigned u32x4 __attribute__((ext_vector_type(4)));
constexpr int BM = 256, BK = 64, HALF = 128, HTB = HALF * BK * 2  , STAGE_BYTES = 8 * HTB, NXCD = 8, WGM = 8;

__host__ __device__ __forceinline__ int lds_byte(int r, int c) { const int st = (r >> 4) * 2 + (c >> 5), rr = r & 15, cc = c & 31, ob = rr * 64 + cc * 2; return st * 1024 + (ob ^ (((ob >> 9) & 1) << 5)); }
__host__ __device__ __forceinline__ void stage_rc(int b, int& R, int& C) { const int st = b / 1024, sb = b % 1024, swz = sb ^ (((sb >> 9) & 1) << 5); R = (st >> 1) * 16 + swz / 64; C = (st & 1) * 32 + (swz % 64) / 2; }
__host__ __device__ __forceinline__ int perm32(int rho) { const int n = rho >> 4, i = rho & 15; return 8 * (i >> 2) + 4 * n + (i & 3); }

struct Unit { int pm, pn; };
struct Gemm { const bf16_t* A; const bf16_t* Bt; int M, N, K; };

struct StaticOrder {
    int nM, nN, nwg, G, c;
    __host__ __device__ void init(int M, int N, int G_, int c_) { nM = M / BM; nN = N / BM; nwg = nM * nN; G = G_; c = c_; }
    __host__ __device__ bool next(int i, Unit& u) const {
        const long L = (long)i * G + c; if (L >= nwg) return false;
        int wgid = (int)L; { const int q = nwg / NXCD, r = nwg % NXCD, xcd = wgid % NXCD, off = wgid / NXCD; wgid = (xcd < r ? xcd * (q + 1) : r * (q + 1) + (xcd - r) * q) + off; }
        const int nig = WGM * nN, gid = wgid / nig, fm = gid * WGM, gsz = (nM - fm) < WGM ? (nM - fm) : WGM;
        u.pm = fm + ((wgid % nig) % gsz); u.pn = (wgid % nig) / gsz; return true;
    }
    __device__ __forceinline__ void a_ready(const Unit&) const {}
    __device__ __forceinline__ void done(const Unit&) const {}
};

__device__ __forceinline__ unsigned cvt_pk_bf16(float lo, float hi) { unsigned r; asm volatile("v_cvt_pk_bf16_f32 %0, %1, %2" : "=v"(r) : "v"(lo), "v"(hi)); return r; }
constexpr float RMS_EPS = 1e-6f;
typedef float f32x2 __attribute__((ext_vector_type(2)));
__device__ __forceinline__ float sum_fq(float t) {
    auto a = __builtin_amdgcn_permlane16_swap(__float_as_uint(t), __float_as_uint(t), false, false); t = __uint_as_float(a[0]) + __uint_as_float(a[1]);
    auto b = __builtin_amdgcn_permlane32_swap(__float_as_uint(t), __float_as_uint(t), false, false); return __uint_as_float(b[0]) + __uint_as_float(b[1]);
}
__device__ __forceinline__ float row_rstd(const float* stats, int row, int fq) {
    const f32x4 a = *(const f32x4*)(stats + (size_t)row * 16 + 4 * fq);
    const float t = sum_fq((a[0] + a[1]) + (a[2] + a[3]));
    return __builtin_amdgcn_rsqf(t * (1.0f / 1024.0f) + RMS_EPS);
}
#define EPI_RS8(rsv) float rsv[8]; _Pragma("unroll") for (int ai_ = 0; ai_ < 2; ++ai_) _Pragma("unroll") for (int m_ = 0; m_ < 4; ++m_) rsv[ai_ * 4 + m_] = row_rstd(stats, row0 + ai_ * HALF + m_ * 16, fq); asm volatile("" ::: "memory")
#define EPI_FENCE() asm volatile("" ::: "memory")
#define EPI_RS4(rsv) float rsv[4]; _Pragma("unroll") for (int m_ = 0; m_ < 4; ++m_) rsv[m_] = row_rstd(stats, row0 + ai * HALF + m_ * 16, fq); asm volatile("" ::: "memory")
__device__ __forceinline__ float silu_f(float x) { return x * __builtin_amdgcn_rcpf(1.0f + __builtin_amdgcn_exp2f(-1.4426950408889634f * x)); }
__device__ __forceinline__ u32x4 pack8(const f32x4 a, const f32x4 b) { u32x4 w; w.x = cvt_pk_bf16(a[0], a[1]); w.y = cvt_pk_bf16(a[2], a[3]); w.z = cvt_pk_bf16(b[0], b[1]); w.w = cvt_pk_bf16(b[2], b[3]); return w; }

struct EpiGateUp {
    static constexpr bool PERM = true, AFTER_DRAIN = false;
    bf16_t* O; const float* stats; int ldo;
    __device__ __forceinline__ void operator()(const f32x4 (&acc)[2][2][4][2], const Unit& u, int wr, int wc, int fr_in, int fq_in) const {
        int fr = fr_in, fq = fq_in; asm volatile("" : "+v"(fr), "+v"(fq));
        const int row0 = u.pm * BM + wr * 64 + fr, col0 = u.pn * 128 + wc * 32 + 8 * fq;
        EPI_RS8(rsv);
#pragma unroll
        for (int ai = 0; ai < 2; ++ai)
#pragma unroll
            for (int m = 0; m < 4; ++m) { const int row = row0 + ai * HALF + m * 16; const float rs = rsv[ai * 4 + m], c1 = -1.4426950408889634f * rs, rs2 = rs * rs;
                f32x2 t[4], gu[4];
#pragma unroll
                for (int p = 0; p < 4; ++p) { const f32x4 gq = acc[ai][0][m][p >> 1], uq = acc[ai][1][m][p >> 1];
                    const f32x2 g = (p & 1) ? (f32x2){gq[2], gq[3]} : (f32x2){gq[0], gq[1]}, uu = (p & 1) ? (f32x2){uq[2], uq[3]} : (f32x2){uq[0], uq[1]};
                    const f32x2 a = g * c1; t[p].x = __builtin_amdgcn_exp2f(a.x); t[p].y = __builtin_amdgcn_exp2f(a.y); gu[p] = g * uu; }
#pragma unroll
                for (int p = 0; p < 4; ++p) { const f32x2 d = t[p] + 1.0f; t[p].x = __builtin_amdgcn_rcpf(d.x); t[p].y = __builtin_amdgcn_rcpf(d.y); }
                f32x4 o0, o1;
#pragma unroll
                for (int p = 0; p < 4; ++p) { const f32x2 o = gu[p] * (t[p] * rs2); if (p < 2) { o0[2 * p] = o.x; o0[2 * p + 1] = o.y; } else { o1[2 * p - 4] = o.x; o1[2 * p - 3] = o.y; } }
                *(u32x4*)(O + (size_t)row * ldo + col0) = pack8(o0, o1); EPI_FENCE(); }
    }
};
struct EpiResid {
    static constexpr bool PERM = true, AFTER_DRAIN = false;
    bf16_t* HB; float* stats; float scale;
    __device__ __forceinline__ void operator()(const f32x4 (&acc)[2][2][4][2], const Unit& u, int wr, int wc, int fr_in, int fq_in) const {
        int fr = fr_in, fq = fq_in; asm volatile("" : "+v"(fr), "+v"(fq));
        const int row0 = u.pm * BM + wr * 64 + fr, col0 = u.pn * BM + wc * 32 + 8 * fq;
#pragma unroll
        for (int ai = 0; ai < 2; ++ai) {
            u32x4 hw[4][2];
#pragma unroll
            for (int m = 0; m < 4; ++m)
#pragma unroll
                for (int bj = 0; bj < 2; ++bj) hw[m][bj] = *(const u32x4*)(HB + (size_t)(row0 + ai * HALF + m * 16) * 1024 + col0 + bj * HALF);
            EPI_FENCE();
#pragma unroll
            for (int m = 0; m < 4; ++m) { const int row = row0 + ai * HALF + m * 16; float ss = 0.f;
#pragma unroll
                for (int bj = 0; bj < 2; ++bj) { u32x4* hp = (u32x4*)(HB + (size_t)row * 1024 + col0 + bj * HALF);
                    const u32x4 w = hw[m][bj]; f32x4 h0, h1;
                    h0[0] = __uint_as_float(w.x << 16); h0[1] = __uint_as_float(w.x & 0xffff0000u); h0[2] = __uint_as_float(w.y << 16); h0[3] = __uint_as_float(w.y & 0xffff0000u);
                    h1[0] = __uint_as_float(w.z << 16); h1[1] = __uint_as_float(w.z & 0xffff0000u); h1[2] = __uint_as_float(w.w << 16); h1[3] = __uint_as_float(w.w & 0xffff0000u);
                    h0 = h0 + acc[ai][bj][m][0] * scale; h1 = h1 + acc[ai][bj][m][1] * scale;
                    *hp = pack8(h0, h1);
                    ss += ((h0[0] * h0[0] + h0[1] * h0[1]) + (h0[2] * h0[2] + h0[3] * h0[3])) + ((h1[0] * h1[0] + h1[1] * h1[1]) + (h1[2] * h1[2] + h1[3] * h1[3])); }
                ss = sum_fq(ss);
                if (fq == 0) stats[(size_t)row * 16 + u.pn * 4 + wc] = ss; }
            EPI_FENCE();
        }
    }
};
__device__ __forceinline__ int kv_row(int row) {
    if (row < 16384) return row + 64 * (row >> 12);
    if (row < 81920) return row + 64 * (4 + ((row - 16384) >> 13));
    const int q = (row - 81920) >> 6, i = (row - 81920) & 63;
    return (q < 4 ? 4096 * q + 4096 : 16384 + 8192 * (q - 4) + 8192) + 64 * q + i;
}
struct EpiWin {
    static constexpr bool PERM = true, AFTER_DRAIN = false;
    bf16_t *Q, *K, *V, *CB, *U; const float* stats; const float* qg; const float* kg; const float* rope;
    __device__ __forceinline__ void operator()(const f32x4 (&acc)[2][2][4][2], const Unit& u, int wr, int wc, int fr_in, int fq_in) const {
        int fr = fr_in, fq = fq_in; asm volatile("" : "+v"(fr), "+v"(fq));
        const int row0 = u.pm * BM + wr * 64 + fr, pn = u.pn;
        if (pn >= 5) {
            const int col0 = (pn - 5) * 128 + wc * 32 + 8 * fq;
#pragma unroll
            for (int ai = 0; ai < 2; ++ai) { EPI_RS4(rs4);
#pragma unroll
                for (int m = 0; m < 4; ++m) { const int row = row0 + ai * HALF + m * 16; const float rs = rs4[m], rs2 = rs * rs;
                    const f32x4 o0 = acc[ai][0][m][0] * acc[ai][1][m][0] * rs2, o1 = acc[ai][0][m][1] * acc[ai][1][m][1] * rs2;
                    *(u32x4*)(U + (size_t)row * 512 + col0) = pack8(o0, o1); EPI_FENCE(); } }
            return;
        }
        const int hd = 4 * pn + wc;
        const bool is_q = hd < 8, is_k = (hd >= 8 && hd < 10);
        bf16_t* dst; int ldd, cb;
        if (is_q) { dst = Q; ldd = 512; cb = hd * 64; } else if (is_k) { dst = K; ldd = 128; cb = (hd - 8) * 64; }
        else if (hd < 12) { dst = V; ldd = 128; cb = (hd - 10) * 64; } else { dst = CB; ldd = 512; cb = (hd - 12) * 64; }
        cb += 8 * fq;
        if (is_q || is_k) {
            const float* gp = (is_q ? qg : kg) + 8 * fq;
            const float osc = is_q ? (0.125f * 1.4426950408889634f) : 1.0f;
#pragma unroll
            for (int ai = 0; ai < 2; ++ai) { EPI_RS4(rs4);
#pragma unroll
                for (int m = 0; m < 4; ++m) { const int row = row0 + ai * HALF + m * 16; const float rs = rs4[m];
                    f32x4 v00 = acc[ai][0][m][0] * rs, v01 = acc[ai][0][m][1] * rs, v10 = acc[ai][1][m][0] * rs, v11 = acc[ai][1][m][1] * rs;
                    float ss = ((v00[0] * v00[0] + v00[1] * v00[1]) + (v00[2] * v00[2] + v00[3] * v00[3])) + ((v01[0] * v01[0] + v01[1] * v01[1]) + (v01[2] * v01[2] + v01[3] * v01[3]))
                             + ((v10[0] * v10[0] + v10[1] * v10[1]) + (v10[2] * v10[2] + v10[3] * v10[3])) + ((v11[0] * v11[0] + v11[1] * v11[1]) + (v11[2] * v11[2] + v11[3] * v11[3]));
                    ss = sum_fq(ss);
                    const float rn = __builtin_amdgcn_rsqf(ss * (1.0f / 64.0f) + RMS_EPS);
                    v00 = v00 * *(const f32x4*)gp * rn; v01 = v01 * *(const f32x4*)(gp + 4) * rn; v10 = v10 * *(const f32x4*)(gp + 32) * rn; v11 = v11 * *(const f32x4*)(gp + 36) * rn;
                    int rp = 0, cp = 0;
                    if (row < 81920) { const int nn = row & (row < 16384 ? 4095 : 8191); rp = nn >> 6; cp = nn & 63; }
                    const float* tr = rope + (size_t)rp * 32 + 8 * fq; const float* tc = rope + (size_t)cp * 32 + 8 * fq;
                    const f32x4 r0 = *(const f32x4*)tr, r1 = *(const f32x4*)(tr + 4), c0 = *(const f32x4*)tc, c1 = *(const f32x4*)(tc + 4);
                    f32x4 o00, o01, o10, o11;
                    o00[0] = v00[0] * r0[0] - v00[1] * r0[1]; o00[1] = v00[0] * r0[1] + v00[1] * r0[0]; o00[2] = v00[2] * r0[2] - v00[3] * r0[3]; o00[3] = v00[2] * r0[3] + v00[3] * r0[2];
                    o01[0] = v01[0] * r1[0] - v01[1] * r1[1]; o01[1] = v01[0] * r1[1] + v01[1] * r1[0]; o01[2] = v01[2] * r1[2] - v01[3] * r1[3]; o01[3] = v01[2] * r1[3] + v01[3] * r1[2];
                    o10[0] = v10[0] * c0[0] - v10[1] * c0[1]; o10[1] = v10[0] * c0[1] + v10[1] * c0[0]; o10[2] = v10[2] * c0[2] - v10[3] * c0[3]; o10[3] = v10[2] * c0[3] + v10[3] * c0[2];
                    o11[0] = v11[0] * c1[0] - v11[1] * c1[1]; o11[1] = v11[0] * c1[1] + v11[1] * c1[0]; o11[2] = v11[2] * c1[2] - v11[3] * c1[3]; o11[3] = v11[2] * c1[3] + v11[3] * c1[2];
                    bf16_t* dp = dst + (size_t)(is_k ? kv_row(row) : row) * ldd + cb;
                    *(u32x4*)dp = pack8(o00 * osc, o01 * osc); *(u32x4*)(dp + 32) = pack8(o10 * osc, o11 * osc); EPI_FENCE(); } }
        } else {
#pragma unroll
            for (int ai = 0; ai < 2; ++ai) { EPI_RS4(rs4);
#pragma unroll
                for (int m = 0; m < 4; ++m) { const int row = row0 + ai * HALF + m * 16; const float rs = rs4[m];
                    bf16_t* dp = dst + (size_t)(hd < 12 ? kv_row(row) : row) * ldd + cb;
                    *(u32x4*)dp = pack8(acc[ai][0][m][0] * rs, acc[ai][0][m][1] * rs); *(u32x4*)(dp + 32) = pack8(acc[ai][1][m][0] * rs, acc[ai][1][m][1] * rs); EPI_FENCE(); } }
        }
    }
};

template <class Epi, class Sched, bool ALIGN_EPI = false, bool SP2 = false>
__device__ __forceinline__ void gemm_phase(PG8_LAS unsigned char* lds, const Gemm g, const Sched& S, const Epi& E) {
    int tid_ = threadIdx.x; asm volatile("" : "+v"(tid_));
    const int tid = tid_, wid = __builtin_amdgcn_readfirstlane(tid >> 6), lane = tid & 63, wr = wid >> 2, wc = wid & 3, fr = lane & 15, fq = lane >> 4;
    const int K = g.K, nt = K / BK;
    unsigned voffA[2], voffB[2];
#pragma unroll
    for (int i = 0; i < 2; ++i) { int R, C; stage_rc(tid * 16 + i * 8192, R, C); const int Rb = Epi::PERM ? ((R & ~31) + perm32(R & 31)) : R;
        voffA[i] = (unsigned)(R * K + C) * 2u; voffB[i] = (unsigned)(Rb * K + C) * 2u; }
    const size_t kstep = (size_t)(BK * 2);
    const size_t hstep = (size_t)HALF * K * 2;
    const size_t tstep = 2 * hstep;
    const unsigned ldsw = (unsigned)wid * 1024u;
    const int aoff = lds_byte(wr * 64 + fr, fq * 8), boff = lds_byte(wc * 32 + fr, fq * 8);
#define PG8_SA(b, h) (((b) * 2 + (h)) * HTB)
#define PG8_SB(b, h) ((4 + (b) * 2 + (h)) * HTB)
#define PG8_STAGE(bufoff, gbase, voff) do { _Pragma("unroll") for (int _i = 0; _i < 2; ++_i) \
        __builtin_amdgcn_global_load_lds((const unsigned*)((const char*)(gbase) + (voff)[_i]), (PG8_LAS unsigned*)(lds + (bufoff) + ldsw + _i * 8192), 16, 0, 0); } while (0)
#define PG8_LDA(dst, b, h) do { _Pragma("unroll") for (int m = 0; m < 4; ++m) _Pragma("unroll") for (int k = 0; k < 2; ++k) dst[m][k] = *(const PG8_LAS bf16x8*)(lds + PG8_SA(b, h) + aoff + m * 2048 + k * 1024); } while (0)
#define PG8_LDB(dst, b, h) do { _Pragma("unroll") for (int n = 0; n < 2; ++n) _Pragma("unroll") for (int k = 0; k < 2; ++k) dst[n][k] = *(const PG8_LAS bf16x8*)(lds + PG8_SB(b, h) + boff + n * 2048 + k * 1024); } while (0)
#define PG8_MMA(ai, bj, At, Bt) do { __builtin_amdgcn_s_setprio(1); _Pragma("unroll") for (int m = 0; m < 4; ++m) _Pragma("unroll") for (int n = 0; n < 2; ++n) _Pragma("unroll") for (int k = 0; k < 2; ++k) \
        acc[ai][bj][m][n] = __builtin_amdgcn_mfma_f32_16x16x32_bf16(Bt[n][k], At[m][k], acc[ai][bj][m][n], 0, 0, 0); __builtin_amdgcn_s_setprio(0); } while (0)
#define PG8_WAIT_V(n) asm volatile("s_waitcnt vmcnt(" #n ")" ::: "memory")
#define PG8_WAIT_L(n) asm volatile("s_waitcnt lgkmcnt(" #n ")" ::: "memory")
#define PG8_BAR __builtin_amdgcn_s_barrier()
#define PG8_SCHED __builtin_amdgcn_sched_barrier(0)
    Unit cur, nxt; int ui = 0;
    if (!S.next(0, cur)) return;
    f32x4 acc[2][2][4][2];
#pragma unroll
    for (int a = 0; a < 2; ++a)
#pragma unroll
        for (int b = 0; b < 2; ++b)
#pragma unroll
            for (int m = 0; m < 4; ++m)
#pragma unroll
                for (int n = 0; n < 2; ++n) acc[a][b][m][n] = (f32x4){0.f, 0.f, 0.f, 0.f};
    bf16x8 At[4][2], B0[2][2], B1[2][2];
    const char* cA = (const char*)g.A + (size_t)cur.pm * tstep; const char* cB = (const char*)g.Bt + (size_t)cur.pn * tstep;
    S.a_ready(cur);
    if constexpr (SP2) {
        PG8_STAGE(PG8_SB(0, 0), cB, voffB); PG8_STAGE(PG8_SB(0, 1), cB + hstep, voffB); PG8_STAGE(PG8_SA(0, 0), cA, voffA); PG8_STAGE(PG8_SA(0, 1), cA + hstep, voffA);
        if (wr == 1) PG8_BAR;
        PG8_WAIT_V(2); PG8_BAR;
        PG8_STAGE(PG8_SB(1, 0), cB + kstep, voffB); PG8_STAGE(PG8_SA(1, 0), cA + kstep, voffA); PG8_STAGE(PG8_SB(1, 1), cB + hstep + kstep, voffB);
        PG8_WAIT_V(6); PG8_BAR;
    } else {
        PG8_STAGE(PG8_SB(0, 0), cB, voffB); PG8_STAGE(PG8_SA(0, 0), cA, voffA); PG8_STAGE(PG8_SB(0, 1), cB + hstep, voffB); PG8_STAGE(PG8_SA(0, 1), cA + hstep, voffA);
        if (wr == 1) PG8_BAR;
        PG8_WAIT_V(4); PG8_BAR;
        PG8_STAGE(PG8_SB(1, 0), cB + kstep, voffB); PG8_STAGE(PG8_SA(1, 0), cA + kstep, voffA); PG8_STAGE(PG8_SB(1, 1), cB + hstep + kstep, voffB);
        PG8_WAIT_V(6); PG8_BAR;
    }
    for (;;) {
        const bool has_next = S.next(ui + 1, nxt);
        const char* nA = has_next ? (const char*)g.A + (size_t)nxt.pm * tstep : cA; const char* nB = has_next ? (const char*)g.Bt + (size_t)nxt.pn * tstep : cB;
        for (int t = 0; t < nt; t += 2) {
            const bool last = (t == nt - 2);
            const char* a1 = cA + (size_t)(t + 1) * kstep;
            const char* a2 = last ? nA : cA + (size_t)(t + 2) * kstep; const char* b2 = last ? nB : cB + (size_t)(t + 2) * kstep;
            const char* a3 = a2 + kstep; const char* b3 = b2 + kstep;
            if (last && has_next) S.a_ready(nxt);
            if constexpr (SP2) {
            PG8_LDB(B0, 0, 0); PG8_LDB(B1, 0, 1); PG8_SCHED; PG8_LDA(At, 0, 0); PG8_STAGE(PG8_SA(1, 1), a1 + hstep, voffA);
            PG8_WAIT_V(8); PG8_WAIT_L(0); PG8_BAR; PG8_MMA(0, 0, At, B0); PG8_MMA(0, 1, At, B1); PG8_BAR; PG8_SCHED;
            PG8_LDA(At, 0, 1); PG8_STAGE(PG8_SB(0, 0), b2, voffB); PG8_STAGE(PG8_SB(0, 1), b2 + hstep, voffB); PG8_STAGE(PG8_SA(0, 0), a2, voffA);
            PG8_WAIT_V(8); PG8_WAIT_L(0); PG8_BAR; PG8_MMA(1, 0, At, B0); PG8_MMA(1, 1, At, B1); PG8_BAR; PG8_SCHED;
            PG8_LDB(B0, 1, 0); PG8_LDB(B1, 1, 1); PG8_SCHED; PG8_LDA(At, 1, 0); PG8_STAGE(PG8_SA(0, 1), a2 + hstep, voffA);
            PG8_WAIT_V(8); PG8_WAIT_L(0); PG8_BAR; PG8_MMA(0, 0, At, B0); PG8_MMA(0, 1, At, B1); PG8_BAR; PG8_SCHED;
            PG8_LDA(At, 1, 1); PG8_STAGE(PG8_SB(1, 0), b3, voffB); PG8_STAGE(PG8_SB(1, 1), b3 + hstep, voffB); PG8_STAGE(PG8_SA(1, 0), a3, voffA);
            PG8_WAIT_V(8); PG8_WAIT_L(0); PG8_BAR; PG8_MMA(1, 0, At, B0); PG8_MMA(1, 1, At, B1); PG8_BAR; PG8_SCHED;
            } else {
            PG8_LDB(B0, 0, 0); PG8_SCHED; PG8_LDA(At, 0, 0); PG8_STAGE(PG8_SA(1, 1), a1 + hstep, voffA);
            PG8_WAIT_L(8); PG8_BAR; PG8_WAIT_L(0); PG8_MMA(0, 0, At, B0); PG8_BAR; PG8_SCHED;
            PG8_LDB(B1, 0, 1); PG8_STAGE(PG8_SB(0, 0), b2, voffB);
            PG8_BAR; PG8_WAIT_L(0); PG8_MMA(0, 1, At, B1); PG8_BAR;
            PG8_LDA(At, 0, 1); PG8_STAGE(PG8_SA(0, 0), a2, voffA);
            PG8_BAR; PG8_WAIT_L(0); PG8_MMA(1, 0, At, B0); PG8_BAR; PG8_SCHED;
            PG8_STAGE(PG8_SB(0, 1), b2 + hstep, voffB);
            PG8_WAIT_V(6); PG8_BAR; PG8_MMA(1, 1, At, B1); PG8_BAR;
            PG8_LDB(B0, 1, 0); PG8_SCHED; PG8_LDA(At, 1, 0); PG8_STAGE(PG8_SA(0, 1), a2 + hstep, voffA);
            PG8_WAIT_L(8); PG8_BAR; PG8_WAIT_L(0); PG8_MMA(0, 0, At, B0); PG8_BAR; PG8_SCHED;
            PG8_LDB(B1, 1, 1); PG8_STAGE(PG8_SB(1, 0), b3, voffB);
            PG8_BAR; PG8_WAIT_L(0); PG8_MMA(0, 1, At, B1); PG8_BAR;
            PG8_LDA(At, 1, 1); PG8_STAGE(PG8_SA(1, 0), a3, voffA);
            PG8_BAR; PG8_WAIT_L(0); PG8_MMA(1, 0, At, B0); PG8_BAR; PG8_SCHED;
            PG8_STAGE(PG8_SB(1, 1), b3 + hstep, voffB);
            PG8_WAIT_V(6); PG8_BAR; PG8_MMA(1, 1, At, B1); PG8_BAR;
            }
        }
        if constexpr (ALIGN_EPI) { if (wr == 0) PG8_BAR; }
        if constexpr (!Epi::AFTER_DRAIN) { E(acc, cur, wr, wc, fr, fq); S.done(cur); }
        if (!has_next) break;
#pragma unroll
        for (int a = 0; a < 2; ++a)
#pragma unroll
            for (int b = 0; b < 2; ++b)
#pragma unroll
                for (int m = 0; m < 4; ++m)
#pragma unroll
                    for (int n = 0; n < 2; ++n) acc[a][b][m][n] = (f32x4){0.f, 0.f, 0.f, 0.f};
        cur = nxt; cA = nA; cB = nB; ++ui;
        if constexpr (ALIGN_EPI) { if (wr == 1) PG8_BAR; }
    }
    PG8_WAIT_V(0);
    if constexpr (!ALIGN_EPI) { if (wr == 0) PG8_BAR; }
    PG8_BAR;
    if constexpr (Epi::AFTER_DRAIN) { E.fused(acc, cur, wr, wc, fr, fq, lds, wid, lane); S.done(cur); }
#undef PG8_SA
#undef PG8_SB
#undef PG8_STAGE
#undef PG8_LDA
#undef PG8_LDB
#undef PG8_MMA
#undef PG8_WAIT_V
#undef PG8_WAIT_L
#undef PG8_BAR
#undef PG8_SCHED
}
}

namespace attn_body {
using bf16=__hip_bfloat16;
using bf16x8=__attribute__((ext_vector_type(8)))short;
using s16x4=__attribute__((ext_vector_type(4)))short;
using f32x16=__attribute__((ext_vector_type(16)))float;
using u32x4=__attribute__((ext_vector_type(4)))unsigned;
constexpr int D=64,QP=512,KP=128,OP=1024;
typedef float f32x4 __attribute__((ext_vector_type(4)));
constexpr int NW=8,QBLK=32,QB=QBLK*NW,KVBLK=64;
__device__ __forceinline__ int crow(int r,int hi){return (r&3)+8*(r>>2)+4*hi;}
#define SBAR() __builtin_amdgcn_sched_barrier(0)
#define ATTN_STORE16(p,v) (*(u32x4*)(p)=(v))
__device__ __forceinline__ void mmask(f32x16&p0,f32x16&p1,bool any,bool all){
  const float NEG=-INFINITY;
  #pragma unroll
  for(int r=0;r<16;++r){p1[r]=any?NEG:p1[r]; p0[r]=((r>=8)?any:all)?NEG:p0[r];}
}
constexpr int NSLOT=3, SLOTB=8192;
constexpr int LDS_K=0, LDS_V=NSLOT*SLOTB, LDS_WS=2*NSLOT*SLOTB, LDS_OST=LDS_WS+NW*64*4, LDS_BYTES=LDS_OST+NW*4096;
constexpr float C2=0.125f*1.4426950408889634f;
__device__ __forceinline__ void glds16(const void*gsrc,unsigned lds_dst){unsigned keep;
  asm volatile("s_mov_b32 %0, m0\n\ts_mov_b32 m0, %2\n\ts_nop 0\n\tglobal_load_lds_dwordx4 %1, off\n\ts_mov_b32 m0, %0":"=&s"(keep):"v"(gsrc),"s"(lds_dst):"memory");}
__device__ __forceinline__ float max3f(float a,float b,float c){float r;asm("v_max3_f32 %0, %1, %2, %3":"=v"(r):"v"(a),"v"(b),"v"(c));return r;}
__device__ __forceinline__ float max2f(float a,float b){float r;asm("v_max_f32_e32 %0, %1, %2":"=v"(r):"v"(a),"v"(b));return r;}
__device__ __forceinline__ float fadd_s(float a,float b){float r;asm("v_add_f32_e32 %0, %1, %2":"=v"(r):"v"(a),"v"(b));return r;}
__device__ __forceinline__ float fsub_s(float a,float b){float r;asm("v_sub_f32_e32 %0, %1, %2":"=v"(r):"v"(a),"v"(b));return r;}
typedef float f32x2_t __attribute__((ext_vector_type(2))); typedef __bf16 bf16x2_t __attribute__((ext_vector_type(2)));
__device__ __forceinline__ unsigned cvtpk_s(float lo,float hi){f32x2_t v={lo,hi};bf16x2_t b=__builtin_convertvector(v,bf16x2_t);return __builtin_bit_cast(unsigned,b);}
#define WAIT_BAR(N) asm volatile("s_waitcnt vmcnt(" #N ") lgkmcnt(0)\n\ts_barrier":::"memory")

__device__ __forceinline__ void qkt(f32x16&p0,f32x16&p1,const char*Kslot,const bf16x8*qr,const f32x16&negm,int r32,int hi){
  const char*kb=Kslot+hi*1024+r32*16;
  #pragma unroll
  for(int d0=0;d0<4;++d0){
    const bf16x8 b0=*reinterpret_cast<const bf16x8*>(kb+d0*2048);
    const bf16x8 b1=*reinterpret_cast<const bf16x8*>(kb+d0*2048+512);
    if(d0==0){p0=__builtin_amdgcn_mfma_f32_32x32x16_bf16(b0,qr[0],negm,0,0,0);p1=__builtin_amdgcn_mfma_f32_32x32x16_bf16(b1,qr[0],negm,0,0,0);}
    else{p0=__builtin_amdgcn_mfma_f32_32x32x16_bf16(b0,qr[d0],p0,0,0,0);p1=__builtin_amdgcn_mfma_f32_32x32x16_bf16(b1,qr[d0],p1,0,0,0);}}
}
typedef __attribute__((address_space(3))) const char* lds_cptr;
typedef short v4i16_t __attribute__((ext_vector_type(4)));
__device__ __forceinline__ void kload8(bf16x8*kf,lds_cptr kp){
  kf[0]=*(const __attribute__((address_space(3))) bf16x8*)(kp);      kf[1]=*(const __attribute__((address_space(3))) bf16x8*)(kp+512);
  kf[2]=*(const __attribute__((address_space(3))) bf16x8*)(kp+2048); kf[3]=*(const __attribute__((address_space(3))) bf16x8*)(kp+2560);
  kf[4]=*(const __attribute__((address_space(3))) bf16x8*)(kp+4096); kf[5]=*(const __attribute__((address_space(3))) bf16x8*)(kp+4608);
  kf[6]=*(const __attribute__((address_space(3))) bf16x8*)(kp+6144); kf[7]=*(const __attribute__((address_space(3))) bf16x8*)(kp+6656);
}
__device__ __forceinline__ void kload2(bf16x8*kf,lds_cptr kp,int j){ kf[2*j]=*(const __attribute__((address_space(3))) bf16x8*)(kp+j*2048); kf[2*j+1]=*(const __attribute__((address_space(3))) bf16x8*)(kp+j*2048+512); }
__device__ __forceinline__ s16x4 vtr(lds_cptr p){ return __builtin_bit_cast(s16x4,__builtin_amdgcn_ds_read_tr16_b64_v4i16((__attribute__((address_space(3))) v4i16_t*)p)); }
__device__ __forceinline__ float rowmax(const f32x16&p0,const f32x16&p1){
  float a=max3f(p0[0],p0[1],p1[0]),b=max3f(p0[2],p0[3],p1[1]);a=max3f(a,p1[2],p1[3]);
  #pragma unroll
  for(int r=4;r<16;r+=4){a=max3f(a,p0[r],p0[r+1]);b=max3f(b,p0[r+2],p0[r+3]);a=max3f(a,p1[r],p1[r+1]);b=max3f(b,p1[r+2],p1[r+3]);}
  const float m=max2f(a,b);
  auto rr=__builtin_amdgcn_permlane32_swap(__float_as_uint(m),__float_as_uint(m),false,false);
  return max2f(__uint_as_float(rr[0]),__uint_as_float(rr[1]));
}
__device__ __forceinline__ void pv(f32x16*o,int vb,bf16x8 pa0,bf16x8 pa1,bf16x8 pa2,bf16x8 pa3){
  #pragma unroll
  for(int d0=0;d0<2;++d0){s16x4 lo[4],hi[4];
    #pragma unroll
    for(int ks=0;ks<4;++ks){
      asm volatile("ds_read_b64_tr_b16 %0,%1 offset:%c2":"=&v"(lo[ks]):"v"(vb),"i"(d0*4096+ks*1024):"memory");
      asm volatile("ds_read_b64_tr_b16 %0,%1 offset:%c2":"=&v"(hi[ks]):"v"(vb),"i"(d0*4096+ks*1024+512):"memory");}
    asm volatile("s_waitcnt lgkmcnt(0)":::"memory");SBAR();
    #define PK(k) (bf16x8){lo[k][0],lo[k][1],lo[k][2],lo[k][3],hi[k][0],hi[k][1],hi[k][2],hi[k][3]}
    o[d0]=__builtin_amdgcn_mfma_f32_32x32x16_bf16(pa0,PK(0),o[d0],0,0,0);
    o[d0]=__builtin_amdgcn_mfma_f32_32x32x16_bf16(pa1,PK(1),o[d0],0,0,0);
    o[d0]=__builtin_amdgcn_mfma_f32_32x32x16_bf16(pa2,PK(2),o[d0],0,0,0);
    o[d0]=__builtin_amdgcn_mfma_f32_32x32x16_bf16(pa3,PK(3),o[d0],0,0,0);
    #undef PK
  }
}

template<int THRL> __device__ __forceinline__ void attn_unit(long qrow0,int is_meta,long kvbase,int NR,long metarow,int h,const bf16*Q,const bf16*__restrict__ K,const bf16*__restrict__ V,bf16*O,char*shm){
  int tid_=threadIdx.x; asm volatile("":"+v"(tid_)); const int tid=tid_,lane=tid&63,r32=lane&31,hi=lane>>5; const int wid=__builtin_amdgcn_readfirstlane(tid>>6);
  const long qrow_l=is_meta?(metarow+(long)(r32&15)):(qrow0+wid*QBLK+r32);
  const int h_l=is_meta?(h+2*(wid&1)+(r32>>4)):h;
  const bf16*Qw=Q+qrow_l*QP+h_l*D;
  const bf16*Kh=K+(h>>2)*D,*Vh=V+(h>>2)*D;
  const unsigned lds0=(unsigned)(uintptr_t)shm;
  float*wsf=(float*)(shm+LDS_WS)+wid*64;
  const bf16*ksrc=Kh+(long)lane*KP+wid*8;
  const bf16*vsrc=Vh+(long)(16*(wid&3)+(lane>>2))*KP+(wid>>2)*32+(lane&3)*8;
  #define TROW(t) (kvbase+(long)(t)*KVBLK)
  const unsigned kdst=lds0+LDS_K+wid*1024, vdst=lds0+LDS_V+wid*1024;
  #define DMA_K(t,slot) glds16(ksrc+TROW(t)*KP,(unsigned)__builtin_amdgcn_readfirstlane(kdst+(slot)))
  #define DMA_V(t,slot) glds16(vsrc+TROW(t)*KP,(unsigned)__builtin_amdgcn_readfirstlane(vdst+(slot)))
  const int vb0=(int)(lds0+LDS_V)+((lane>>4)&1)*32+(lane&3)*8+(4*hi+((lane&15)>>2))*64;
  const char*Kbase=shm+LDS_K; bf16x8 kf[8];
  const lds_cptr shm3=(lds_cptr)shm; const lds_cptr kp0=shm3+LDS_K+hi*1024+r32*16; const lds_cptr vp0=shm3+LDS_V+((lane>>4)&1)*32+(lane&3)*8+(4*hi+((lane&15)>>2))*64;
  const int NT=NR+2;
  DMA_K(0,0);DMA_V(0,0);DMA_K(1,SLOTB);
  bf16x8 qr[4];
  #pragma unroll
  for(int d0=0;d0<4;++d0)qr[d0]=*reinterpret_cast<const bf16x8*>(&Qw[d0*16+hi*8]);
  float mhat=0.f,l_reg=0.f;f32x16 o[2];o[0]=f32x16{};o[1]=f32x16{};f32x16 negm=f32x16{};asm volatile("":"+v"(negm));
  #define CMASK(P0,P1,t) do{ mmask(P0,P1,(t)>=NT-2,(t)==NT-1); }while(0)
  bool resc=false;
  #define START(P0,P1) do{ const float rm=rowmax(P0,P1); resc=false; \
    { const float dl=rm; mhat=fadd_s(mhat,dl); \
      _Pragma("unroll") for(int r=0;r<16;++r){P0[r]=fsub_s(P0[r],dl);P1[r]=fsub_s(P1[r],dl);} \
      _Pragma("unroll") for(int r=0;r<16;++r)negm[r]=-mhat; asm volatile("":"+v"(negm)); } \
    _Pragma("unroll") for(int r=0;r<16;++r)P0[r]=__builtin_amdgcn_exp2f(P0[r]); }while(0)
  #define RESC() do{ if(resc){ asm volatile("s_waitcnt lgkmcnt(0)":::"memory"); \
      _Pragma("unroll") for(int d_=0;d_<2;++d_) _Pragma("unroll") for(int r=0;r<16;++r)o[d_][r]*=wsf[crow(r,hi)]; } }while(0)
  f32x16 pA0,pA1,pB0,pB1;
  int sl_prev=0,sl_cur=0,sl_next=SLOTB;
  #define ROT() do{sl_prev=sl_cur;sl_cur=sl_next;sl_next=(sl_next==(NSLOT-1)*SLOTB)?0:sl_next+SLOTB;}while(0)
  DMA_K(2,2*SLOTB);
  WAIT_BAR(3);
  qkt(pA0,pA1,Kbase,qr,negm,r32,hi);asm volatile("s_nop 15\n\ts_nop 7":"+v"(pA0),"+v"(pA1));
  START(pA0,pA1);
  _Pragma("unroll") for(int r=0;r<16;++r)pA1[r]=__builtin_amdgcn_exp2f(pA1[r]);
  WAIT_BAR(0);
  DMA_K(3,0);DMA_V(1,SLOTB);
  ROT();
  kload8(kf,kp0+sl_cur);
  WAIT_BAR(2);
  s16x4 vlo[8],vhi[8]; u32x4 pw0,pw1,pw2,pw3;
  #define PKW(P,B) cvtpk_s(P[B],P[B+1])
  #define PAF(k) __builtin_bit_cast(bf16x8,pw##k)
  #define VFR(i) (bf16x8){vlo[i][0],vlo[i][1],vlo[i][2],vlo[i][3],vhi[i][0],vhi[i][1],vhi[i][2],vhi[i][3]}
  #define PIN(x) asm volatile("":"+v"(x))
  #define MX3(a,b,c) __builtin_fmaxf(__builtin_fmaxf((a),(b)),(c))
  #define GAPA(MF,A0,A1,A2,A3,W0,W1,PW) do{ MF; sacc+=A0; sacc+=A1; sacc+=A2; sacc+=A3; PIN(sacc); W0; W1; PIN(PW); SBAR(); }while(0)
  #define EX(v) __builtin_amdgcn_exp2f(v)
  #define GAPB(MF,X,B) do{ MF; X[B]=EX(X[B]); X[B+1]=EX(X[B+1]); X[B+2]=EX(X[B+2]); X[B+3]=EX(X[B+3]); PIN(X); SBAR(); }while(0)
  #define VRD(i) do{ vlo[i]=vtr(vp_+(((i)>>2)*4096+((i)&3)*1024)); vhi[i]=vtr(vp_+(((i)>>2)*4096+((i)&3)*1024+512)); }while(0)
  #define KRD(G,j) do{ if(G){ kload2(kf,kp0+sl_next,j); SBAR(); } }while(0)
  #define STEP(C0,C1,P0,P1,t,GK,GV,GL) do{ SBAR(); \
    const lds_cptr vp_=vp0+sl_prev; \
    VRD(0); SBAR(); float sacc=(P0[0]+P0[1]); \
    GAPA(C0=__builtin_amdgcn_mfma_f32_32x32x16_bf16(kf[0],qr[0],negm,0,0,0), P0[2],P0[3],P0[4],P0[5],     pw0[0]=PKW(P0,0), pw0[1]=PKW(P0,2), pw0); \
    VRD(4); SBAR(); GAPA(C1=__builtin_amdgcn_mfma_f32_32x32x16_bf16(kf[1],qr[0],negm,0,0,0), P0[6],P0[7],P0[8],P0[9],     pw0[2]=PKW(P0,4), pw0[3]=PKW(P0,6), pw0); \
    VRD(1); SBAR(); GAPA(C0=__builtin_amdgcn_mfma_f32_32x32x16_bf16(kf[2],qr[1],C0,0,0,0),   P0[10],P0[11],P0[12],P0[13], pw1[0]=PKW(P0,8), pw1[1]=PKW(P0,10), pw1); \
    VRD(5); SBAR(); GAPA(C1=__builtin_amdgcn_mfma_f32_32x32x16_bf16(kf[3],qr[1],C1,0,0,0),   P0[14],P0[15],P1[0],P1[1],   pw1[2]=PKW(P0,12),pw1[3]=PKW(P0,14), pw1); \
    VRD(2); SBAR(); GAPA(C0=__builtin_amdgcn_mfma_f32_32x32x16_bf16(kf[4],qr[2],C0,0,0,0),   P1[2],P1[3],P1[4],P1[5],     pw2[0]=PKW(P1,0), pw2[1]=PKW(P1,2), pw2); \
    VRD(6); SBAR(); GAPA(C1=__builtin_amdgcn_mfma_f32_32x32x16_bf16(kf[5],qr[2],C1,0,0,0),   P1[6],P1[7],P1[8],P1[9],     pw2[2]=PKW(P1,4), pw2[3]=PKW(P1,6), pw2); \
    VRD(3); SBAR(); GAPA(C0=__builtin_amdgcn_mfma_f32_32x32x16_bf16(kf[6],qr[3],C0,0,0,0),   P1[10],P1[11],P1[12],P1[13], pw3[0]=PKW(P1,8), pw3[1]=PKW(P1,10), pw3); \
    VRD(7); SBAR(); GAPA(C1=__builtin_amdgcn_mfma_f32_32x32x16_bf16(kf[7],qr[3],C1,0,0,0),   P1[14],P1[15],0.f,0.f,       pw3[2]=PKW(P1,12),pw3[3]=PKW(P1,14), pw3); \
    l_reg+=sacc; \
    if(GK){DMA_K((t)+3,sl_cur);} if(GV){DMA_V((t)+1,sl_next);} \
    CMASK(C0,C1,t); \
    { float a=MX3(C0[0],C0[1],C1[0]),b=MX3(C0[2],C0[3],C1[1]); a=MX3(a,C1[2],C1[3]); \
      _Pragma("unroll") for(int r=4;r<16;r+=4){a=MX3(a,C0[r],C0[r+1]);b=MX3(b,C0[r+2],C0[r+3]);a=MX3(a,C1[r],C1[r+1]);b=MX3(b,C1[r+2],C1[r+3]);} \
      float rm=__builtin_fmaxf(a,b); { auto rr=__builtin_amdgcn_permlane32_swap(__float_as_uint(rm),__float_as_uint(rm),false,false); rm=__builtin_fmaxf(__uint_as_float(rr[0]),__uint_as_float(rr[1])); } \
      resc=false; \
      if(__builtin_expect(__any(rm>(float)THRL),0)){ const float dl=__builtin_fmaxf(rm,0.f); mhat+=dl; \
        _Pragma("unroll") for(int r=0;r<16;++r){C0[r]-=dl;C1[r]-=dl;} \
        _Pragma("unroll") for(int r=0;r<16;++r)negm[r]=-mhat; asm volatile("":"+v"(negm)); \
        const float f=__builtin_amdgcn_exp2f(-dl); l_reg*=f; if(hi==0)wsf[r32]=f; resc=true; } } \
    SBAR(); \
    GAPB(o[0]=__builtin_amdgcn_mfma_f32_32x32x16_bf16(PAF(0),VFR(0),o[0],0,0,0), C0,0); \
    GAPB(o[1]=__builtin_amdgcn_mfma_f32_32x32x16_bf16(PAF(0),VFR(4),o[1],0,0,0), C0,4); \
    KRD(GL,0); GAPB(o[0]=__builtin_amdgcn_mfma_f32_32x32x16_bf16(PAF(1),VFR(1),o[0],0,0,0), C0,8); \
    KRD(GL,1); GAPB(o[1]=__builtin_amdgcn_mfma_f32_32x32x16_bf16(PAF(1),VFR(5),o[1],0,0,0), C0,12); \
    KRD(GL,2); GAPB(o[0]=__builtin_amdgcn_mfma_f32_32x32x16_bf16(PAF(2),VFR(2),o[0],0,0,0), C1,0); \
    KRD(GL,3); GAPB(o[1]=__builtin_amdgcn_mfma_f32_32x32x16_bf16(PAF(2),VFR(6),o[1],0,0,0), C1,4); \
    GAPB(o[0]=__builtin_amdgcn_mfma_f32_32x32x16_bf16(PAF(3),VFR(3),o[0],0,0,0), C1,8); \
    GAPB(o[1]=__builtin_amdgcn_mfma_f32_32x32x16_bf16(PAF(3),VFR(7),o[1],0,0,0), C1,12); \
    }while(0)
  int t=1;
  #undef CMASK
  #define CMASK(P0,P1,t) do{}while(0)
  for(;t+5<NT;t+=2){
    STEP(pB0,pB1,pA0,pA1,t,true,true,true);     WAIT_BAR(2); RESC(); ROT();
    STEP(pA0,pA1,pB0,pB1,t+1,true,true,true);   WAIT_BAR(2); RESC(); ROT();
  }
  #undef CMASK
  #define CMASK(P0,P1,t) do{ mmask(P0,P1,(t)>=NT-2,(t)==NT-1); }while(0)
  #define ENDW(tt) do{ if((tt)+3<NT){WAIT_BAR(2);} else if((tt)+2<NT){WAIT_BAR(1);} else {WAIT_BAR(0);} }while(0)
  for(;t+1<NT;t+=2){
    STEP(pB0,pB1,pA0,pA1,t,(t+3<NT),(t+1<NT),(t+1<NT));       ENDW(t);   RESC(); ROT();
    STEP(pA0,pA1,pB0,pB1,t+1,(t+4<NT),(t+2<NT),(t+2<NT));     ENDW(t+1); RESC(); ROT();
  }
  STEP(pB0,pB1,pA0,pA1,NT-1,false,false,false); RESC();
  { float sacc=pB0[0]+pB0[1]; _Pragma("unroll") for(int r=2;r<16;++r)sacc+=pB0[r]; _Pragma("unroll") for(int r=0;r<16;++r)sacc+=pB1[r]; l_reg+=sacc;
    pw0=(u32x4){PKW(pB0,0),PKW(pB0,2),PKW(pB0,4),PKW(pB0,6)};pw1=(u32x4){PKW(pB0,8),PKW(pB0,10),PKW(pB0,12),PKW(pB0,14)};pw2=(u32x4){PKW(pB1,0),PKW(pB1,2),PKW(pB1,4),PKW(pB1,6)};pw3=(u32x4){PKW(pB1,8),PKW(pB1,10),PKW(pB1,12),PKW(pB1,14)};
    SBAR(); pv(o,vb0+sl_cur,PAF(0),PAF(1),PAF(2),PAF(3)); }
  #undef PKW
  #undef PAF
  #undef VFR
  #undef PIN
  #undef MX3
  #undef GAPA
  #undef GAPB
  #undef EX
  #undef VRD
  #undef KRD
  #undef STEP
  #undef ENDW
  {auto rr=__builtin_amdgcn_permlane32_swap(__float_as_uint(l_reg),__float_as_uint(l_reg),false,false);l_reg=__uint_as_float(rr[0])+__uint_as_float(rr[1]);}
  if(hi==0)wsf[32+r32]=l_reg;asm volatile("s_waitcnt lgkmcnt(0)":::"memory");
  float rli[16];
  #pragma unroll
  for(int r=0;r<16;++r)rli[r]=__builtin_amdgcn_rcpf(wsf[32+crow(r,hi)]);
  { bf16*stg=(bf16*)(shm+LDS_OST)+wid*2048;
    #pragma unroll
    for(int r=0;r<16;++r){const int orow=crow(r,hi);
      #pragma unroll
      for(int d0=0;d0<2;++d0)stg[orow*64+d0*32+r32]=__float2bfloat16(o[d0][r]*rli[r]);}
    asm volatile("s_waitcnt lgkmcnt(0)":::"memory");
    #pragma unroll
    for(int i=0;i<4;++i){const int row=i*8+(lane>>3),ch=lane&7; const u32x4 w=*(const u32x4*)(stg+row*64+ch*8);
      float x[8];
      #pragma unroll
      for(int e=0;e<4;++e){x[2*e]=__uint_as_float(w[e]<<16); x[2*e+1]=__uint_as_float(w[e]&0xffff0000u);}
      float ss=((x[0]*x[0]+x[1]*x[1])+(x[2]*x[2]+x[3]*x[3]))+((x[4]*x[4]+x[5]*x[5])+(x[6]*x[6]+x[7]*x[7]));
      ss+=__shfl_xor(ss,1); ss+=__shfl_xor(ss,2); ss+=__shfl_xor(ss,4);
      const float rn=rsqrtf(ss*(1.0f/64.0f)+1e-6f);
      u32x4 v; v.x=cvtpk_s(x[0]*rn,x[1]*rn); v.y=cvtpk_s(x[2]*rn,x[3]*rn); v.z=cvtpk_s(x[4]*rn,x[5]*rn); v.w=cvtpk_s(x[6]*rn,x[7]*rn);
      const long orow_g=is_meta?(metarow+(row&15)):(qrow0+wid*QBLK+row);
      const int h_o=is_meta?(h+2*wid+(row>>4)):h;
      const bool ok=(!is_meta)||(wid<2);
      if(ok) ATTN_STORE16(O+orow_g*OP+h_o*D+ch*8,v);} }
  asm volatile("s_waitcnt lgkmcnt(0)\n\ts_barrier":::"memory");
  #undef DMA_K
  #undef TROW
  #undef DMA_V
  #undef CMASK
  #undef START
  #undef RESC
  #undef ROT
}
constexpr int ATTN_LDS_BYTES=LDS_BYTES;
#undef SBAR
#undef WAIT_BAR
}

constexpr int NWAVES = 8;
constexpr int DM = 1024, DFF = 2816, NIN = 2304, DEPTH = 4;
constexpr int NREAL = 81920, MB = 81920, MP = 82688;
constexpr int NSEQ = 12;
constexpr size_t MiB = 1u << 20;
constexpr size_t WS_CTL = 0, WS_ROPE = 65536, WS_STATS = 131072, WS_W = 6 * MiB, WS_H = 165 * MiB, WS_BIG = 327 * MiB;
constexpr size_t WS_END = WS_BIG + (size_t)MP * 2816 * 2;
constexpr size_t W_GU = (size_t)2 * DFF * DM, W_D = (size_t)DM * DFF, W_IN = (size_t)NIN * DM, W_OUT = (size_t)DM * DM;
constexpr size_t WL_1GU = 0, WL_1D = WL_1GU + W_GU, WL_IN = WL_1D + W_D, WL_OUT = WL_IN + W_IN, WL_2GU = WL_OUT + W_OUT, WL_2D = WL_2GU + W_GU, WL_SZ = WL_2D + W_D;
static_assert(WS_STATS + (size_t)MP * 16 * 4 <= WS_W && WS_W + WL_SZ * 2 * DEPTH <= WS_H && WS_H + (size_t)MP * DM * 2 <= WS_BIG, "ws map");
constexpr int CTL_WORDS = 16384, CW_BAR = 4096;
constexpr int RING_BYTES = 131072, LDS_BYTES = 147456;
static_assert(attn_body::ATTN_LDS_BYTES <= RING_BYTES, "attention LDS");

#define LAS __attribute__((address_space(3)))
typedef unsigned short bf16;
typedef unsigned v4u __attribute__((ext_vector_type(4)));
typedef float f32x4 __attribute__((ext_vector_type(4)));
__device__ __forceinline__ unsigned f2bf(float f) { unsigned u = __builtin_bit_cast(unsigned, f); return (u + 0x7fffu + ((u >> 16) & 1u)) >> 16; }
__device__ __forceinline__ unsigned pk2(float lo, float hi) { return f2bf(lo) | (f2bf(hi) << 16); }
__device__ __forceinline__ float bflo(unsigned w) { return __builtin_bit_cast(float, w << 16); }
__device__ __forceinline__ float bfhi(unsigned w) { return __builtin_bit_cast(float, w & 0xffff0000u); }
__device__ __forceinline__ float wave_sum(float v) {
#pragma unroll
    for (int o = 1; o < 64; o <<= 1) v += __shfl_xor(v, o);
    return v;
}
__device__ __forceinline__ void tr_item(const float* W, int K, int N, const float* gain, bf16* WT, int drow0, LAS float* scr, int k0, int n0, int lane) {
#pragma unroll 16
    for (int i = 0; i < 32; ++i) { const int kk = 2 * i + (lane >> 5); const float g = gain ? gain[k0 + kk] : 1.0f; scr[kk * 33 + (lane & 31)] = g * W[(size_t)(k0 + kk) * N + n0 + (lane & 31)]; }
    asm volatile("s_waitcnt lgkmcnt(0)" ::: "memory");
    const int c = lane & 7;
#pragma unroll
    for (int j = 0; j < 4; ++j) { const int n = (lane >> 3) + 8 * j; const LAS float* s = scr + (8 * c) * 33 + n;
        v4u o; o.x = pk2(s[0 * 33], s[1 * 33]); o.y = pk2(s[2 * 33], s[3 * 33]); o.z = pk2(s[4 * 33], s[5 * 33]); o.w = pk2(s[6 * 33], s[7 * 33]);
        *(v4u*)(WT + (size_t)(drow0 + n) * K + k0 + 8 * c) = o; }
    asm volatile("s_waitcnt lgkmcnt(0)" ::: "memory");
}
__device__ __forceinline__ int win_drow(int n0) {
    if (n0 < 1280) { const int hd = n0 >> 6, bj = (n0 >> 5) & 1; return 256 * (hd >> 2) + 128 * bj + 32 * (hd & 3); }
    if (n0 < 1792) { const int t = (n0 - 1280) >> 7, w = (n0 - 1280) & 127; return 1280 + 256 * t + w; }
    { const int t = (n0 - 1792) >> 7, w = (n0 - 1792) & 127; return 1280 + 256 * t + 128 + w; }
}
__device__ __forceinline__ long seq_base(int q) { return q < 4 ? 4096L * q : 16384L + 8192L * (q - 4); }

#define GAS __attribute__((address_space(1)))
#define XB_TMO      128
#define XB_XCNT(j)  (256  + 64 * (j))
#define XB_XSUB(j)  (1280 + 64 * (j))
#define XB_XGEN(j)  (2304 + 64 * (j))
#define XB_TOP      3328
#define XB_TOPGEN   3392
#define XCD_BAR_WORDS 3456
#define XB_SPIN_CAP (1u << 18)

__device__ __forceinline__ unsigned xb_ld(unsigned* p)              { return __hip_atomic_load(p, __ATOMIC_RELAXED, __HIP_MEMORY_SCOPE_AGENT); }
__device__ __forceinline__ unsigned xb_add(unsigned* p, unsigned v) { return __hip_atomic_fetch_add(p, v, __ATOMIC_RELAXED, __HIP_MEMORY_SCOPE_AGENT); }
__device__ __forceinline__ unsigned xb_xcc_id() { return (unsigned)__builtin_amdgcn_s_getreg((3 << 11) | 20) & 0xFu; }
#define XB_SPIN(cond, bar) do { unsigned _sp = 0; while (cond) { __builtin_amdgcn_s_sleep(1); \
    if ((++_sp & 255u) == 0u) { if (xb_ld(&(bar)[XB_TMO])) break; if (_sp > XB_SPIN_CAP) { atomicAdd(&(bar)[XB_TMO], 1u); break; } } } } while (0)

struct XcdBarrier {
    unsigned* bar; unsigned x;
    volatile LAS unsigned* st;
};

__device__ __forceinline__ XcdBarrier xcd_barrier_post(unsigned* bar, volatile LAS unsigned* st) {
    XcdBarrier b; b.bar = bar; b.x = xb_xcc_id(); b.st = st;
    if (threadIdx.x == 0) (void)xb_add(&bar[XB_XCNT(b.x)], 1u);
    return b;
}
__device__ __forceinline__ void xcd_barrier_complete(unsigned* bar, unsigned x, unsigned& nloc, unsigned& nx) {
    const unsigned G = gridDim.x * gridDim.y * gridDim.z;
    unsigned sum, cnt, mine, sp = 0u;
    for (;;) {
        sum = 0u; cnt = 0u; mine = 0u;
#pragma unroll
        for (unsigned j = 0; j < 16; ++j) { const unsigned c = xb_ld(&bar[XB_XCNT(j)]); sum += c; cnt += (c > 0u) ? 1u : 0u; mine = (j == x) ? c : mine; }
        if (sum == G) break;
        __builtin_amdgcn_s_sleep(1);
        if ((++sp & 255u) == 0u) { if (xb_ld(&bar[XB_TMO])) break; if (sp > XB_SPIN_CAP) { atomicAdd(&bar[XB_TMO], 1u); break; } }
    }
    nloc = mine > 0u ? mine : 1u; nx = cnt > 0u ? cnt : 1u;
}

__device__ __forceinline__ void xcd_barrier(const XcdBarrier& b) {
    asm volatile("s_waitcnt vmcnt(0)" ::: "memory");
    __syncthreads();
    if (threadIdx.x == 0) {
        unsigned* bar = b.bar;
        __builtin_amdgcn_s_waitcnt(0);
        unsigned nloc = b.st[0], nx = b.st[1];
        if (nloc == 0u) { xcd_barrier_complete(bar, b.x, nloc, nx); b.st[0] = nloc; b.st[1] = nx; }
        const unsigned old = xb_add(&bar[XB_XSUB(b.x)], 1u);
        const unsigned gen = old / nloc;
        if (old + 1u == (gen + 1u) * nloc) {
            __builtin_amdgcn_fence(__ATOMIC_RELEASE, "agent");
            asm volatile("s_waitcnt vmcnt(0)" ::: "memory");
            const unsigned og = xb_add(&bar[XB_TOP], 1u);
            const unsigned tg = og / nx;
            if (og + 1u == (tg + 1u) * nx) xb_add(&bar[XB_TOPGEN], 1u);
            else XB_SPIN(xb_ld(&bar[XB_TOPGEN]) == tg, bar);
            __builtin_amdgcn_fence(__ATOMIC_ACQUIRE, "agent");
            xb_add(&bar[XB_XGEN(b.x)], 1u);
            asm volatile("s_waitcnt vmcnt(0)" ::: "memory");
        } else {
            XB_SPIN(xb_ld(&bar[XB_XGEN(b.x)]) == gen, bar);
            __builtin_amdgcn_fence(__ATOMIC_ACQUIRE, "agent");
            asm volatile("s_waitcnt vmcnt(0)" ::: "memory");
        }
    }
    __syncthreads();
}

static_assert(CW_BAR + XCD_BAR_WORDS <= CTL_WORDS && CTL_WORDS * 4 <= (int)WS_ROPE, "ctl map");

struct Args { const float* in[21]; float* out; unsigned char* ws; };

#define CONVERT_LAYER(LC, W0, NW) do { const int lc__ = (LC), w0__ = (W0), nw__ = (NW); { const int l = lc__; LAS float* scr = (LAS float*)(ldsp + wave * 16384); \
        constexpr int I_GU = 16 * 88, I_D = 44 * 32, I_IN = 16 * 72, I_OUT = 16 * 32, I_L = 4 * I_GU + 2 * I_D + I_IN + I_OUT; \
        for (int it = w0__; it < I_L; it += nw__) { \
            int r = it; bf16* WL = Wb + (size_t)l * WL_SZ; \
            if (r < 4 * I_GU) { const int which = r / I_GU; r %= I_GU; const int kb = r / 88, nb = r % 88, n0 = 32 * nb; \
                const float* W = args.in[(which < 2 ? 4 : 17) + (which & 1)] + (size_t)l * DM * DFF; const float* gn = args.in[which < 2 ? 3 : 16] + l * DM; \
                tr_item(W, DM, DFF, gn, WL + (which < 2 ? WL_1GU : WL_2GU), 256 * (n0 >> 7) + (n0 & 127) + ((which & 1) ? 128 : 0), scr, 64 * kb, n0, lane); continue; } \
            r -= 4 * I_GU; \
            if (r < 2 * I_D) { const int which = r / I_D; r %= I_D; const int kb = r / 32, nb = r % 32; \
                tr_item(args.in[which ? 19 : 6] + (size_t)l * DFF * DM, DFF, DM, nullptr, WL + (which ? WL_2D : WL_1D), 32 * nb, scr, 64 * kb, 32 * nb, lane); continue; } \
            r -= 2 * I_D; \
            if (r < I_IN) { const int kb = r / 72, nb = r % 72; \
                tr_item(args.in[8] + (size_t)l * DM * NIN, DM, NIN, args.in[7] + l * DM, WL + WL_IN, win_drow(32 * nb), scr, 64 * kb, 32 * nb, lane); continue; } \
            r -= I_IN; \
            { const int kb = r / 32, nb = r % 32; const int k0 = 64 * kb; \
              const float* gn = (k0 < 512) ? (args.in[13] + l * 512 + 0) : (args.in[14] + l * 512 - 512); \
              tr_item(args.in[15] + (size_t)l * DM * DM, DM, DM, gn, WL + WL_OUT, 32 * nb, scr, k0, 32 * nb, lane); } \
        } } } while (0)
__global__ void __launch_bounds__(NWAVES * 64, 2) hymba_fwd(Args args) {
    extern __shared__ __attribute__((aligned(16))) unsigned char lds[];
    cg::grid_group grid = cg::this_grid();
    const int tid = threadIdx.x, lane0 = tid & 63, wave = __builtin_amdgcn_readfirstlane(tid >> 6);
    const int G = gridDim.x, bx = blockIdx.x;
    const int gw = bx * NWAVES + wave, NGW = G * NWAVES;
    unsigned char* ws = args.ws;
    unsigned* ctl = (unsigned*)(ws + WS_CTL);
    float* rope = (float*)(ws + WS_ROPE);
    float* stats = (float*)(ws + WS_STATS);
    bf16* Wb = (bf16*)(ws + WS_W);
    bf16* HB = (bf16*)(ws + WS_H);
    bf16* BIG = (bf16*)(ws + WS_BIG);
    bf16* ACT = BIG;
    bf16* Qb = BIG; bf16* Kb = BIG + (size_t)MP * 512; bf16* Vb = BIG + (size_t)MP * 640; bf16* CBb = BIG + (size_t)MP * 768; bf16* Ub = BIG + (size_t)MP * 1280; bf16* Yb = BIG + (size_t)MP * 1792;
    LAS unsigned char* ldsp = (LAS unsigned char*)lds;
    const float* x_prompt = args.in[0]; const float* x_sample = args.in[1]; const float* meta = args.in[2];

    {
        const int lane = lane0;
        for (int i = bx * (NWAVES * 64) + tid; i < CTL_WORDS; i += G * NWAVES * 64) ctl[i] = 0u;
        if (tid < 2) ((LAS unsigned*)(ldsp + RING_BYTES + 128))[tid] = 0u;
        { const int gt = bx * (NWAVES * 64) + tid;
          if (gt < 2048) { const int pos = gt >> 4, i = gt & 15; const double fr = exp2(-(double)i * (13.287712379549449 / 16.0)); double s, c; sincos((double)pos * fr, &s, &c); rope[2 * gt] = (float)c; rope[2 * gt + 1] = (float)s; } }
        CONVERT_LAYER(0, gw, NGW);
        for (int row0 = gw; row0 < MP; row0 += 2 * NGW) {
            f32x4 v[2][4]; float ss[2]; const int rows[2] = {row0, row0 + NGW};
#pragma unroll
            for (int r = 0; r < 2; ++r) { const int row = rows[r]; const float* src = nullptr;
                if (row < 16384) src = x_prompt + (size_t)row * DM; else if (row < NREAL) src = x_sample + (size_t)(row - 16384) * DM;
                else if (row < MP) { const int i = (row - MB) & 63; if (i < 16) src = meta + (size_t)i * DM; }
#pragma unroll
                for (int j = 0; j < 4; ++j) v[r][j] = src ? ((const f32x4*)src)[lane + 64 * j] : (f32x4){0.f, 0.f, 0.f, 0.f}; }
#pragma unroll
            for (int r = 0; r < 2; ++r) { float s = 0.f;
#pragma unroll
                for (int j = 0; j < 4; ++j) s += (v[r][j][0] * v[r][j][0] + v[r][j][1] * v[r][j][1]) + (v[r][j][2] * v[r][j][2] + v[r][j][3] * v[r][j][3]);
                ss[r] = wave_sum(s); }
#pragma unroll
            for (int r = 0; r < 2; ++r) { const int row = rows[r]; if (row < MP) {
#pragma unroll
                for (int j = 0; j < 4; ++j)
                    ((unsigned long long*)(HB + (size_t)row * DM))[lane + 64 * j] = (unsigned long long)pk2(v[r][j][0], v[r][j][1]) | ((unsigned long long)pk2(v[r][j][2], v[r][j][3]) << 32);
                if (lane < 16) stats[(size_t)row * 16 + lane] = (lane == 0) ? ss[r] : 0.f; } }
        }
    }
    grid.sync();
    const XcdBarrier xbar = xcd_barrier_post(ctl + CW_BAR, (volatile LAS unsigned*)(ldsp + RING_BYTES + 128));

    for (int l = 0; l < DEPTH; ++l) {
        const bf16* WL = Wb + (size_t)l * WL_SZ;
        for (int s = 0; s < 2; ++s) {
            if (s == 1) {
#ifndef NO_WIN
                { pg8::Gemm g{HB, WL + WL_IN, MP, NIN, DM}; pg8::StaticOrder S; S.init(MP, NIN, G, bx);
                  pg8::EpiWin E{Qb, Kb, Vb, CBb, Ub, stats, args.in[9] + l * 64, args.in[10] + l * 64, rope};
                  pg8::gemm_phase<pg8::EpiWin, pg8::StaticOrder, true, true>(ldsp, g, S, E); }
#endif

                xcd_barrier(xbar);
                {
                    int lane = lane0; asm volatile("" : "+v"(lane));
                    const float* cw = args.in[11] + (size_t)l * 3 * 512; const float* cbias = args.in[12] + (size_t)l * 512;
                    LAS volatile unsigned* qslot = (LAS volatile unsigned*)(ldsp + RING_BYTES);
                    constexpr int UPG_S = 4 * 32 + 1, UPG_P = 4 * 16 + 1, NU_S = 8 * 2 * UPG_S, NU_P = 4 * 2 * UPG_P, NU = NU_S + NU_P, NCH = MP / 64;
                    for (;;) {
                        if (tid == 0) qslot[0] = atomicAdd(ctl + l, 1u);
                        __syncthreads();
                        const int idx = __builtin_amdgcn_readfirstlane((int)qslot[0]);
                        if (idx >= NU + NCH) break;
                        if (idx < NU) {
                            int q, rem, nqb;
                            if (idx < NU_S) { q = 4 + idx / (2 * UPG_S); rem = idx % (2 * UPG_S); nqb = 32; } else { const int i2 = idx - NU_S; q = i2 / (2 * UPG_P); rem = i2 % (2 * UPG_P); nqb = 16; }
                            const int upg = 4 * nqb + 1, kvg = rem / upg, r2 = rem % upg;
                            const int is_meta = (r2 == 4 * nqb) ? 1 : 0, h = is_meta ? 4 * kvg : 4 * kvg + r2 / nqb, b = is_meta ? 0 : r2 % nqb;
                            const long sb = seq_base(q);
#ifndef NO_ATT
                            attn_body::attn_unit<8>(sb + 256L * b, is_meta, sb + 64L * q, nqb * 4, (long)(MB + 64 * q), h,
                                (const attn_body::bf16*)Qb, (const attn_body::bf16*)Kb, (const attn_body::bf16*)Vb, (attn_body::bf16*)Yb, (char*)lds);
#endif
                        } else {
                            f32x4 w0[2], w1[2], w2[2], bb[2];
#pragma unroll
                            for (int j = 0; j < 2; ++j) { w0[j] = *(const f32x4*)(cw + 8 * lane + 4 * j); w1[j] = *(const f32x4*)(cw + 512 + 8 * lane + 4 * j); w2[j] = *(const f32x4*)(cw + 1024 + 8 * lane + 4 * j); bb[j] = *(const f32x4*)(cbias + 8 * lane + 4 * j); }
                            const int rbase = (idx - NU) * 64 + wave * 8;
                            for (int rr = 0; rr < 8; ++rr) {
                                const int row = rbase + rr;
                                long prev = -1, next = -1; bool valid = true;
                                if (row < NREAL) { const int q = row < 16384 ? (row >> 12) : 4 + ((row - 16384) >> 13); const int nlen = row < 16384 ? 4096 : 8192; const int n = row & (nlen - 1);
                                    prev = (n == 0) ? (long)(MB + 64 * q + 15) : (long)row - 1; next = (n == nlen - 1) ? -1L : (long)row + 1; }
                                else { const int q = (row - MB) >> 6, i = (row - MB) & 63; valid = i < 16; prev = (i == 0) ? -1L : (long)row - 1; next = (i == 15) ? seq_base(q) : (long)row + 1; }
                                v4u* yo = (v4u*)(Yb + (size_t)row * 1024 + 512) + lane;
                                if (!valid) { *yo = (v4u){0u, 0u, 0u, 0u}; *((v4u*)(Yb + (size_t)row * 1024) + lane) = (v4u){0u, 0u, 0u, 0u}; continue; }
                                const v4u uc = *((const v4u*)(Ub + (size_t)row * 512) + lane);
                                const v4u up = prev >= 0 ? *((const v4u*)(Ub + (size_t)prev * 512) + lane) : (v4u){0u, 0u, 0u, 0u};
                                const v4u un = next >= 0 ? *((const v4u*)(Ub + (size_t)next * 512) + lane) : (v4u){0u, 0u, 0u, 0u};
                                const v4u cbv = *((const v4u*)(CBb + (size_t)row * 512) + lane);
                                float y[8]; float ss = 0.f;
#pragma unroll
                                for (int e = 0; e < 8; ++e) { const int wi = e >> 1; const bool hi_ = e & 1;
                                    const float a = hi_ ? bfhi(up[wi]) : bflo(up[wi]), b = hi_ ? bfhi(uc[wi]) : bflo(uc[wi]), c = hi_ ? bfhi(un[wi]) : bflo(un[wi]), d = hi_ ? bfhi(cbv[wi]) : bflo(cbv[wi]);
                                    const float t = a * w0[e >> 2][e & 3] + b * w1[e >> 2][e & 3] + c * w2[e >> 2][e & 3] + bb[e >> 2][e & 3];
                                    y[e] = d * t; ss += y[e] * y[e]; }
                                ss += __shfl_xor(ss, 1); ss += __shfl_xor(ss, 2); ss += __shfl_xor(ss, 4);
                                const float rn = rsqrtf(ss * (1.0f / 64.0f) + 1e-6f);
                                v4u o; o.x = pk2(y[0] * rn, y[1] * rn); o.y = pk2(y[2] * rn, y[3] * rn); o.z = pk2(y[4] * rn, y[5] * rn); o.w = pk2(y[6] * rn, y[7] * rn);
                                *yo = o;
                            }
                            __syncthreads();
                        }
                    }
                }
                xcd_barrier(xbar);
#ifndef NO_WOUT
                { const int Mr = (l == DEPTH - 1) ? NREAL : MP; pg8::Gemm g{Yb, WL + WL_OUT, Mr, DM, DM}; pg8::StaticOrder S; S.init(Mr, DM, G, bx);
                  pg8::EpiResid E{HB, stats, 1.0f};
                  pg8::gemm_phase<pg8::EpiResid, pg8::StaticOrder, true, true>(ldsp, g, S, E); }
#endif

                xcd_barrier(xbar);
            }
#ifndef NO_GU
            { const int Mr = (l == DEPTH - 1 && s == 1) ? NREAL : MP; pg8::Gemm g{HB, WL + (s ? WL_2GU : WL_1GU), Mr, 2 * DFF, DM}; pg8::StaticOrder S; S.init(Mr, 2 * DFF, G, bx);
              pg8::EpiGateUp E{ACT, stats, DFF};
              pg8::gemm_phase<pg8::EpiGateUp, pg8::StaticOrder, true, true>(ldsp, g, S, E); }
#endif

            xcd_barrier(xbar);
#ifndef NO_DOWN
            { const int Mr = (l == DEPTH - 1 && s == 1) ? NREAL : MP; pg8::Gemm g{ACT, WL + (s ? WL_2D : WL_1D), Mr, DM, DFF}; pg8::StaticOrder S; S.init(Mr, DM, G, bx);
              pg8::EpiResid E{HB, stats, 0.5f};
              pg8::gemm_phase<pg8::EpiResid, pg8::StaticOrder, true, true>(ldsp, g, S, E);
              if (s == 0 && l + 1 < DEPTH) {
                  const int extra = S.nwg % G, first = extra ? extra : 0;
                  if (bx >= first) { int lane = lane0; asm volatile("" : "+v"(lane)); CONVERT_LAYER(l + 1, (bx - first) * NWAVES + wave, (G - first) * NWAVES); } } }
#endif

            xcd_barrier(xbar);
        }
    }
    {
        int lane = lane0; asm volatile("" : "+v"(lane));
        const float* fn = args.in[20]; f32x4 gnv[4];
#pragma unroll
        for (int j = 0; j < 4; ++j) gnv[j] = ((const f32x4*)fn)[lane + 64 * j];
        for (int row0 = gw; row0 < NREAL; row0 += 2 * NGW) {
            unsigned long long w[2][4];
#pragma unroll
            for (int r = 0; r < 2; ++r) { const int row = row0 + r * NGW < NREAL ? row0 + r * NGW : row0;
#pragma unroll
                for (int j = 0; j < 4; ++j) w[r][j] = ((const unsigned long long*)(HB + (size_t)row * DM))[lane + 64 * j]; }
#pragma unroll
            for (int r = 0; r < 2; ++r) { const int row = row0 + r * NGW; f32x4 v[4]; float ss = 0.f;
#pragma unroll
                for (int j = 0; j < 4; ++j) { const unsigned lo = (unsigned)w[r][j], hi = (unsigned)(w[r][j] >> 32);
                    v[j][0] = bflo(lo); v[j][1] = bfhi(lo); v[j][2] = bflo(hi); v[j][3] = bfhi(hi); ss += (v[j][0] * v[j][0] + v[j][1] * v[j][1]) + (v[j][2] * v[j][2] + v[j][3] * v[j][3]); }
                const float rs = rsqrtf(wave_sum(ss) * (1.0f / 1024.0f) + 1e-6f);
                if (row < NREAL) {
#pragma unroll
                    for (int j = 0; j < 4; ++j) ((f32x4*)(args.out + (size_t)row * DM))[lane + 64 * j] = v[j] * rs * gnv[j]; } }
        }
    }
}

extern "C" void kernel_launch(void* const* d_in, const int* in_sizes, int n_in, void* d_out, int out_size, void* d_ws, size_t ws_size, hipStream_t stream) {
    static int grid = 0;
    if (grid == 0) {
        if (n_in != 21 || out_size != NREAL * DM || ws_size < WS_END || in_sizes[8] != DEPTH * DM * NIN) {
            fprintf(stderr, "kernel_launch: unexpected shapes: n_in %d out %d ws %zu (need %zu) w_in %d\n", n_in, out_size, ws_size, (size_t)WS_END, n_in > 8 ? in_sizes[8] : -1); grid = -1; return; }
        int dev = 0, cus = 0, per_cu = 0;
        (void)hipGetDevice(&dev); (void)hipDeviceGetAttribute(&cus, hipDeviceAttributeMultiprocessorCount, dev);
        if (hipFuncSetAttribute((const void*)hymba_fwd, hipFuncAttributeMaxDynamicSharedMemorySize, LDS_BYTES) != hipSuccess) { fprintf(stderr, "kernel_launch: hipFuncSetAttribute failed\n"); grid = -1; return; }
        (void)hipOccupancyMaxActiveBlocksPerMultiprocessor(&per_cu, (const void*)hymba_fwd, NWAVES * 64, LDS_BYTES);
        if (per_cu < 1) { fprintf(stderr, "kernel_launch: occupancy query says %d blocks per CU\n", per_cu); per_cu = 1; }
        (void)hipGetLastError();
        grid = cus;
    }
    if (grid < 0) return;
    Args a{};
    for (int i = 0; i < 21; ++i) a.in[i] = (const float*)d_in[i];
    a.out = (float*)d_out; a.ws = (unsigned char*)d_ws;
    void* kargs[] = {&a};
    hipError_t e = hipLaunchCooperativeKernel((const void*)hymba_fwd, dim3(grid), dim3(NWAVES * 64), kargs, LDS_BYTES, stream);
    if (e != hipSuccess) fprintf(stderr, "cooperative launch failed: %s (grid %d)\n", hipGetErrorString(e), grid);
}
```

```cpp
#include <hip/hip_runtime.h>
#include <hip/hip_cooperative_groups.h>
#include <hip/hip_bf16.h>
#include <cstdio>
#include <cstdint>
#include <cmath>
namespace cg = cooperative_groups;
namespace pg8 {
#define PG8_LAS __attribute__((address_space(3)))
typedef unsigned short bf16_t;
typedef short bf16x8 __attribute__((ext_vector_type(8)));
typedef float f32x4 __attribute__((ext_vector_type(4)));
typedef unsigned u32x4 __attribute__((ext_vector_type(4)));
constexpr int BM = 256, BK = 64, HALF = 128, HTB = HALF * BK * 2  , STAGE_BYTES = 8 * HTB, NXCD = 8, WGM = 8;

__host__ __device__ __forceinline__ int lds_byte(int r, int c) { const int st = (r >> 4) * 2 + (c >> 5), rr = r & 15, cc = c & 31, ob = rr * 64 + cc * 2; return st * 1024 + (ob ^ (((ob >> 9) & 1) << 5)); }
__host__ __device__ __forceinline__ void stage_rc(int b, int& R, int& C) { const int st = b / 1024, sb = b % 1024, swz = sb ^ (((sb >> 9) & 1) << 5); R = (st >> 1) * 16 + swz / 64; C = (st & 1) * 32 + (swz % 64) / 2; }
__host__ __device__ __forceinline__ int perm32(int rho) { const int n = rho >> 4, i = rho & 15; return 8 * (i >> 2) + 4 * n + (i & 3); }

struct Unit { int pm, pn; };
struct Gemm { const bf16_t* A; const bf16_t* Bt; int M, N, K; };

struct StaticOrder {
    int nM, nN, nwg, G, c;
    __host__ __device__ void init(int M, int N, int G_, int c_) { nM = M / BM; nN = N / BM; nwg = nM * nN; G = G_; c = c_; }
    __host__ __device__ bool next(int i, Unit& u) const {
        const long L = (long)i * G + c; if (L >= nwg) return false;
        int wgid = (int)L; { const int q = nwg / NXCD, r = nwg % NXCD, xcd = wgid % NXCD, off = wgid / NXCD; wgid = (xcd < r ? xcd * (q + 1) : r * (q + 1) + (xcd - r) * q) + off; }
        const int nig = WGM * nN, gid = wgid / nig, fm = gid * WGM, gsz = (nM - fm) < WGM ? (nM - fm) : WGM;
        u.pm = fm + ((wgid % nig) % gsz); u.pn = (wgid % nig) / gsz; return true;
    }
    __device__ __forceinline__ void a_ready(const Unit&) const {}
    __device__ __forceinline__ void done(const Unit&) const {}
};

__device__ __forceinline__ unsigned cvt_pk_bf16(float lo, float hi) { unsigned r; asm volatile("v_cvt_pk_bf16_f32 %0, %1, %2" : "=v"(r) : "v"(lo), "v"(hi)); return r; }
constexpr float RMS_EPS = 1e-6f;
typedef float f32x2 __attribute__((ext_vector_type(2)));
__device__ __forceinline__ float sum_fq(float t) {
    auto a = __builtin_amdgcn_permlane16_swap(__float_as_uint(t), __float_as_uint(t), false, false); t = __uint_as_float(a[0]) + __uint_as_float(a[1]);
    auto b = __builtin_amdgcn_permlane32_swap(__float_as_uint(t), __float_as_uint(t), false, false); return __uint_as_float(b[0]) + __uint_as_float(b[1]);
}
__device__ __forceinline__ float row_rstd(const float* stats, int row, int fq) {
    const f32x4 a = *(const f32x4*)(stats + (size_t)row * 16 + 4 * fq);
    const float t = sum_fq((a[0] + a[1]) + (a[2] + a[3]));
    return __builtin_amdgcn_rsqf(t * (1.0f / 1024.0f) + RMS_EPS);
}
#define EPI_RS8(rsv) float rsv[8]; _Pragma("unroll") for (int ai_ = 0; ai_ < 2; ++ai_) _Pragma("unroll") for (int m_ = 0; m_ < 4; ++m_) rsv[ai_ * 4 + m_] = row_rstd(stats, row0 + ai_ * HALF + m_ * 16, fq); asm volatile("" ::: "memory")
#define EPI_FENCE() asm volatile("" ::: "memory")
#define EPI_RS4(rsv) float rsv[4]; _Pragma("unroll") for (int m_ = 0; m_ < 4; ++m_) rsv[m_] = row_rstd(stats, row0 + ai * HALF + m_ * 16, fq); asm volatile("" ::: "memory")
__device__ __forceinline__ float silu_f(float x) { return x * __builtin_amdgcn_rcpf(1.0f + __builtin_amdgcn_exp2f(-1.4426950408889634f * x)); }
__device__ __forceinline__ u32x4 pack8(const f32x4 a, const f32x4 b) { u32x4 w; w.x = cvt_pk_bf16(a[0], a[1]); w.y = cvt_pk_bf16(a[2], a[3]); w.z = cvt_pk_bf16(b[0], b[1]); w.w = cvt_pk_bf16(b[2], b[3]); return w; }

struct EpiGateUp {
    static constexpr bool PERM = true, AFTER_DRAIN = false;
    bf16_t* O; const float* stats; int ldo;
    __device__ __forceinline__ void operator()(const f32x4 (&acc)[2][2][4][2], const Unit& u, int wr, int wc, int fr_in, int fq_in) const {
        int fr = fr_in, fq = fq_in; asm volatile("" : "+v"(fr), "+v"(fq));
        const int row0 = u.pm * BM + wr * 64 + fr, col0 = u.pn * 128 + wc * 32 + 8 * fq;
        EPI_RS8(rsv);
#pragma unroll
        for (int ai = 0; ai < 2; ++ai)
#pragma unroll
            for (int m = 0; m < 4; ++m) { const int row = row0 + ai * HALF + m * 16; const float rs = rsv[ai * 4 + m], c1 = -1.4426950408889634f * rs, rs2 = rs * rs;
                f32x2 t[4], gu[4];
#pragma unroll
                for (int p = 0; p < 4; ++p) { const f32x4 gq = acc[ai][0][m][p >> 1], uq = acc[ai][1][m][p >> 1];
                    const f32x2 g = (p & 1) ? (f32x2){gq[2], gq[3]} : (f32x2){gq[0], gq[1]}, uu = (p & 1) ? (f32x2){uq[2], uq[3]} : (f32x2){uq[0], uq[1]};
                    const f32x2 a = g * c1; t[p].x = __builtin_amdgcn_exp2f(a.x); t[p].y = __builtin_amdgcn_exp2f(a.y); gu[p] = g * uu; }
#pragma unroll
                for (int p = 0; p < 4; ++p) { const f32x2 d = t[p] + 1.0f; t[p].x = __builtin_amdgcn_rcpf(d.x); t[p].y = __builtin_amdgcn_rcpf(d.y); }
                f32x4 o0, o1;
#pragma unroll
                for (int p = 0; p < 4; ++p) { const f32x2 o = gu[p] * (t[p] * rs2); if (p < 2) { o0[2 * p] = o.x; o0[2 * p + 1] = o.y; } else { o1[2 * p - 4] = o.x; o1[2 * p - 3] = o.y; } }
                *(u32x4*)(O + (size_t)row * ldo + col0) = pack8(o0, o1); EPI_FENCE(); }
    }
};
struct EpiResid {
    static constexpr bool PERM = true, AFTER_DRAIN = false;
    bf16_t* HB; float* stats; float scale;
    __device__ __forceinline__ void operator()(const f32x4 (&acc)[2][2][4][2], const Unit& u, int wr, int wc, int fr_in, int fq_in) const {
        int fr = fr_in, fq = fq_in; asm volatile("" : "+v"(fr), "+v"(fq));
        const int row0 = u.pm * BM + wr * 64 + fr, col0 = u.pn * BM + wc * 32 + 8 * fq;
#pragma unroll
        for (int ai = 0; ai < 2; ++ai) {
            u32x4 hw[4][2];
#pragma unroll
            for (int m = 0; m < 4; ++m)
#pragma unroll
                for (int bj = 0; bj < 2; ++bj) hw[m][bj] = *(const u32x4*)(HB + (size_t)(row0 + ai * HALF + m * 16) * 1024 + col0 + bj * HALF);
            EPI_FENCE();
#pragma unroll
            for (int m = 0; m < 4; ++m) { const int row = row0 + ai * HALF + m * 16; float ss = 0.f;
#pragma unroll
                for (int bj = 0; bj < 2; ++bj) { u32x4* hp = (u32x4*)(HB + (size_t)row * 1024 + col0 + bj * HALF);
                    const u32x4 w = hw[m][bj]; f32x4 h0, h1;
                    h0[0] = __uint_as_float(w.x << 16); h0[1] = __uint_as_float(w.x & 0xffff0000u); h0[2] = __uint_as_float(w.y << 16); h0[3] = __uint_as_float(w.y & 0xffff0000u);
                    h1[0] = __uint_as_float(w.z << 16); h1[1] = __uint_as_float(w.z & 0xffff0000u); h1[2] = __uint_as_float(w.w << 16); h1[3] = __uint_as_float(w.w & 0xffff0000u);
                    h0 = h0 + acc[ai][bj][m][0] * scale; h1 = h1 + acc[ai][bj][m][1] * scale;
                    *hp = pack8(h0, h1);
                    ss += ((h0[0] * h0[0] + h0[1] * h0[1]) + (h0[2] * h0[2] + h0[3] * h0[3])) + ((h1[0] * h1[0] + h1[1] * h1[1]) + (h1[2] * h1[2] + h1[3] * h1[3])); }
                ss = sum_fq(ss);
                if (fq == 0) stats[(size_t)row * 16 + u.pn * 4 + wc] = ss; }
            EPI_FENCE();
        }
    }
};
__device__ __forceinline__ int kv_row(int row) {
    if (row < 16384) return row + 64 * (row >> 12);
    if (row < 81920) return row + 64 * (4 + ((row - 16384) >> 13));
    const int q = (row - 81920) >> 6, i = (row - 81920) & 63;
    return (q < 4 ? 4096 * q + 4096 : 16384 + 8192 * (q - 4) + 8192) + 64 * q + i;
}
struct EpiWin {
    static constexpr bool PERM = true, AFTER_DRAIN = false;
    bf16_t *Q, *K, *V, *CB, *U; const float* stats; const float* qg; const float* kg; const float* rope;
    __device__ __forceinline__ void operator()(const f32x4 (&acc)[2][2][4][2], const Unit& u, int wr, int wc, int fr_in, int fq_in) const {
        int fr = fr_in, fq = fq_in; asm volatile("" : "+v"(fr), "+v"(fq));
        const int row0 = u.pm * BM + wr * 64 + fr, pn = u.pn;
        if (pn >= 5) {
            const int col0 = (pn - 5) * 128 + wc * 32 + 8 * fq;
#pragma unroll
            for (int ai = 0; ai < 2; ++ai) { EPI_RS4(rs4);
#pragma unroll
                for (int m = 0; m < 4; ++m) { const int row = row0 + ai * HALF + m * 16; const float rs = rs4[m], rs2 = rs * rs;
                    const f32x4 o0 = acc[ai][0][m][0] * acc[ai][1][m][0] * rs2, o1 = acc[ai][0][m][1] * acc[ai][1][m][1] * rs2;
                    *(u32x4*)(U + (size_t)row * 512 + col0) = pack8(o0, o1); EPI_FENCE(); } }
            return;
        }
        const int hd = 4 * pn + wc;
        const bool is_q = hd < 8, is_k = (hd >= 8 && hd < 10);
        bf16_t* dst; int ldd, cb;
        if (is_q) { dst = Q; ldd = 512; cb = hd * 64; } else if (is_k) { dst = K; ldd = 128; cb = (hd - 8) * 64; }
        else if (hd < 12) { dst = V; ldd = 128; cb = (hd - 10) * 64; } else { dst = CB; ldd = 512; cb = (hd - 12) * 64; }
        cb += 8 * fq;
        if (is_q || is_k) {
            const float* gp = (is_q ? qg : kg) + 8 * fq;
            const float osc = is_q ? (0.125f * 1.4426950408889634f) : 1.0f;
#pragma unroll
            for (int ai = 0; ai < 2; ++ai) { EPI_RS4(rs4);
#pragma unroll
                for (int m = 0; m < 4; ++m) { const int row = row0 + ai * HALF + m * 16; const float rs = rs4[m];
                    f32x4 v00 = acc[ai][0][m][0] * rs, v01 = acc[ai][0][m][1] * rs, v10 = acc[ai][1][m][0] * rs, v11 = acc[ai][1][m][1] * rs;
                    float ss = ((v00[0] * v00[0] + v00[1] * v00[1]) + (v00[2] * v00[2] + v00[3] * v00[3])) + ((v01[0] * v01[0] + v01[1] * v01[1]) + (v01[2] * v01[2] + v01[3] * v01[3]))
                             + ((v10[0] * v10[0] + v10[1] * v10[1]) + (v10[2] * v10[2] + v10[3] * v10[3])) + ((v11[0] * v11[0] + v11[1] * v11[1]) + (v11[2] * v11[2] + v11[3] * v11[3]));
                    ss = sum_fq(ss);
                    const float rn = __builtin_amdgcn_rsqf(ss * (1.0f / 64.0f) + RMS_EPS);
                    v00 = v00 * *(const f32x4*)gp * rn; v01 = v01 * *(const f32x4*)(gp + 4) * rn; v10 = v10 * *(const f32x4*)(gp + 32) * rn; v11 = v11 * *(const f32x4*)(gp + 36) * rn;
                    int rp = 0, cp = 0;
                    if (row < 81920) { const int nn = row & (row < 16384 ? 4095 : 8191); rp = nn >> 6; cp = nn & 63; }
                    const float* tr = rope + (size_t)rp * 32 + 8 * fq; const float* tc = rope + (size_t)cp * 32 + 8 * fq;
                    const f32x4 r0 = *(const f32x4*)tr, r1 = *(const f32x4*)(tr + 4), c0 = *(const f32x4*)tc, c1 = *(const f32x4*)(tc + 4);
                    f32x4 o00, o01, o10, o11;
                    o00[0] = v00[0] * r0[0] - v00[1] * r0[1]; o00[1] = v00[0] * r0[1] + v00[1] * r0[0]; o00[2] = v00[2] * r0[2] - v00[3] * r0[3]; o00[3] = v00[2] * r0[3] + v00[3] * r0[2];
                    o01[0] = v01[0] * r1[0] - v01[1] * r1[1]; o01[1] = v01[0] * r1[1] + v01[1] * r1[0]; o01[2] = v01[2] * r1[2] - v01[3] * r1[3]; o01[3] = v01[2] * r1[3] + v01[3] * r1[2];
                    o10[0] = v10[0] * c0[0] - v10[1] * c0[1]; o10[1] = v10[0] * c0[1] + v10[1] * c0[0]; o10[2] = v10[2] * c0[2] - v10[3] * c0[3]; o10[3] = v10[2] * c0[3] + v10[3] * c0[2];
                    o11[0] = v11[0] * c1[0] - v11[1] * c1[1]; o11[1] = v11[0] * c1[1] + v11[1] * c1[0]; o11[2] = v11[2] * c1[2] - v11[3] * c1[3]; o11[3] = v11[2] * c1[3] + v11[3] * c1[2];
                    bf16_t* dp = dst + (size_t)(is_k ? kv_row(row) : row) * ldd + cb;
                    *(u32x4*)dp = pack8(o00 * osc, o01 * osc); *(u32x4*)(dp + 32) = pack8(o10 * osc, o11 * osc); EPI_FENCE(); } }
        } else {
#pragma unroll
            for (int ai = 0; ai < 2; ++ai) { EPI_RS4(rs4);
#pragma unroll
                for (int m = 0; m < 4; ++m) { const int row = row0 + ai * HALF + m * 16; const float rs = rs4[m];
                    bf16_t* dp = dst + (size_t)(hd < 12 ? kv_row(row) : row) * ldd + cb;
                    *(u32x4*)dp = pack8(acc[ai][0][m][0] * rs, acc[ai][0][m][1] * rs); *(u32x4*)(dp + 32) = pack8(acc[ai][1][m][0] * rs, acc[ai][1][m][1] * rs); EPI_FENCE(); } }
        }
    }
};

template <class Epi, class Sched, bool ALIGN_EPI = false, bool SP2 = false>
__device__ __forceinline__ void gemm_phase(PG8_LAS unsigned char* lds, const Gemm g, const Sched& S, const Epi& E) {
    int tid_ = threadIdx.x; asm volatile("" : "+v"(tid_));
    const int tid = tid_, wid = __builtin_amdgcn_readfirstlane(tid >> 6), lane = tid & 63, wr = wid >> 2, wc = wid & 3, fr = lane & 15, fq = lane >> 4;
    const int K = g.K, nt = K / BK;
    unsigned voffA[2], voffB[2];
#pragma unroll
    for (int i = 0; i < 2; ++i) { int R, C; stage_rc(tid * 16 + i * 8192, R, C); const int Rb = Epi::PERM ? ((R & ~31) + perm32(R & 31)) : R;
        voffA[i] = (unsigned)(R * K + C) * 2u; voffB[i] = (unsigned)(Rb * K + C) * 2u; }
    const size_t kstep = (size_t)(BK * 2);
    const size_t hstep = (size_t)HALF * K * 2;
    const size_t tstep = 2 * hstep;
    const unsigned ldsw = (unsigned)wid * 1024u;
    const int aoff = lds_byte(wr * 64 + fr, fq * 8), boff = lds_byte(wc * 32 + fr, fq * 8);
#define PG8_SA(b, h) (((b) * 2 + (h)) * HTB)
#define PG8_SB(b, h) ((4 + (b) * 2 + (h)) * HTB)
#define PG8_STAGE(bufoff, gbase, voff) do { _Pragma("unroll") for (int _i = 0; _i < 2; ++_i) \
        __builtin_amdgcn_global_load_lds((const unsigned*)((const char*)(gbase) + (voff)[_i]), (PG8_LAS unsigned*)(lds + (bufoff) + ldsw + _i * 8192), 16, 0, 0); } while (0)
#define PG8_LDA(dst, b, h) do { _Pragma("unroll") for (int m = 0; m < 4; ++m) _Pragma("unroll") for (int k = 0; k < 2; ++k) dst[m][k] = *(const PG8_LAS bf16x8*)(lds + PG8_SA(b, h) + aoff + m * 2048 + k * 1024); } while (0)
#define PG8_LDB(dst, b, h) do { _Pragma("unroll") for (int n = 0; n < 2; ++n) _Pragma("unroll") for (int k = 0; k < 2; ++k) dst[n][k] = *(const PG8_LAS bf16x8*)(lds + PG8_SB(b, h) + boff + n * 2048 + k * 1024); } while (0)
#define PG8_MMA(ai, bj, At, Bt) do { __builtin_amdgcn_s_setprio(1); _Pragma("unroll") for (int m = 0; m < 4; ++m) _Pragma("unroll") for (int n = 0; n < 2; ++n) _Pragma("unroll") for (int k = 0; k < 2; ++k) \
        acc[ai][bj][m][n] = __builtin_amdgcn_mfma_f32_16x16x32_bf16(Bt[n][k], At[m][k], acc[ai][bj][m][n], 0, 0, 0); __builtin_amdgcn_s_setprio(0); } while (0)
#define PG8_WAIT_V(n) asm volatile("s_waitcnt vmcnt(" #n ")" ::: "memory")
#define PG8_WAIT_L(n) asm volatile("s_waitcnt lgkmcnt(" #n ")" ::: "memory")
#define PG8_BAR __builtin_amdgcn_s_barrier()
#define PG8_SCHED __builtin_amdgcn_sched_barrier(0)
    Unit cur, nxt; int ui = 0;
    if (!S.next(0, cur)) return;
    f32x4 acc[2][2][4][2];
#pragma unroll
    for (int a = 0; a < 2; ++a)
#pragma unroll
        for (int b = 0; b < 2; ++b)
#pragma unroll
            for (int m = 0; m < 4; ++m)
#pragma unroll
                for (int n = 0; n < 2; ++n) acc[a][b][m][n] = (f32x4){0.f, 0.f, 0.f, 0.f};
    bf16x8 At[4][2], B0[2][2], B1[2][2];
    const char* cA = (const char*)g.A + (size_t)cur.pm * tstep; const char* cB = (const char*)g.Bt + (size_t)cur.pn * tstep;
    S.a_ready(cur);
    if constexpr (SP2) {
        PG8_STAGE(PG8_SB(0, 0), cB, voffB); PG8_STAGE(PG8_SB(0, 1), cB + hstep, voffB); PG8_STAGE(PG8_SA(0, 0), cA, voffA); PG8_STAGE(PG8_SA(0, 1), cA + hstep, voffA);
        if (wr == 1) PG8_BAR;
        PG8_WAIT_V(2); PG8_BAR;
        PG8_STAGE(PG8_SB(1, 0), cB + kstep, voffB); PG8_STAGE(PG8_SA(1, 0), cA + kstep, voffA); PG8_STAGE(PG8_SB(1, 1), cB + hstep + kstep, voffB);
        PG8_WAIT_V(6); PG8_BAR;
    } else {
        PG8_STAGE(PG8_SB(0, 0), cB, voffB); PG8_STAGE(PG8_SA(0, 0), cA, voffA); PG8_STAGE(PG8_SB(0, 1), cB + hstep, voffB); PG8_STAGE(PG8_SA(0, 1), cA + hstep, voffA);
        if (wr == 1) PG8_BAR;
        PG8_WAIT_V(4); PG8_BAR;
        PG8_STAGE(PG8_SB(1, 0), cB + kstep, voffB); PG8_STAGE(PG8_SA(1, 0), cA + kstep, voffA); PG8_STAGE(PG8_SB(1, 1), cB + hstep + kstep, voffB);
        PG8_WAIT_V(6); PG8_BAR;
    }
    for (;;) {
        const bool has_next = S.next(ui + 1, nxt);
        const char* nA = has_next ? (const char*)g.A + (size_t)nxt.pm * tstep : cA; const char* nB = has_next ? (const char*)g.Bt + (size_t)nxt.pn * tstep : cB;
        for (int t = 0; t < nt; t += 2) {
            const bool last = (t == nt - 2);
            const char* a1 = cA + (size_t)(t + 1) * kstep;
            const char* a2 = last ? nA : cA + (size_t)(t + 2) * kstep; const char* b2 = last ? nB : cB + (size_t)(t + 2) * kstep;
            const char* a3 = a2 + kstep; const char* b3 = b2 + kstep;
            if (last && has_next) S.a_ready(nxt);
            if constexpr (SP2) {
            PG8_LDB(B0, 0, 0); PG8_LDB(B1, 0, 1); PG8_SCHED; PG8_LDA(At, 0, 0); PG8_STAGE(PG8_SA(1, 1), a1 + hstep, voffA);
            PG8_WAIT_V(8); PG8_WAIT_L(0); PG8_BAR; PG8_MMA(0, 0, At, B0); PG8_MMA(0, 1, At, B1); PG8_BAR; PG8_SCHED;
            PG8_LDA(At, 0, 1); PG8_STAGE(PG8_SB(0, 0), b2, voffB); PG8_STAGE(PG8_SB(0, 1), b2 + hstep, voffB); PG8_STAGE(PG8_SA(0, 0), a2, voffA);
            PG8_WAIT_V(8); PG8_WAIT_L(0); PG8_BAR; PG8_MMA(1, 0, At, B0); PG8_MMA(1, 1, At, B1); PG8_BAR; PG8_SCHED;
            PG8_LDB(B0, 1, 0); PG8_LDB(B1, 1, 1); PG8_SCHED; PG8_LDA(At, 1, 0); PG8_STAGE(PG8_SA(0, 1), a2 + hstep, voffA);
            PG8_WAIT_V(8); PG8_WAIT_L(0); PG8_BAR; PG8_MMA(0, 0, At, B0); PG8_MMA(0, 1, At, B1); PG8_BAR; PG8_SCHED;
            PG8_LDA(At, 1, 1); PG8_STAGE(PG8_SB(1, 0), b3, voffB); PG8_STAGE(PG8_SB(1, 1), b3 + hstep, voffB); PG8_STAGE(PG8_SA(1, 0), a3, voffA);
            PG8_WAIT_V(8); PG8_WAIT_L(0); PG8_BAR; PG8_MMA(1, 0, At, B0); PG8_MMA(1, 1, At, B1); PG8_BAR; PG8_SCHED;
            } else {
            PG8_LDB(B0, 0, 0); PG8_SCHED; PG8_LDA(At, 0, 0); PG8_STAGE(PG8_SA(1, 1), a1 + hstep, voffA);
            PG8_WAIT_L(8); PG8_BAR; PG8_WAIT_L(0); PG8_MMA(0, 0, At, B0); PG8_BAR; PG8_SCHED;
            PG8_LDB(B1, 0, 1); PG8_STAGE(PG8_SB(0, 0), b2, voffB);
            PG8_BAR; PG8_WAIT_L(0); PG8_MMA(0, 1, At, B1); PG8_BAR;
            PG8_LDA(At, 0, 1); PG8_STAGE(PG8_SA(0, 0), a2, voffA);
            PG8_BAR; PG8_WAIT_L(0); PG8_MMA(1, 0, At, B0); PG8_BAR; PG8_SCHED;
            PG8_STAGE(PG8_SB(0, 1), b2 + hstep, voffB);
            PG8_WAIT_V(6); PG8_BAR; PG8_MMA(1, 1, At, B1); PG8_BAR;
            PG8_LDB(B0, 1, 0); PG8_SCHED; PG8_LDA(At, 1, 0); PG8_STAGE(PG8_SA(0, 1), a2 + hstep, voffA);
            PG8_WAIT_L(8); PG8_BAR; PG8_WAIT_L(0); PG8_MMA(0, 0, At, B0); PG8_BAR; PG8_SCHED;
            PG8_LDB(B1, 1, 1); PG8_STAGE(PG8_SB(1, 0), b3, voffB);
            PG8_BAR; PG8_WAIT_L(0); PG8_MMA(0, 1, At, B1); PG8_BAR;
            PG8_LDA(At, 1, 1); PG8_STAGE(PG8_SA(1, 0), a3, voffA);
            PG8_BAR; PG8_WAIT_L(0); PG8_MMA(1, 0, At, B0); PG8_BAR; PG8_SCHED;
            PG8_STAGE(PG8_SB(1, 1), b3 + hstep, voffB);
            PG8_WAIT_V(6); PG8_BAR; PG8_MMA(1, 1, At, B1); PG8_BAR;
            }
        }
        if constexpr (ALIGN_EPI) { if (wr == 0) PG8_BAR; }
        if constexpr (!Epi::AFTER_DRAIN) { E(acc, cur, wr, wc, fr, fq); S.done(cur); }
        if (!has_next) break;
#pragma unroll
        for (int a = 0; a < 2; ++a)
#pragma unroll
            for (int b = 0; b < 2; ++b)
#pragma unroll
                for (int m = 0; m < 4; ++m)
#pragma unroll
                    for (int n = 0; n < 2; ++n) acc[a][b][m][n] = (f32x4){0.f, 0.f, 0.f, 0.f};
        cur = nxt; cA = nA; cB = nB; ++ui;
        if constexpr (ALIGN_EPI) { if (wr == 1) PG8_BAR; }
    }
    PG8_WAIT_V(0);
    if constexpr (!ALIGN_EPI) { if (wr == 0) PG8_BAR; }
    PG8_BAR;
    if constexpr (Epi::AFTER_DRAIN) { E.fused(acc, cur, wr, wc, fr, fq, lds, wid, lane); S.done(cur); }
#undef PG8_SA
#undef PG8_SB
#undef PG8_STAGE
#undef PG8_LDA
#undef PG8_LDB
#undef PG8_MMA
#undef PG8_WAIT_V
#undef PG8_WAIT_L
#undef PG8_BAR
#undef PG8_SCHED
}
}

namespace attn_body {
using bf16=__hip_bfloat16;
using bf16x8=__attribute__((ext_vector_type(8)))short;
using s16x4=__attribute__((ext_vector_type(4)))short;
using f32x16=__attribute__((ext_vector_type(16)))float;
using u32x4=__attribute__((ext_vector_type(4)))unsigned;
constexpr int D=64,QP=512,KP=128,OP=1024;
typedef float f32x4 __attribute__((ext_vector_type(4)));
constexpr int NW=8,QBLK=32,QB=QBLK*NW,KVBLK=64;
__device__ __forceinline__ int crow(int r,int hi){return (r&3)+8*(r>>2)+4*hi;}
#define SBAR() __builtin_amdgcn_sched_barrier(0)
#define ATTN_STORE16(p,v) (*(u32x4*)(p)=(v))
__device__ __forceinline__ void mmask(f32x16&p0,f32x16&p1,bool any,bool all){
  const float NEG=-INFINITY;
  #pragma unroll
  for(int r=0;r<16;++r){p1[r]=any?NEG:p1[r]; p0[r]=((r>=8)?any:all)?NEG:p0[r];}
}
constexpr int NSLOT=3, SLOTB=8192;
constexpr int LDS_K=0, LDS_V=NSLOT*SLOTB, LDS_WS=2*NSLOT*SLOTB, LDS_OST=LDS_WS+NW*64*4, LDS_BYTES=LDS_OST+NW*4096;
constexpr float C2=0.125f*1.4426950408889634f;
__device__ __forceinline__ void glds16(const void*gsrc,unsigned lds_dst){unsigned keep;
  asm volatile("s_mov_b32 %0, m0\n\ts_mov_b32 m0, %2\n\ts_nop 0\n\tglobal_load_lds_dwordx4 %1, off\n\ts_mov_b32 m0, %0":"=&s"(keep):"v"(gsrc),"s"(lds_dst):"memory");}
__device__ __forceinline__ float max3f(float a,float b,float c){float r;asm("v_max3_f32 %0, %1, %2, %3":"=v"(r):"v"(a),"v"(b),"v"(c));return r;}
__device__ __forceinline__ float max2f(float a,float b){float r;asm("v_max_f32_e32 %0, %1, %2":"=v"(r):"v"(a),"v"(b));return r;}
__device__ __forceinline__ float fadd_s(float a,float b){float r;asm("v_add_f32_e32 %0, %1, %2":"=v"(r):"v"(a),"v"(b));return r;}
__device__ __forceinline__ float fsub_s(float a,float b){float r;asm("v_sub_f32_e32 %0, %1, %2":"=v"(r):"v"(a),"v"(b));return r;}
typedef float f32x2_t __attribute__((ext_vector_type(2))); typedef __bf16 bf16x2_t __attribute__((ext_vector_type(2)));
__device__ __forceinline__ unsigned cvtpk_s(float lo,float hi){f32x2_t v={lo,hi};bf16x2_t b=__builtin_convertvector(v,bf16x2_t);return __builtin_bit_cast(unsigned,b);}
#define WAIT_BAR(N) asm volatile("s_waitcnt vmcnt(" #N ") lgkmcnt(0)\n\ts_barrier":::"memory")

__device__ __forceinline__ void qkt(f32x16&p0,f32x16&p1,const char*Kslot,const bf16x8*qr,const f32x16&negm,int r32,int hi){
  const char*kb=Kslot+hi*1024+r32*16;
  #pragma unroll
  for(int d0=0;d0<4;++d0){
    const bf16x8 b0=*reinterpret_cast<const bf16x8*>(kb+d0*2048);
    const bf16x8 b1=*reinterpret_cast<const bf16x8*>(kb+d0*2048+512);
    if(d0==0){p0=__builtin_amdgcn_mfma_f32_32x32x16_bf16(b0,qr[0],negm,0,0,0);p1=__builtin_amdgcn_mfma_f32_32x32x16_bf16(b1,qr[0],negm,0,0,0);}
    else{p0=__builtin_amdgcn_mfma_f32_32x32x16_bf16(b0,qr[d0],p0,0,0,0);p1=__builtin_amdgcn_mfma_f32_32x32x16_bf16(b1,qr[d0],p1,0,0,0);}}
}
typedef __attribute__((address_space(3))) const char* lds_cptr;
typedef short v4i16_t __attribute__((ext_vector_type(4)));
__device__ __forceinline__ void kload8(bf16x8*kf,lds_cptr kp){
  kf[0]=*(const __attribute__((address_space(3))) bf16x8*)(kp);      kf[1]=*(const __attribute__((address_space(3))) bf16x8*)(kp+512);
  kf[2]=*(const __attribute__((address_space(3))) bf16x8*)(kp+2048); kf[3]=*(const __attribute__((address_space(3))) bf16x8*)(kp+2560);
  kf[4]=*(const __attribute__((address_space(3))) bf16x8*)(kp+4096); kf[5]=*(const __attribute__((address_space(3))) bf16x8*)(kp+4608);
  kf[6]=*(const __attribute__((address_space(3))) bf16x8*)(kp+6144); kf[7]=*(const __attribute__((address_space(3))) bf16x8*)(kp+6656);
}
__device__ __forceinline__ void kload2(bf16x8*kf,lds_cptr kp,int j){ kf[2*j]=*(const __attribute__((address_space(3))) bf16x8*)(kp+j*2048); kf[2*j+1]=*(const __attribute__((address_space(3))) bf16x8*)(kp+j*2048+512); }
__device__ __forceinline__ s16x4 vtr(lds_cptr p){ return __builtin_bit_cast(s16x4,__builtin_amdgcn_ds_read_tr16_b64_v4i16((__attribute__((address_space(3))) v4i16_t*)p)); }
__device__ __forceinline__ float rowmax(const f32x16&p0,const f32x16&p1){
  float a=max3f(p0[0],p0[1],p1[0]),b=max3f(p0[2],p0[3],p1[1]);a=max3f(a,p1[2],p1[3]);
  #pragma unroll
  for(int r=4;r<16;r+=4){a=max3f(a,p0[r],p0[r+1]);b=max3f(b,p0[r+2],p0[r+3]);a=max3f(a,p1[r],p1[r+1]);b=max3f(b,p1[r+2],p1[r+3]);}
  const float m=max2f(a,b);
  auto rr=__builtin_amdgcn_permlane32_swap(__float_as_uint(m),__float_as_uint(m),false,false);
  return max2f(__uint_as_float(rr[0]),__uint_as_float(rr[1]));
}
__device__ __forceinline__ void pv(f32x16*o,int vb,bf16x8 pa0,bf16x8 pa1,bf16x8 pa2,bf16x8 pa3){
  #pragma unroll
  for(int d0=0;d0<2;++d0){s16x4 lo[4],hi[4];
    #pragma unroll
    for(int ks=0;ks<4;++ks){
      asm volatile("ds_read_b64_tr_b16 %0,%1 offset:%c2":"=&v"(lo[ks]):"v"(vb),"i"(d0*4096+ks*1024):"memory");
      asm volatile("ds_read_b64_tr_b16 %0,%1 offset:%c2":"=&v"(hi[ks]):"v"(vb),"i"(d0*4096+ks*1024+512):"memory");}
    asm volatile("s_waitcnt lgkmcnt(0)":::"memory");SBAR();
    #define PK(k) (bf16x8){lo[k][0],lo[k][1],lo[k][2],lo[k][3],hi[k][0],hi[k][1],hi[k][2],hi[k][3]}
    o[d0]=__builtin_amdgcn_mfma_f32_32x32x16_bf16(pa0,PK(0),o[d0],0,0,0);
    o[d0]=__builtin_amdgcn_mfma_f32_32x32x16_bf16(pa1,PK(1),o[d0],0,0,0);
    o[d0]=__builtin_amdgcn_mfma_f32_32x32x16_bf16(pa2,PK(2),o[d0],0,0,0);
    o[d0]=__builtin_amdgcn_mfma_f32_32x32x16_bf16(pa3,PK(3),o[d0],0,0,0);
    #undef PK
  }
}

template<int THRL> __device__ __forceinline__ void attn_unit(long qrow0,int is_meta,long kvbase,int NR,long metarow,int h,const bf16*Q,const bf16*__restrict__ K,const bf16*__restrict__ V,bf16*O,char*shm){
  int tid_=threadIdx.x; asm volatile("":"+v"(tid_)); const int tid=tid_,lane=tid&63,r32=lane&31,hi=lane>>5; const int wid=__builtin_amdgcn_readfirstlane(tid>>6);
  const long qrow_l=is_meta?(metarow+(long)(r32&15)):(qrow0+wid*QBLK+r32);
  const int h_l=is_meta?(h+2*(wid&1)+(r32>>4)):h;
  const bf16*Qw=Q+qrow_l*QP+h_l*D;
  const bf16*Kh=K+(h>>2)*D,*Vh=V+(h>>2)*D;
  const unsigned lds0=(unsigned)(uintptr_t)shm;
  float*wsf=(float*)(shm+LDS_WS)+wid*64;
  const bf16*ksrc=Kh+(long)lane*KP+wid*8;
  const bf16*vsrc=Vh+(long)(16*(wid&3)+(lane>>2))*KP+(wid>>2)*32+(lane&3)*8;
  #define TROW(t) (kvbase+(long)(t)*KVBLK)
  const unsigned kdst=lds0+LDS_K+wid*1024, vdst=lds0+LDS_V+wid*1024;
  #define DMA_K(t,slot) glds16(ksrc+TROW(t)*KP,(unsigned)__builtin_amdgcn_readfirstlane(kdst+(slot)))
  #define DMA_V(t,slot) glds16(vsrc+TROW(t)*KP,(unsigned)__builtin_amdgcn_readfirstlane(vdst+(slot)))
  const int vb0=(int)(lds0+LDS_V)+((lane>>4)&1)*32+(lane&3)*8+(4*hi+((lane&15)>>2))*64;
  const char*Kbase=shm+LDS_K; bf16x8 kf[8];
  const lds_cptr shm3=(lds_cptr)shm; const lds_cptr kp0=shm3+LDS_K+hi*1024+r32*16; const lds_cptr vp0=shm3+LDS_V+((lane>>4)&1)*32+(lane&3)*8+(4*hi+((lane&15)>>2))*64;
  const int NT=NR+2;
  DMA_K(0,0);DMA_V(0,0);DMA_K(1,SLOTB);
  bf16x8 qr[4];
  #pragma unroll
  for(int d0=0;d0<4;++d0)qr[d0]=*reinterpret_cast<const bf16x8*>(&Qw[d0*16+hi*8]);
  float mhat=0.f,l_reg=0.f;f32x16 o[2];o[0]=f32x16{};o[1]=f32x16{};f32x16 negm=f32x16{};asm volatile("":"+v"(negm));
  #define CMASK(P0,P1,t) do{ mmask(P0,P1,(t)>=NT-2,(t)==NT-1); }while(0)
  bool resc=false;
  #define START(P0,P1) do{ const float rm=rowmax(P0,P1); resc=false; \
    { const float dl=rm; mhat=fadd_s(mhat,dl); \
      _Pragma("unroll") for(int r=0;r<16;++r){P0[r]=fsub_s(P0[r],dl);P1[r]=fsub_s(P1[r],dl);} \
      _Pragma("unroll") for(int r=0;r<16;++r)negm[r]=-mhat; asm volatile("":"+v"(negm)); } \
    _Pragma("unroll") for(int r=0;r<16;++r)P0[r]=__builtin_amdgcn_exp2f(P0[r]); }while(0)
  #define RESC() do{ if(resc){ asm volatile("s_waitcnt lgkmcnt(0)":::"memory"); \
      _Pragma("unroll") for(int d_=0;d_<2;++d_) _Pragma("unroll") for(int r=0;r<16;++r)o[d_][r]*=wsf[crow(r,hi)]; } }while(0)
  f32x16 pA0,pA1,pB0,pB1;
  int sl_prev=0,sl_cur=0,sl_next=SLOTB;
  #define ROT() do{sl_prev=sl_cur;sl_cur=sl_next;sl_next=(sl_next==(NSLOT-1)*SLOTB)?0:sl_next+SLOTB;}while(0)
  DMA_K(2,2*SLOTB);
  WAIT_BAR(3);
  qkt(pA0,pA1,Kbase,qr,negm,r32,hi);asm volatile("s_nop 15\n\ts_nop 7":"+v"(pA0),"+v"(pA1));
  START(pA0,pA1);
  _Pragma("unroll") for(int r=0;r<16;++r)pA1[r]=__builtin_amdgcn_exp2f(pA1[r]);
  WAIT_BAR(0);
  DMA_K(3,0);DMA_V(1,SLOTB);
  ROT();
  kload8(kf,kp0+sl_cur);
  WAIT_BAR(2);
  s16x4 vlo[8],vhi[8]; u32x4 pw0,pw1,pw2,pw3;
  #define PKW(P,B) cvtpk_s(P[B],P[B+1])
  #define PAF(k) __builtin_bit_cast(bf16x8,pw##k)
  #define VFR(i) (bf16x8){vlo[i][0],vlo[i][1],vlo[i][2],vlo[i][3],vhi[i][0],vhi[i][1],vhi[i][2],vhi[i][3]}
  #define PIN(x) asm volatile("":"+v"(x))
  #define MX3(a,b,c) __builtin_fmaxf(__builtin_fmaxf((a),(b)),(c))
  #define GAPA(MF,A0,A1,A2,A3,W0,W1,PW) do{ MF; sacc+=A0; sacc+=A1; sacc+=A2; sacc+=A3; PIN(sacc); W0; W1; PIN(PW); SBAR(); }while(0)
  #define EX(v) __builtin_amdgcn_exp2f(v)
  #define GAPB(MF,X,B) do{ MF; X[B]=EX(X[B]); X[B+1]=EX(X[B+1]); X[B+2]=EX(X[B+2]); X[B+3]=EX(X[B+3]); PIN(X); SBAR(); }while(0)
  #define VRD(i) do{ vlo[i]=vtr(vp_+(((i)>>2)*4096+((i)&3)*1024)); vhi[i]=vtr(vp_+(((i)>>2)*4096+((i)&3)*1024+512)); }while(0)
  #define KRD(G,j) do{ if(G){ kload2(kf,kp0+sl_next,j); SBAR(); } }while(0)
  #define STEP(C0,C1,P0,P1,t,GK,GV,GL) do{ SBAR(); \
    const lds_cptr vp_=vp0+sl_prev; \
    VRD(0); SBAR(); float sacc=(P0[0]+P0[1]); \
    GAPA(C0=__builtin_amdgcn_mfma_f32_32x32x16_bf16(kf[0],qr[0],negm,0,0,0), P0[2],P0[3],P0[4],P0[5],     pw0[0]=PKW(P0,0), pw0[1]=PKW(P0,2), pw0); \
    VRD(4); SBAR(); GAPA(C1=__builtin_amdgcn_mfma_f32_32x32x16_bf16(kf[1],qr[0],negm,0,0,0), P0[6],P0[7],P0[8],P0[9],     pw0[2]=PKW(P0,4), pw0[3]=PKW(P0,6), pw0); \
    VRD(1); SBAR(); GAPA(C0=__builtin_amdgcn_mfma_f32_32x32x16_bf16(kf[2],qr[1],C0,0,0,0),   P0[10],P0[11],P0[12],P0[13], pw1[0]=PKW(P0,8), pw1[1]=PKW(P0,10), pw1); \
    VRD(5); SBAR(); GAPA(C1=__builtin_amdgcn_mfma_f32_32x32x16_bf16(kf[3],qr[1],C1,0,0,0),   P0[14],P0[15],P1[0],P1[1],   pw1[2]=PKW(P0,12),pw1[3]=PKW(P0,14), pw1); \
    VRD(2); SBAR(); GAPA(C0=__builtin_amdgcn_mfma_f32_32x32x16_bf16(kf[4],qr[2],C0,0,0,0),   P1[2],P1[3],P1[4],P1[5],     pw2[0]=PKW(P1,0), pw2[1]=PKW(P1,2), pw2); \
    VRD(6); SBAR(); GAPA(C1=__builtin_amdgcn_mfma_f32_32x32x16_bf16(kf[5],qr[2],C1,0,0,0),   P1[6],P1[7],P1[8],P1[9],     pw2[2]=PKW(P1,4), pw2[3]=PKW(P1,6), pw2); \
    VRD(3); SBAR(); GAPA(C0=__builtin_amdgcn_mfma_f32_32x32x16_bf16(kf[6],qr[3],C0,0,0,0),   P1[10],P1[11],P1[12],P1[13], pw3[0]=PKW(P1,8), pw3[1]=PKW(P1,10), pw3); \
    VRD(7); SBAR(); GAPA(C1=__builtin_amdgcn_mfma_f32_32x32x16_bf16(kf[7],qr[3],C1,0,0,0),   P1[14],P1[15],0.f,0.f,       pw3[2]=PKW(P1,12),pw3[3]=PKW(P1,14), pw3); \
    l_reg+=sacc; \
    if(GK){DMA_K((t)+3,sl_cur);} if(GV){DMA_V((t)+1,sl_next);} \
    CMASK(C0,C1,t); \
    { float a=MX3(C0[0],C0[1],C1[0]),b=MX3(C0[2],C0[3],C1[1]); a=MX3(a,C1[2],C1[3]); \
      _Pragma("unroll") for(int r=4;r<16;r+=4){a=MX3(a,C0[r],C0[r+1]);b=MX3(b,C0[r+2],C0[r+3]);a=MX3(a,C1[r],C1[r+1]);b=MX3(b,C1[r+2],C1[r+3]);} \
      float rm=__builtin_fmaxf(a,b); { auto rr=__builtin_amdgcn_permlane32_swap(__float_as_uint(rm),__float_as_uint(rm),false,false); rm=__builtin_fmaxf(__uint_as_float(rr[0]),__uint_as_float(rr[1])); } \
      resc=false; \
      if(__builtin_expect(__any(rm>(float)THRL),0)){ const float dl=__builtin_fmaxf(rm,0.f); mhat+=dl; \
        _Pragma("unroll") for(int r=0;r<16;++r){C0[r]-=dl;C1[r]-=dl;} \
        _Pragma("unroll") for(int r=0;r<16;++r)negm[r]=-mhat; asm volatile("":"+v"(negm)); \
        const float f=__builtin_amdgcn_exp2f(-dl); l_reg*=f; if(hi==0)wsf[r32]=f; resc=true; } } \
    SBAR(); \
    GAPB(o[0]=__builtin_amdgcn_mfma_f32_32x32x16_bf16(PAF(0),VFR(0),o[0],0,0,0), C0,0); \
    GAPB(o[1]=__builtin_amdgcn_mfma_f32_32x32x16_bf16(PAF(0),VFR(4),o[1],0,0,0), C0,4); \
    KRD(GL,0); GAPB(o[0]=__builtin_amdgcn_mfma_f32_32x32x16_bf16(PAF(1),VFR(1),o[0],0,0,0), C0,8); \
    KRD(GL,1); GAPB(o[1]=__builtin_amdgcn_mfma_f32_32x32x16_bf16(PAF(1),VFR(5),o[1],0,0,0), C0,12); \
    KRD(GL,2); GAPB(o[0]=__builtin_amdgcn_mfma_f32_32x32x16_bf16(PAF(2),VFR(2),o[0],0,0,0), C1,0); \
    KRD(GL,3); GAPB(o[1]=__builtin_amdgcn_mfma_f32_32x32x16_bf16(PAF(2),VFR(6),o[1],0,0,0), C1,4); \
    GAPB(o[0]=__builtin_amdgcn_mfma_f32_32x32x16_bf16(PAF(3),VFR(3),o[0],0,0,0), C1,8); \
    GAPB(o[1]=__builtin_amdgcn_mfma_f32_32x32x16_bf16(PAF(3),VFR(7),o[1],0,0,0), C1,12); \
    }while(0)
  int t=1;
  #undef CMASK
  #define CMASK(P0,P1,t) do{}while(0)
  for(;t+5<NT;t+=2){
    STEP(pB0,pB1,pA0,pA1,t,true,true,true);     WAIT_BAR(2); RESC(); ROT();
    STEP(pA0,pA1,pB0,pB1,t+1,true,true,true);   WAIT_BAR(2); RESC(); ROT();
  }
  #undef CMASK
  #define CMASK(P0,P1,t) do{ mmask(P0,P1,(t)>=NT-2,(t)==NT-1); }while(0)
  #define ENDW(tt) do{ if((tt)+3<NT){WAIT_BAR(2);} else if((tt)+2<NT){WAIT_BAR(1);} else {WAIT_BAR(0);} }while(0)
  for(;t+1<NT;t+=2){
    STEP(pB0,pB1,pA0,pA1,t,(t+3<NT),(t+1<NT),(t+1<NT));       ENDW(t);   RESC(); ROT();
    STEP(pA0,pA1,pB0,pB1,t+1,(t+4<NT),(t+2<NT),(t+2<NT));     ENDW(t+1); RESC(); ROT();
  }
  STEP(pB0,pB1,pA0,pA1,NT-1,false,false,false); RESC();
  { float sacc=pB0[0]+pB0[1]; _Pragma("unroll") for(int r=2;r<16;++r)sacc+=pB0[r]; _Pragma("unroll") for(int r=0;r<16;++r)sacc+=pB1[r]; l_reg+=sacc;
    pw0=(u32x4){PKW(pB0,0),PKW(pB0,2),PKW(pB0,4),PKW(pB0,6)};pw1=(u32x4){PKW(pB0,8),PKW(pB0,10),PKW(pB0,12),PKW(pB0,14)};pw2=(u32x4){PKW(pB1,0),PKW(pB1,2),PKW(pB1,4),PKW(pB1,6)};pw3=(u32x4){PKW(pB1,8),PKW(pB1,10),PKW(pB1,12),PKW(pB1,14)};
    SBAR(); pv(o,vb0+sl_cur,PAF(0),PAF(1),PAF(2),PAF(3)); }
  #undef PKW
  #undef PAF
  #undef VFR
  #undef PIN
  #undef MX3
  #undef GAPA
  #undef GAPB
  #undef EX
  #undef VRD
  #undef KRD
  #undef STEP
  #undef ENDW
  {auto rr=__builtin_amdgcn_permlane32_swap(__float_as_uint(l_reg),__float_as_uint(l_reg),false,false);l_reg=__uint_as_float(rr[0])+__uint_as_float(rr[1]);}
  if(hi==0)wsf[32+r32]=l_reg;asm volatile("s_waitcnt lgkmcnt(0)":::"memory");
  float rli[16];
  #pragma unroll
  for(int r=0;r<16;++r)rli[r]=__builtin_amdgcn_rcpf(wsf[32+crow(r,hi)]);
  { bf16*stg=(bf16*)(shm+LDS_OST)+wid*2048;
    #pragma unroll
    for(int r=0;r<16;++r){const int orow=crow(r,hi);
      #pragma unroll
      for(int d0=0;d0<2;++d0)stg[orow*64+d0*32+r32]=__float2bfloat16(o[d0][r]*rli[r]);}
    asm volatile("s_waitcnt lgkmcnt(0)":::"memory");
    #pragma unroll
    for(int i=0;i<4;++i){const int row=i*8+(lane>>3),ch=lane&7; const u32x4 w=*(const u32x4*)(stg+row*64+ch*8);
      float x[8];
      #pragma unroll
      for(int e=0;e<4;++e){x[2*e]=__uint_as_float(w[e]<<16); x[2*e+1]=__uint_as_float(w[e]&0xffff0000u);}
      float ss=((x[0]*x[0]+x[1]*x[1])+(x[2]*x[2]+x[3]*x[3]))+((x[4]*x[4]+x[5]*x[5])+(x[6]*x[6]+x[7]*x[7]));
      ss+=__shfl_xor(ss,1); ss+=__shfl_xor(ss,2); ss+=__shfl_xor(ss,4);
      const float rn=rsqrtf(ss*(1.0f/64.0f)+1e-6f);
      u32x4 v; v.x=cvtpk_s(x[0]*rn,x[1]*rn); v.y=cvtpk_s(x[2]*rn,x[3]*rn); v.z=cvtpk_s(x[4]*rn,x[5]*rn); v.w=cvtpk_s(x[6]*rn,x[7]*rn);
      const long orow_g=is_meta?(metarow+(row&15)):(qrow0+wid*QBLK+row);
      const int h_o=is_meta?(h+2*wid+(row>>4)):h;
      const bool ok=(!is_meta)||(wid<2);
      if(ok) ATTN_STORE16(O+orow_g*OP+h_o*D+ch*8,v);} }
  asm volatile("s_waitcnt lgkmcnt(0)\n\ts_barrier":::"memory");
  #undef DMA_K
  #undef TROW
  #undef DMA_V
  #undef CMASK
  #undef START
  #undef RESC
  #undef ROT
}
constexpr int ATTN_LDS_BYTES=LDS_BYTES;
#undef SBAR
#undef WAIT_BAR
}

constexpr int NWAVES = 8;
constexpr int DM = 1024, DFF = 2816, NIN = 2304, DEPTH = 4;
constexpr int NREAL = 81920, MB = 81920, MP = 82688;
constexpr int NSEQ = 12;
constexpr size_t MiB = 1u << 20;
constexpr size_t WS_CTL = 0, WS_ROPE = 65536, WS_STATS = 131072, WS_W = 6 * MiB, WS_H = 165 * MiB, WS_BIG = 327 * MiB;
constexpr size_t WS_END = WS_BIG + (size_t)MP * 2816 * 2;
constexpr size_t W_GU = (size_t)2 * DFF * DM, W_D = (size_t)DM * DFF, W_IN = (size_t)NIN * DM, W_OUT = (size_t)DM * DM;
constexpr size_t WL_1GU = 0, WL_1D = WL_1GU + W_GU, WL_IN = WL_1D + W_D, WL_OUT = WL_IN + W_IN, WL_2GU = WL_OUT + W_OUT, WL_2D = WL_2GU + W_GU, WL_SZ = WL_2D + W_D;
static_assert(WS_STATS + (size_t)MP * 16 * 4 <= WS_W && WS_W + WL_SZ * 2 * DEPTH <= WS_H && WS_H + (size_t)MP * DM * 2 <= WS_BIG, "ws map");
constexpr int CTL_WORDS = 16384, CW_BAR = 4096;
constexpr int RING_BYTES = 131072, LDS_BYTES = 147456;
static_assert(attn_body::ATTN_LDS_BYTES <= RING_BYTES, "attention LDS");

#define LAS __attribute__((address_space(3)))
typedef unsigned short bf16;
typedef unsigned v4u __attribute__((ext_vector_type(4)));
typedef float f32x4 __attribute__((ext_vector_type(4)));
__device__ __forceinline__ unsigned f2bf(float f) { unsigned u = __builtin_bit_cast(unsigned, f); return (u + 0x7fffu + ((u >> 16) & 1u)) >> 16; }
__device__ __forceinline__ unsigned pk2(float lo, float hi) { return f2bf(lo) | (f2bf(hi) << 16); }
__device__ __forceinline__ float bflo(unsigned w) { return __builtin_bit_cast(float, w << 16); }
__device__ __forceinline__ float bfhi(unsigned w) { return __builtin_bit_cast(float, w & 0xffff0000u); }
__device__ __forceinline__ float wave_sum(float v) {
#pragma unroll
    for (int o = 1; o < 64; o <<= 1) v += __shfl_xor(v, o);
    return v;
}
__device__ __forceinline__ void tr_item(const float* W, int K, int N, const float* gain, bf16* WT, int drow0, LAS float* scr, int k0, int n0, int lane) {
#pragma unroll 16
    for (int i = 0; i < 32; ++i) { const int kk = 2 * i + (lane >> 5); const float g = gain ? gain[k0 + kk] : 1.0f; scr[kk * 33 + (lane & 31)] = g * W[(size_t)(k0 + kk) * N + n0 + (lane & 31)]; }
    asm volatile("s_waitcnt lgkmcnt(0)" ::: "memory");
    const int c = lane & 7;
#pragma unroll
    for (int j = 0; j < 4; ++j) { const int n = (lane >> 3) + 8 * j; const LAS float* s = scr + (8 * c) * 33 + n;
        v4u o; o.x = pk2(s[0 * 33], s[1 * 33]); o.y = pk2(s[2 * 33], s[3 * 33]); o.z = pk2(s[4 * 33], s[5 * 33]); o.w = pk2(s[6 * 33], s[7 * 33]);
        *(v4u*)(WT + (size_t)(drow0 + n) * K + k0 + 8 * c) = o; }
    asm volatile("s_waitcnt lgkmcnt(0)" ::: "memory");
}
__device__ __forceinline__ int win_drow(int n0) {
    if (n0 < 1280) { const int hd = n0 >> 6, bj = (n0 >> 5) & 1; return 256 * (hd >> 2) + 128 * bj + 32 * (hd & 3); }
    if (n0 < 1792) { const int t = (n0 - 1280) >> 7, w = (n0 - 1280) & 127; return 1280 + 256 * t + w; }
    { const int t = (n0 - 1792) >> 7, w = (n0 - 1792) & 127; return 1280 + 256 * t + 128 + w; }
}
__device__ __forceinline__ long seq_base(int q) { return q < 4 ? 4096L * q : 16384L + 8192L * (q - 4); }

#define GAS __attribute__((address_space(1)))
#define XB_TMO      128
#define XB_XCNT(j)  (256  + 64 * (j))
#define XB_XSUB(j)  (1280 + 64 * (j))
#define XB_XGEN(j)  (2304 + 64 * (j))
#define XB_TOP      3328
#define XB_TOPGEN   3392
#define XCD_BAR_WORDS 3456
#define XB_SPIN_CAP (1u << 18)

__device__ __forceinline__ unsigned xb_ld(unsigned* p)              { return __hip_atomic_load(p, __ATOMIC_RELAXED, __HIP_MEMORY_SCOPE_AGENT); }
__device__ __forceinline__ unsigned xb_add(unsigned* p, unsigned v) { return __hip_atomic_fetch_add(p, v, __ATOMIC_RELAXED, __HIP_MEMORY_SCOPE_AGENT); }
__device__ __forceinline__ unsigned xb_xcc_id() { return (unsigned)__builtin_amdgcn_s_getreg((3 << 11) | 20) & 0xFu; }
#define XB_SPIN(cond, bar) do { unsigned _sp = 0; while (cond) { __builtin_amdgcn_s_sleep(1); \
    if ((++_sp & 255u) == 0u) { if (xb_ld(&(bar)[XB_TMO])) break; if (_sp > XB_SPIN_CAP) { atomicAdd(&(bar)[XB_TMO], 1u); break; } } } } while (0)

struct XcdBarrier {
    unsigned* bar; unsigned x;
    volatile LAS unsigned* st;
};

__device__ __forceinline__ XcdBarrier xcd_barrier_post(unsigned* bar, volatile LAS unsigned* st) {
    XcdBarrier b; b.bar = bar; b.x = xb_xcc_id(); b.st = st;
    if (threadIdx.x == 0) (void)xb_add(&bar[XB_XCNT(b.x)], 1u);
    return b;
}
__device__ __forceinline__ void xcd_barrier_complete(unsigned* bar, unsigned x, unsigned& nloc, unsigned& nx) {
    const unsigned G = gridDim.x * gridDim.y * gridDim.z;
    unsigned sum, cnt, mine, sp = 0u;
    for (;;) {
        sum = 0u; cnt = 0u; mine = 0u;
#pragma unroll
        for (unsigned j = 0; j < 16; ++j) { const unsigned c = xb_ld(&bar[XB_XCNT(j)]); sum += c; cnt += (c > 0u) ? 1u : 0u; mine = (j == x) ? c : mine; }
        if (sum == G) break;
        __builtin_amdgcn_s_sleep(1);
        if ((++sp & 255u) == 0u) { if (xb_ld(&bar[XB_TMO])) break; if (sp > XB_SPIN_CAP) { atomicAdd(&bar[XB_TMO], 1u); break; } }
    }
    nloc = mine > 0u ? mine : 1u; nx = cnt > 0u ? cnt : 1u;
}

__device__ __forceinline__ void xcd_barrier(const XcdBarrier& b) {
    asm volatile("s_waitcnt vmcnt(0)" ::: "memory");
    __syncthreads();
    if (threadIdx.x == 0) {
        unsigned* bar = b.bar;
        __builtin_amdgcn_s_waitcnt(0);
        unsigned nloc = b.st[0], nx = b.st[1];
        if (nloc == 0u) { xcd_barrier_complete(bar, b.x, nloc, nx); b.st[0] = nloc; b.st[1] = nx; }
        const unsigned old = xb_add(&bar[XB_XSUB(b.x)], 1u);
        const unsigned gen = old / nloc;
        if (old + 1u == (gen + 1u) * nloc) {
            __builtin_amdgcn_fence(__ATOMIC_RELEASE, "agent");
            asm volatile("s_waitcnt vmcnt(0)" ::: "memory");
            const unsigned og = xb_add(&bar[XB_TOP], 1u);
            const unsigned tg = og / nx;
            if (og + 1u == (tg + 1u) * nx) xb_add(&bar[XB_TOPGEN], 1u);
            else XB_SPIN(xb_ld(&bar[XB_TOPGEN]) == tg, bar);
            __builtin_amdgcn_fence(__ATOMIC_ACQUIRE, "agent");
            xb_add(&bar[XB_XGEN(b.x)], 1u);
            asm volatile("s_waitcnt vmcnt(0)" ::: "memory");
        } else {
            XB_SPIN(xb_ld(&bar[XB_XGEN(b.x)]) == gen, bar);
            __builtin_amdgcn_fence(__ATOMIC_ACQUIRE, "agent");
            asm volatile("s_waitcnt vmcnt(0)" ::: "memory");
        }
    }
    __syncthreads();
}

static_assert(CW_BAR + XCD_BAR_WORDS <= CTL_WORDS && CTL_WORDS * 4 <= (int)WS_ROPE, "ctl map");

struct Args { const float* in[21]; float* out; unsigned char* ws; };

#define CONVERT_LAYER(LC, W0, NW) do { const int lc__ = (LC), w0__ = (W0), nw__ = (NW); { const int l = lc__; LAS float* scr = (LAS float*)(ldsp + wave * 16384); \
        constexpr int I_GU = 16 * 88, I_D = 44 * 32, I_IN = 16 * 72, I_OUT = 16 * 32, I_L = 4 * I_GU + 2 * I_D + I_IN + I_OUT; \
        for (int it = w0__; it < I_L; it += nw__) { \
            int r = it; bf16* WL = Wb + (size_t)l * WL_SZ; \
            if (r < 4 * I_GU) { const int which = r / I_GU; r %= I_GU; const int kb = r / 88, nb = r % 88, n0 = 32 * nb; \
                const float* W = args.in[(which < 2 ? 4 : 17) + (which & 1)] + (size_t)l * DM * DFF; const float* gn = args.in[which < 2 ? 3 : 16] + l * DM; \
                tr_item(W, DM, DFF, gn, WL + (which < 2 ? WL_1GU : WL_2GU), 256 * (n0 >> 7) + (n0 & 127) + ((which & 1) ? 128 : 0), scr, 64 * kb, n0, lane); continue; } \
            r -= 4 * I_GU; \
            if (r < 2 * I_D) { const int which = r / I_D; r %= I_D; const int kb = r / 32, nb = r % 32; \
                tr_item(args.in[which ? 19 : 6] + (size_t)l * DFF * DM, DFF, DM, nullptr, WL + (which ? WL_2D : WL_1D), 32 * nb, scr, 64 * kb, 32 * nb, lane); continue; } \
            r -= 2 * I_D; \
            if (r < I_IN) { const int kb = r / 72, nb = r % 72; \
                tr_item(args.in[8] + (size_t)l * DM * NIN, DM, NIN, args.in[7] + l * DM, WL + WL_IN, win_drow(32 * nb), scr, 64 * kb, 32 * nb, lane); continue; } \
            r -= I_IN; \
            { const int kb = r / 32, nb = r % 32; const int k0 = 64 * kb; \
              const float* gn = (k0 < 512) ? (args.in[13] + l * 512 + 0) : (args.in[14] + l * 512 - 512); \
              tr_item(args.in[15] + (size_t)l * DM * DM, DM, DM, gn, WL + WL_OUT, 32 * nb, scr, k0, 32 * nb, lane); } \
        } } } while (0)
__global__ void __launch_bounds__(NWAVES * 64, 2) hymba_fwd(Args args) {
    extern __shared__ __attribute__((aligned(16))) unsigned char lds[];
    cg::grid_group grid = cg::this_grid();
    const int tid = threadIdx.x, lane0 = tid & 63, wave = __builtin_amdgcn_readfirstlane(tid >> 6);
    const int G = gridDim.x, bx = blockIdx.x;
    const int gw = bx * NWAVES + wave, NGW = G * NWAVES;
    unsigned char* ws = args.ws;
    unsigned* ctl = (unsigned*)(ws + WS_CTL);
    float* rope = (float*)(ws + WS_ROPE);
    float* stats = (float*)(ws + WS_STATS);
    bf16* Wb = (bf16*)(ws + WS_W);
    bf16* HB = (bf16*)(ws + WS_H);
    bf16* BIG = (bf16*)(ws + WS_BIG);
    bf16* ACT = BIG;
    bf16* Qb = BIG; bf16* Kb = BIG + (size_t)MP * 512; bf16* Vb = BIG + (size_t)MP * 640; bf16* CBb = BIG + (size_t)MP * 768; bf16* Ub = BIG + (size_t)MP * 1280; bf16* Yb = BIG + (size_t)MP * 1792;
    LAS unsigned char* ldsp = (LAS unsigned char*)lds;
    const float* x_prompt = args.in[0]; const float* x_sample = args.in[1]; const float* meta = args.in[2];

    {
        const int lane = lane0;
        for (int i = bx * (NWAVES * 64) + tid; i < CTL_WORDS; i += G * NWAVES * 64) ctl[i] = 0u;
        if (tid < 2) ((LAS unsigned*)(ldsp + RING_BYTES + 128))[tid] = 0u;
        { const int gt = bx * (NWAVES * 64) + tid;
          if (gt < 2048) { const int pos = gt >> 4, i = gt & 15; const double fr = exp2(-(double)i * (13.287712379549449 / 16.0)); double s, c; sincos((double)pos * fr, &s, &c); rope[2 * gt] = (float)c; rope[2 * gt + 1] = (float)s; } }
        CONVERT_LAYER(0, gw, NGW);
        for (int row0 = gw; row0 < MP; row0 += 2 * NGW) {
            f32x4 v[2][4]; float ss[2]; const int rows[2] = {row0, row0 + NGW};
#pragma unroll
            for (int r = 0; r < 2; ++r) { const int row = rows[r]; const float* src = nullptr;
                if (row < 16384) src = x_prompt + (size_t)row * DM; else if (row < NREAL) src = x_sample + (size_t)(row - 16384) * DM;
                else if (row < MP) { const int i = (row - MB) & 63; if (i < 16) src = meta + (size_t)i * DM; }
#pragma unroll
                for (int j = 0; j < 4; ++j) v[r][j] = src ? ((const f32x4*)src)[lane + 64 * j] : (f32x4){0.f, 0.f, 0.f, 0.f}; }
#pragma unroll
            for (int r = 0; r < 2; ++r) { float s = 0.f;
#pragma unroll
                for (int j = 0; j < 4; ++j) s += (v[r][j][0] * v[r][j][0] + v[r][j][1] * v[r][j][1]) + (v[r][j][2] * v[r][j][2] + v[r][j][3] * v[r][j][3]);
                ss[r] = wave_sum(s); }
#pragma unroll
            for (int r = 0; r < 2; ++r) { const int row = rows[r]; if (row < MP) {
#pragma unroll
                for (int j = 0; j < 4; ++j)
                    ((unsigned long long*)(HB + (size_t)row * DM))[lane + 64 * j] = (unsigned long long)pk2(v[r][j][0], v[r][j][1]) | ((unsigned long long)pk2(v[r][j][2], v[r][j][3]) << 32);
                if (lane < 16) stats[(size_t)row * 16 + lane] = (lane == 0) ? ss[r] : 0.f; } }
        }
    }
    grid.sync();
    const XcdBarrier xbar = xcd_barrier_post(ctl + CW_BAR, (volatile LAS unsigned*)(ldsp + RING_BYTES + 128));

    for (int l = 0; l < DEPTH; ++l) {
        const bf16* WL = Wb + (size_t)l * WL_SZ;
        for (int s = 0; s < 2; ++s) {
            if (s == 1) {
#ifndef NO_WIN
                { pg8::Gemm g{HB, WL + WL_IN, MP, NIN, DM}; pg8::StaticOrder S; S.init(MP, NIN, G, bx);
                  pg8::EpiWin E{Qb, Kb, Vb, CBb, Ub, stats, args.in[9] + l * 64, args.in[10] + l * 64, rope};
                  pg8::gemm_phase<pg8::EpiWin, pg8::StaticOrder, true, true>(ldsp, g, S, E); }
#endif

                xcd_barrier(xbar);
                {
                    int lane = lane0; asm volatile("" : "+v"(lane));
                    const float* cw = args.in[11] + (size_t)l * 3 * 512; const float* cbias = args.in[12] + (size_t)l * 512;
                    LAS volatile unsigned* qslot = (LAS volatile unsigned*)(ldsp + RING_BYTES);
                    constexpr int UPG_S = 4 * 32 + 1, UPG_P = 4 * 16 + 1, NU_S = 8 * 2 * UPG_S, NU_P = 4 * 2 * UPG_P, NU = NU_S + NU_P, NCH = MP / 64;
                    for (;;) {
                        if (tid == 0) qslot[0] = atomicAdd(ctl + l, 1u);
                        __syncthreads();
                        const int idx = __builtin_amdgcn_readfirstlane((int)qslot[0]);
                        if (idx >= NU + NCH) break;
                        if (idx < NU) {
                            int q, rem, nqb;
                            if (idx < NU_S) { q = 4 + idx / (2 * UPG_S); rem = idx % (2 * UPG_S); nqb = 32; } else { const int i2 = idx - NU_S; q = i2 / (2 * UPG_P); rem = i2 % (2 * UPG_P); nqb = 16; }
                            const int upg = 4 * nqb + 1, kvg = rem / upg, r2 = rem % upg;
                            const int is_meta = (r2 == 4 * nqb) ? 1 : 0, h = is_meta ? 4 * kvg : 4 * kvg + r2 / nqb, b = is_meta ? 0 : r2 % nqb;
                            const long sb = seq_base(q);
#ifndef NO_ATT
                            attn_body::attn_unit<8>(sb + 256L * b, is_meta, sb + 64L * q, nqb * 4, (long)(MB + 64 * q), h,
                                (const attn_body::bf16*)Qb, (const attn_body::bf16*)Kb, (const attn_body::bf16*)Vb, (attn_body::bf16*)Yb, (char*)lds);
#endif
                        } else {
                            f32x4 w0[2], w1[2], w2[2], bb[2];
#pragma unroll
                            for (int j = 0; j < 2; ++j) { w0[j] = *(const f32x4*)(cw + 8 * lane + 4 * j); w1[j] = *(const f32x4*)(cw + 512 + 8 * lane + 4 * j); w2[j] = *(const f32x4*)(cw + 1024 + 8 * lane + 4 * j); bb[j] = *(const f32x4*)(cbias + 8 * lane + 4 * j); }
                            const int rbase = (idx - NU) * 64 + wave * 8;
                            long prev0 = -1, next7 = -1; bool valid = true;
                            if (rbase < NREAL) { const int q = rbase < 16384 ? (rbase >> 12) : 4 + ((rbase - 16384) >> 13); const int nlen = rbase < 16384 ? 4096 : 8192; const int n = rbase & (nlen - 1);
                                prev0 = (n == 0) ? (long)(MB + 64 * q + 15) : (long)rbase - 1; next7 = (n + 7 == nlen - 1) ? -1L : (long)rbase + 8; }
                            else { const int q = (rbase - MB) >> 6, i = (rbase - MB) & 63; valid = i < 16; prev0 = (i == 0) ? -1L : (long)rbase - 1; next7 = (i + 7 == 15) ? seq_base(q) : (long)rbase + 8; }
                            if (!valid) {
                                for (int rr = 0; rr < 8; ++rr) { const int row = rbase + rr; *((v4u*)(Yb + (size_t)row * 1024 + 512) + lane) = (v4u){0u, 0u, 0u, 0u}; *((v4u*)(Yb + (size_t)row * 1024) + lane) = (v4u){0u, 0u, 0u, 0u}; }
                            } else {
                                v4u uu[10], cbv[8];
                                uu[0] = prev0 >= 0 ? *((const v4u*)(Ub + (size_t)prev0 * 512) + lane) : (v4u){0u, 0u, 0u, 0u};
#pragma unroll
                                for (int k = 0; k < 8; ++k) { uu[1 + k] = *((const v4u*)(Ub + (size_t)(rbase + k) * 512) + lane); cbv[k] = *((const v4u*)(CBb + (size_t)(rbase + k) * 512) + lane); }
                                uu[9] = next7 >= 0 ? *((const v4u*)(Ub + (size_t)next7 * 512) + lane) : (v4u){0u, 0u, 0u, 0u};
#pragma unroll
                                for (int rr = 0; rr < 8; ++rr) {
                                    const v4u up = uu[rr], uc = uu[rr + 1], un = uu[rr + 2], cb = cbv[rr];
                                    float y[8]; float ss = 0.f;
#pragma unroll
                                    for (int e = 0; e < 8; ++e) { const int wi = e >> 1; const bool hi_ = e & 1;
                                        const float a = hi_ ? bfhi(up[wi]) : bflo(up[wi]), b = hi_ ? bfhi(uc[wi]) : bflo(uc[wi]), c = hi_ ? bfhi(un[wi]) : bflo(un[wi]), d = hi_ ? bfhi(cb[wi]) : bflo(cb[wi]);
                                        const float t = a * w0[e >> 2][e & 3] + b * w1[e >> 2][e & 3] + c * w2[e >> 2][e & 3] + bb[e >> 2][e & 3];
                                        y[e] = d * t; ss += y[e] * y[e]; }
                                    ss += __shfl_xor(ss, 1); ss += __shfl_xor(ss, 2); ss += __shfl_xor(ss, 4);
                                    const float rn = rsqrtf(ss * (1.0f / 64.0f) + 1e-6f);
                                    v4u o; o.x = pk2(y[0] * rn, y[1] * rn); o.y = pk2(y[2] * rn, y[3] * rn); o.z = pk2(y[4] * rn, y[5] * rn); o.w = pk2(y[6] * rn, y[7] * rn);
                                    *((v4u*)(Yb + (size_t)(rbase + rr) * 1024 + 512) + lane) = o;
                                }
                            }
                            __syncthreads();
                        }
                    }
                }
                xcd_barrier(xbar);
#ifndef NO_WOUT
                { const int Mr = (l == DEPTH - 1) ? NREAL : MP; pg8::Gemm g{Yb, WL + WL_OUT, Mr, DM, DM}; pg8::StaticOrder S; S.init(Mr, DM, G, bx);
                  pg8::EpiResid E{HB, stats, 1.0f};
                  pg8::gemm_phase<pg8::EpiResid, pg8::StaticOrder, true, true>(ldsp, g, S, E); }
#endif

                xcd_barrier(xbar);
            }
#ifndef NO_GU
            { const int Mr = (l == DEPTH - 1 && s == 1) ? NREAL : MP; pg8::Gemm g{HB, WL + (s ? WL_2GU : WL_1GU), Mr, 2 * DFF, DM}; pg8::StaticOrder S; S.init(Mr, 2 * DFF, G, bx);
              pg8::EpiGateUp E{ACT, stats, DFF};
              pg8::gemm_phase<pg8::EpiGateUp, pg8::StaticOrder, true, true>(ldsp, g, S, E); }
#endif

            xcd_barrier(xbar);
#ifndef NO_DOWN
            { const int Mr = (l == DEPTH - 1 && s == 1) ? NREAL : MP; pg8::Gemm g{ACT, WL + (s ? WL_2D : WL_1D), Mr, DM, DFF}; pg8::StaticOrder S; S.init(Mr, DM, G, bx);
              pg8::EpiResid E{HB, stats, 0.5f};
              pg8::gemm_phase<pg8::EpiResid, pg8::StaticOrder, true, true>(ldsp, g, S, E);
              if (s == 0 && l + 1 < DEPTH) {
                  const int extra = S.nwg % G, first = extra ? extra : 0;
                  if (bx >= first) { int lane = lane0; asm volatile("" : "+v"(lane)); CONVERT_LAYER(l + 1, (bx - first) * NWAVES + wave, (G - first) * NWAVES); } } }
#endif

            xcd_barrier(xbar);
        }
    }
    {
        int lane = lane0; asm volatile("" : "+v"(lane));
        const float* fn = args.in[20]; f32x4 gnv[4];
#pragma unroll
        for (int j = 0; j < 4; ++j) gnv[j] = ((const f32x4*)fn)[lane + 64 * j];
        for (int row0 = gw; row0 < NREAL; row0 += 2 * NGW) {
            unsigned long long w[2][4];
#pragma unroll
            for (int r = 0; r < 2; ++r) { const int row = row0 + r * NGW < NREAL ? row0 + r * NGW : row0;
#pragma unroll
                for (int j = 0; j < 4; ++j) w[r][j] = ((const unsigned long long*)(HB + (size_t)row * DM))[lane + 64 * j]; }
#pragma unroll
            for (int r = 0; r < 2; ++r) { const int row = row0 + r * NGW; f32x4 v[4]; float ss = 0.f;
#pragma unroll
                for (int j = 0; j < 4; ++j) { const unsigned lo = (unsigned)w[r][j], hi = (unsigned)(w[r][j] >> 32);
                    v[j][0] = bflo(lo); v[j][1] = bfhi(lo); v[j][2] = bflo(hi); v[j][3] = bfhi(hi); ss += (v[j][0] * v[j][0] + v[j][1] * v[j][1]) + (v[j][2] * v[j][2] + v[j][3] * v[j][3]); }
                const float rs = rsqrtf(wave_sum(ss) * (1.0f / 1024.0f) + 1e-6f);
                if (row < NREAL) {
#pragma unroll
                    for (int j = 0; j < 4; ++j) ((f32x4*)(args.out + (size_t)row * DM))[lane + 64 * j] = v[j] * rs * gnv[j]; } }
        }
    }
}

extern "C" void kernel_launch(void* const* d_in, const int* in_sizes, int n_in, void* d_out, int out_size, void* d_ws, size_t ws_size, hipStream_t stream) {
    static int grid = 0;
    if (grid == 0) {
        if (n_in != 21 || out_size != NREAL * DM || ws_size < WS_END || in_sizes[8] != DEPTH * DM * NIN) {
            fprintf(stderr, "kernel_launch: unexpected shapes: n_in %d out %d ws %zu (need %zu) w_in %d\n", n_in, out_size, ws_size, (size_t)WS_END, n_in > 8 ? in_sizes[8] : -1); grid = -1; return; }
        int dev = 0, cus = 0, per_cu = 0;
        (void)hipGetDevice(&dev); (void)hipDeviceGetAttribute(&cus, hipDeviceAttributeMultiprocessorCount, dev);
        if (hipFuncSetAttribute((const void*)hymba_fwd, hipFuncAttributeMaxDynamicSharedMemorySize, LDS_BYTES) != hipSuccess) { fprintf(stderr, "kernel_launch: hipFuncSetAttribute failed\n"); grid = -1; return; }
        (void)hipOccupancyMaxActiveBlocksPerMultiprocessor(&per_cu, (const void*)hymba_fwd, NWAVES * 64, LDS_BYTES);
        if (per_cu < 1) { fprintf(stderr, "kernel_launch: occupancy query says %d blocks per CU\n", per_cu); per_cu = 1; }
        (void)hipGetLastError();
        grid = cus;
    }
    if (grid < 0) return;
    Args a{};
    for (int i = 0; i < 21; ++i) a.in[i] = (const float*)d_in[i];
    a.out = (float*)d_out; a.ws = (unsigned char*)d_ws;
    void* kargs[] = {&a};
    hipError_t e = hipLaunchCooperativeKernel((const void*)hymba_fwd, dim3(grid), dim3(NWAVES * 64), kargs, LDS_BYTES, stream);
    if (e != hipSuccess) fprintf(stderr, "cooperative launch failed: %s (grid %d)\n", hipGetErrorString(e), grid);
}
```
